# Optimizing an MI355X kernel written in HIP

```python
import math
import jax, jax.numpy as jnp
from jax import lax
import numpy as np

D_MODEL = 2048
BATCH = 2
SEQ = 4096
DEPTH = 1

CHUNK = 64
EPS = 1e-6
N_HEADS_A = 8
HEAD_DIM = 128
ATTN_WIDTH = N_HEADS_A * HEAD_DIM
Q_BLOCK = 128
SGU_WIDTH = D_MODEL // 2
SGU_GROUPS = 8
SGU_GROUP_DIM = SGU_WIDTH // SGU_GROUPS
SGU_BLOCK = 128
PROJ_SPLITS = (ATTN_WIDTH, ATTN_WIDTH, ATTN_WIDTH, 2 * SGU_WIDTH, D_MODEL, D_MODEL)
PROJ_WIDTH = sum(PROJ_SPLITS)
N_EXPERTS = 32
TOP_K = 4
D_EXPERT = D_MODEL
SWIGLU_LIMIT = 7.0
SWIGLU_ALPHA = 1.702
ROW_BLOCK = 128

kernel_name = "hybrid_stickbreak_gmlp_moe_block"


def rms_norm(x, gain):
    xf = x.astype(jnp.float32)
    y = xf * lax.rsqrt(jnp.mean(xf * xf, axis=-1, keepdims=True) + EPS)
    return (y * gain.astype(jnp.float32)).astype(x.dtype)


def layer_norm(x, gain):
    xf = x.astype(jnp.float32)
    xc = xf - jnp.mean(xf, axis=-1, keepdims=True)
    y = xc * lax.rsqrt(jnp.mean(xc * xc, axis=-1, keepdims=True) + EPS)
    return (y * gain.astype(jnp.float32)).astype(x.dtype)


def stick_breaking_attention(q, k, v):
    seq = q.shape[2]
    scale = HEAD_DIM ** -0.5
    outs = []
    for blk in range(seq // Q_BLOCK):
        q0 = blk * Q_BLOCK
        end = q0 + Q_BLOCK
        z = jnp.einsum('bhtd,bhsd->bhts', q[:, :, q0:end], k[:, :, :end]).astype(jnp.float32) * scale
        t_pos = q0 + jnp.arange(Q_BLOCK)[:, None]
        s_pos = jnp.arange(end)[None, :]
        past = s_pos < t_pos
        log_keep = jnp.where(past, jax.nn.log_sigmoid(-z), 0.0)
        after = lax.cumsum(log_keep, axis=3, reverse=True) - log_keep
        w = jnp.where(past, jnp.exp(jax.nn.log_sigmoid(z) + after), 0.0)
        outs.append(jnp.einsum('bhts,bhsd->bhtd', w.astype(v.dtype), v[:, :, :end]))
    return jnp.concatenate(outs, axis=2)


def spatial_gating(v, w_s, b_s):
    bsz, seq, _ = v.shape
    vb = v.reshape(bsz, seq // SGU_BLOCK, SGU_BLOCK, SGU_GROUPS, SGU_GROUP_DIM)
    i = jnp.arange(SGU_BLOCK)
    mask = (i[None, :] // CHUNK) <= (i[:, None] // CHUNK)
    w = jnp.where(mask[None], w_s, 0.0).astype(v.dtype)
    out = jnp.einsum('gij,bnjgc->bnigc', w, vb) + b_s.T[None, None, :, :, None].astype(v.dtype)
    return out.reshape(bsz, seq, SGU_WIDTH)


def moe_ffn(h, w_router, b_router, w_up, b_up, w_down, b_down):
    bsz, seq, d = h.shape
    xt = h.reshape(-1, d)
    n_tok = xt.shape[0]
    logits = (xt @ w_router + b_router).astype(jnp.float32)
    top_val, top_idx = lax.top_k(logits, TOP_K)
    gate = jax.nn.softmax(top_val, axis=-1)
    n_assign = n_tok * TOP_K
    flat_e = top_idx.reshape(-1)
    order = jnp.argsort(flat_e)
    sorted_e = flat_e[order]
    counts = jnp.bincount(flat_e, length=N_EXPERTS)
    padded = ((counts + ROW_BLOCK - 1) // ROW_BLOCK) * ROW_BLOCK
    pad_end = jnp.cumsum(padded)
    pad_start = pad_end - padded
    start = jnp.cumsum(counts) - counts
    dest = pad_start[sorted_e] + jnp.arange(n_assign) - start[sorted_e]
    n_rows = n_assign + N_EXPERTS * ROW_BLOCK
    n_blocks = n_rows // ROW_BLOCK
    rows = jnp.zeros((n_rows, d), xt.dtype).at[dest].set(xt[order // TOP_K])
    block_e = jnp.minimum(jnp.searchsorted(pad_end, jnp.arange(n_blocks) * ROW_BLOCK, side='right'),
                          N_EXPERTS - 1).astype(jnp.int32)

    def expert_block(args):
        xb, e = args
        hu = xb @ w_up[e] + b_up[e]
        g, u = hu[:, :D_EXPERT], hu[:, D_EXPERT:]
        g = jnp.minimum(g, SWIGLU_LIMIT)
        u = jnp.clip(u, -SWIGLU_LIMIT, SWIGLU_LIMIT)
        a = g * jax.nn.sigmoid(SWIGLU_ALPHA * g) * (u + 1.0)
        return a @ w_down[e] + b_down[e]

    y_rows = lax.map(expert_block, (rows.reshape(n_blocks, ROW_BLOCK, d), block_e)).reshape(n_rows, d)
    y_sorted = y_rows[dest]
    y_assign = jnp.zeros_like(y_sorted).at[order].set(y_sorted).reshape(n_tok, TOP_K, d)
    out = jnp.einsum('tk,tkd->td', gate.astype(y_assign.dtype), y_assign)
    return out.reshape(bsz, seq, d)


def hybrid_layer(h, norm1_gain, w_in, q_norm_gain, k_norm_gain, sgu_norm_gain, w_spatial, b_spatial,
                 w_branch_a, w_branch_b, w_out, norm2_gain, w_router, b_router, w_up, b_up, w_down, b_down):
    bsz, seq, _ = h.shape
    xn = rms_norm(h, norm1_gain)
    proj = xn @ w_in
    offsets = list(np.cumsum(PROJ_SPLITS)[:-1])
    q, k, v, uv, g_a, g_b = jnp.split(proj, offsets, axis=-1)
    heads = lambda t: t.reshape(bsz, seq, N_HEADS_A, HEAD_DIM)
    q = rms_norm(heads(q), q_norm_gain).transpose(0, 2, 1, 3)
    k = rms_norm(heads(k), k_norm_gain).transpose(0, 2, 1, 3)
    v = heads(v).transpose(0, 2, 1, 3)
    o_a = stick_breaking_attention(q, k, v).transpose(0, 2, 1, 3).reshape(bsz, seq, ATTN_WIDTH)
    uv = jax.nn.gelu(uv)
    u, vv = uv[..., :SGU_WIDTH], uv[..., SGU_WIDTH:]
    o_b = u * spatial_gating(layer_norm(vv, sgu_norm_gain), w_spatial, b_spatial)
    y = jax.nn.sigmoid(g_a) * (o_a @ w_branch_a) + jax.nn.sigmoid(g_b) * (o_b @ w_branch_b)
    h = h + y @ w_out
    return h + moe_ffn(rms_norm(h, norm2_gain), w_router, b_router, w_up, b_up, w_down, b_down)


def setup_inputs(seed: int = 0) -> dict:
    key = jax.random.key(seed)
    ks = jax.random.split(key, 18)
    L = DEPTH
    f32 = jnp.float32
    nrm = lambda k, shape, fan_in: jax.random.normal(k, shape, f32) * (fan_in ** -0.5)
    gain = lambda k, n: 1.0 + 0.02 * jax.random.normal(k, (L, n), f32)
    return {
        "x": jax.random.normal(ks[0], (BATCH, SEQ, D_MODEL), f32),
        "norm1_gain": gain(ks[1], D_MODEL),
        "w_in": nrm(ks[2], (L, D_MODEL, PROJ_WIDTH), D_MODEL),
        "q_norm_gain": gain(ks[3], HEAD_DIM),
        "k_norm_gain": gain(ks[4], HEAD_DIM),
        "sgu_norm_gain": gain(ks[5], SGU_WIDTH),
        "w_spatial": nrm(ks[6], (L, SGU_GROUPS, SGU_BLOCK, SGU_BLOCK), SGU_BLOCK),
        "b_spatial": 1.0 + 0.02 * jax.random.normal(ks[7], (L, SGU_GROUPS, SGU_BLOCK), f32),
        "w_branch_a": nrm(ks[8], (L, ATTN_WIDTH, D_MODEL), ATTN_WIDTH),
        "w_branch_b": nrm(ks[9], (L, SGU_WIDTH, D_MODEL), SGU_WIDTH),
        "w_out": nrm(ks[10], (L, D_MODEL, D_MODEL), D_MODEL),
        "norm2_gain": gain(ks[11], D_MODEL),
        "w_router": nrm(ks[12], (L, D_MODEL, N_EXPERTS), D_MODEL),
        "b_router": 0.01 * jax.random.normal(ks[13], (L, N_EXPERTS), f32),
        "w_up": nrm(ks[14], (L, N_EXPERTS, D_MODEL, 2 * D_EXPERT), D_MODEL),
        "b_up": 0.01 * jax.random.normal(ks[15], (L, N_EXPERTS, 2 * D_EXPERT), f32),
        "w_down": nrm(ks[16], (L, N_EXPERTS, D_EXPERT, D_MODEL), D_EXPERT),
        "b_down": 0.01 * jax.random.normal(ks[17], (L, N_EXPERTS, D_MODEL), f32),
    }


def reference(x, norm1_gain, w_in, q_norm_gain, k_norm_gain, sgu_norm_gain, w_spatial, b_spatial,
              w_branch_a, w_branch_b, w_out, norm2_gain, w_router, b_router, w_up, b_up, w_down, b_down):
    h = x
    for l in range(DEPTH):
        h = hybrid_layer(h, norm1_gain[l], w_in[l], q_norm_gain[l], k_norm_gain[l], sgu_norm_gain[l],
                         w_spatial[l], b_spatial[l], w_branch_a[l], w_branch_b[l], w_out[l], norm2_gain[l],
                         w_router[l], b_router[l], w_up[l], b_up[l], w_down[l], b_down[l])
    return h
```

```cpp
#ifndef MOE_TAIL_TEST
#define MOE_TAIL_TEST 0
#endif
#include <hip/hip_runtime.h>
#include <cstdio>
#include <cstdint>

#ifndef DBG_STAGE
#define DBG_STAGE 99
#endif
#ifndef PH_MASK
#define PH_MASK 0x1ff
#endif
#define PH_ON(p) ((PH_MASK >> (p)) & 1)

#define LAS __attribute__((address_space(3)))
#define GAS __attribute__((address_space(1)))
typedef unsigned short bf16;
typedef short bf16x8 __attribute__((ext_vector_type(8)));
typedef float f32x4 __attribute__((ext_vector_type(4)));
typedef float f32x2 __attribute__((ext_vector_type(2)));
typedef float f32x16 __attribute__((ext_vector_type(16)));
typedef unsigned u32x4 __attribute__((ext_vector_type(4)));
typedef unsigned u32x2 __attribute__((ext_vector_type(2)));
typedef int i32x8 __attribute__((ext_vector_type(8)));
typedef int i32x4 __attribute__((ext_vector_type(4)));

constexpr int T = 8192, D = 2048, SEQ = 4096, NH = 8, HD = 128, AW = 1024, SW = 1024, PW = 9216, NE = 32, TOPK = 4, DE = 2048;
constexpr int N1 = 7168;
constexpr int C_Q = 0, C_K = 1024, C_U = 2048, C_GA = 3072, C_GB = 5120;
constexpr float EPS = 1e-6f;
constexpr int NWAVES = 8;

constexpr size_t MiB = 1u << 20;
constexpr size_t WS_CTL = 0, CTL_ZERO_BYTES = 64 * 1024;
constexpr size_t WS_W1T = 2 * MiB;
constexpr size_t WS_W2T = 32 * MiB;
constexpr size_t WS_WAT = 40 * MiB;
constexpr size_t WS_WBT = 44 * MiB;
constexpr size_t WS_WOT = 48 * MiB;
constexpr size_t WS_XN = 64 * MiB;
constexpr size_t WS_PB = 96 * MiB;
constexpr size_t WS_VT = 208 * MiB;
constexpr size_t WS_OA = 240 * MiB;
constexpr size_t WS_OB = 256 * MiB;
constexpr size_t WS_QB = 272 * MiB;
constexpr size_t WS_KB = 288 * MiB;
constexpr size_t WS_Y = 336 * MiB;
constexpr size_t WS_ROUTE = 368 * MiB;
constexpr size_t WS_STATS = 369 * MiB;
constexpr size_t WS_ACT = 370 * MiB;
constexpr size_t WS_YM = 500 * MiB;
constexpr size_t WS_WUT = 640 * MiB;
constexpr size_t WS_WDT = 1152 * MiB;
constexpr size_t WS_XG = 1408 * MiB;
constexpr size_t WS_END = 2432 * MiB;
constexpr int CW_BAR = 4096;
constexpr int CW_CNT = 8192;
constexpr int CW_STATS = 16384;

constexpr int RING_BYTES = 131072;
constexpr int SCR_OFF = RING_BYTES;
constexpr int MISC_OFF = RING_BYTES + 8192;
constexpr int LDS_BYTES = RING_BYTES + 8192 + 2048;
constexpr int MW_BAR = 8;
constexpr int MW_CNT = 32, MW_OFF = 64, MW_US6 = 96, MW_US7 = 160;

#define LDS_WAIT() asm volatile("s_waitcnt lgkmcnt(0)" ::: "memory")
#define VM_WAIT() asm volatile("s_waitcnt vmcnt(0)" ::: "memory")

__device__ __forceinline__ unsigned cvt_pk_bf16(float lo, float hi) { unsigned r; asm volatile("v_cvt_pk_bf16_f32 %0, %1, %2" : "=v"(r) : "v"(lo), "v"(hi)); return r; }
__device__ __forceinline__ unsigned pk4_fp8(float a, float b, float c, float d) {
    a = __builtin_amdgcn_fmed3f(a, -448.f, 448.f); b = __builtin_amdgcn_fmed3f(b, -448.f, 448.f); c = __builtin_amdgcn_fmed3f(c, -448.f, 448.f); d = __builtin_amdgcn_fmed3f(d, -448.f, 448.f);
    int r = 0; r = __builtin_amdgcn_cvt_pk_fp8_f32(a, b, r, false); r = __builtin_amdgcn_cvt_pk_fp8_f32(c, d, r, true); return (unsigned)r; }
constexpr float SC_W8 = 64.f, SC_X8 = 4.f, SC_A8 = 2.f;
__device__ __forceinline__ float bf_lo(unsigned u) { return __uint_as_float(u << 16); }
__device__ __forceinline__ float bf_hi(unsigned u) { return __uint_as_float(u & 0xffff0000u); }
__device__ __forceinline__ float fast_rcp(float x) { return __builtin_amdgcn_rcpf(x); }
__device__ __forceinline__ float sigmoid_f(float x) { return fast_rcp(1.f + __builtin_amdgcn_exp2f(-1.4426950408889634f * x)); }
__device__ __forceinline__ float gelu_tanh_f(float x) { const float in = -2.302208198f * (x + 0.044715f * x * x * x); return x * fast_rcp(1.f + __builtin_amdgcn_exp2f(in)); }
__device__ __forceinline__ float wave_sum(float v) {
#pragma unroll
    for (int o = 1; o < 64; o <<= 1) v += __shfl_xor(v, o);
    return v;
}

namespace pg8 {
constexpr int BM = 256, BK = 64, HALF = 128, HTB = HALF * BK * 2, STAGE_BYTES = 8 * HTB;
__host__ __device__ __forceinline__ int lds_byte(int r, int c) { const int st = (r >> 4) * 2 + (c >> 5), rr = r & 15, cc = c & 31, ob = rr * 64 + cc * 2; return st * 1024 + (ob ^ (((ob >> 9) & 1) << 5)); }
__host__ __device__ __forceinline__ void stage_rc(int b, int& R, int& C) { const int st = b / 1024, sb = b % 1024, swz = sb ^ (((sb >> 9) & 1) << 5); R = (st >> 1) * 16 + swz / 64; C = (st & 1) * 32 + (swz % 64) / 2; }
__host__ __device__ __forceinline__ int perm32(int rho) { const int n = rho >> 4, i = rho & 15; return 8 * (i >> 2) + 4 * n + (i & 3); }

struct Unit { const char* A; const char* B; int kind, pm, pn, e, nvalid, rbase; };
struct Gemm { int lda, ldb, K; };

__device__ __forceinline__ void tile_order(int L, int nM, int nN, int& pm, int& pn) {
    const int nwg = nM * nN; int wgid = L;
    { const int q = nwg / 8, r = nwg % 8, xcd = wgid % 8, off = wgid / 8; wgid = (xcd < r ? xcd * (q + 1) : r * (q + 1) + (xcd - r) * q) + off; }
    const int nig = 8 * nN, gid = wgid / nig, fm = gid * 8, gsz = (nM - fm) < 8 ? (nM - fm) : 8;
    pm = fm + ((wgid % nig) % gsz); pn = (wgid % nig) / gsz;
}

template <class Epi, class Sched, bool F8 = false>
__device__ __forceinline__ void gemm_phase(LAS unsigned char* lds, const Gemm g, const Sched& S, const Epi& E) {
    int tid_ = threadIdx.x; asm volatile("" : "+v"(tid_));
    const int tid = tid_, wid = __builtin_amdgcn_readfirstlane(tid >> 6), lane = tid & 63, wr = wid >> 2, wc = wid & 3, fr = lane & 15, fq = lane >> 4;
    const int K = g.K, nt = K / BK;
    unsigned voffA[2], voffB[2];
#pragma unroll
    for (int i = 0; i < 2; ++i) { int R, C; stage_rc(tid * 16 + i * 8192, R, C); const int Rb = Epi::PERM ? ((R & ~31) + perm32(R & 31)) : R;
        voffA[i] = (unsigned)(R * g.lda + C) * 2u; voffB[i] = (unsigned)(Rb * g.ldb + C) * 2u; }
    const size_t kstep = (size_t)(BK * 2);
    const size_t hstepA = (size_t)HALF * g.lda * 2, hstepB = (size_t)HALF * g.ldb * 2;
    const unsigned ldsw = (unsigned)wid * 1024u;
    const int aoff = lds_byte(wr * 64 + fr, fq * 8), boff = lds_byte(wc * 32 + fr, fq * 8);
#define PG8_SA(b, h) (((b) * 2 + (h)) * HTB)
#define PG8_SB(b, h) ((4 + (b) * 2 + (h)) * HTB)
#define PG8_STAGE(bufoff, gbase, voff) do { _Pragma("unroll") for (int _i = 0; _i < 2; ++_i) \
        __builtin_amdgcn_global_load_lds((const unsigned*)((const char*)(gbase) + (voff)[_i]), (LAS unsigned*)(lds + (bufoff) + ldsw + _i * 8192), 16, 0, 0); } while (0)
#define PG8_LDA(dst, b, h) do { _Pragma("unroll") for (int m = 0; m < 4; ++m) { const i32x4 lo_ = *(const LAS i32x4*)(lds + PG8_SA(b, h) + aoff + m * 2048), hi_ = *(const LAS i32x4*)(lds + PG8_SA(b, h) + aoff + m * 2048 + 1024); \
        dst[m] = __builtin_shufflevector(lo_, hi_, 0, 1, 2, 3, 4, 5, 6, 7); } } while (0)
#define PG8_LDB(dst, b, h) do { _Pragma("unroll") for (int n = 0; n < 2; ++n) { const i32x4 lo_ = *(const LAS i32x4*)(lds + PG8_SB(b, h) + boff + n * 2048), hi_ = *(const LAS i32x4*)(lds + PG8_SB(b, h) + boff + n * 2048 + 1024); \
        dst[n] = __builtin_shufflevector(lo_, hi_, 0, 1, 2, 3, 4, 5, 6, 7); } } while (0)
#define PG8_MMA(ai, bj, At, Bt) do { __builtin_amdgcn_s_setprio(1); _Pragma("unroll") for (int m = 0; m < 4; ++m) _Pragma("unroll") for (int n = 0; n < 2; ++n) { \
        if constexpr (F8) { asm volatile("v_mfma_f32_16x16x128_f8f6f4 %0, %1, %2, %0" : "+v"(acc[ai][bj][m][n]) : "v"(Bt[n]), "v"(At[m])); } \
        else { acc[ai][bj][m][n] = __builtin_amdgcn_mfma_f32_16x16x32_bf16(__builtin_bit_cast(bf16x8, __builtin_shufflevector(Bt[n], Bt[n], 0, 1, 2, 3)), __builtin_bit_cast(bf16x8, __builtin_shufflevector(At[m], At[m], 0, 1, 2, 3)), acc[ai][bj][m][n], 0, 0, 0); \
               acc[ai][bj][m][n] = __builtin_amdgcn_mfma_f32_16x16x32_bf16(__builtin_bit_cast(bf16x8, __builtin_shufflevector(Bt[n], Bt[n], 4, 5, 6, 7)), __builtin_bit_cast(bf16x8, __builtin_shufflevector(At[m], At[m], 4, 5, 6, 7)), acc[ai][bj][m][n], 0, 0, 0); } } \
        __builtin_amdgcn_s_setprio(0); } while (0)
#define PG8_WAIT_V(n) asm volatile("s_waitcnt vmcnt(" #n ")" ::: "memory")
#define PG8_WAIT_L(n) asm volatile("s_waitcnt lgkmcnt(" #n ")" ::: "memory")
#define PG8_BAR __builtin_amdgcn_s_barrier()
#define PG8_SCHED __builtin_amdgcn_sched_barrier(0)
    Unit cur, nxt; int ui = 0;
    if (!S.next(0, cur)) return;
    f32x4 acc[2][2][4][2];
#pragma unroll
    for (int a = 0; a < 2; ++a)
#pragma unroll
        for (int b = 0; b < 2; ++b)
#pragma unroll
            for (int m = 0; m < 4; ++m)
#pragma unroll
                for (int n = 0; n < 2; ++n) acc[a][b][m][n] = (f32x4){0.f, 0.f, 0.f, 0.f};
    i32x8 At[4], B0[2], B1[2];
    const char* cA = cur.A; const char* cB = cur.B;
    PG8_STAGE(PG8_SB(0, 0), cB, voffB); PG8_STAGE(PG8_SB(0, 1), cB + hstepB, voffB); PG8_STAGE(PG8_SA(0, 0), cA, voffA); PG8_STAGE(PG8_SA(0, 1), cA + hstepA, voffA);
    if (wr == 1) PG8_BAR;
    PG8_WAIT_V(2); PG8_BAR;
    PG8_STAGE(PG8_SB(1, 0), cB + kstep, voffB); PG8_STAGE(PG8_SA(1, 0), cA + kstep, voffA); PG8_STAGE(PG8_SB(1, 1), cB + hstepB + kstep, voffB);
    PG8_WAIT_V(6); PG8_BAR;
    for (;;) {
        const bool has_next = S.next(ui + 1, nxt);
        const char* nA = has_next ? nxt.A : cA; const char* nB = has_next ? nxt.B : cB;
        const bool full = cur.nvalid > HALF;
        for (int t = 0; t < nt; t += 2) {
            const bool last = (t == nt - 2);
            const char* a1 = cA + (size_t)(t + 1) * kstep;
            const char* a2 = last ? nA : cA + (size_t)(t + 2) * kstep; const char* b2 = last ? nB : cB + (size_t)(t + 2) * kstep;
            const char* a3 = a2 + kstep; const char* b3 = b2 + kstep;
            PG8_LDB(B0, 0, 0); PG8_LDB(B1, 0, 1); PG8_SCHED; PG8_LDA(At, 0, 0); PG8_STAGE(PG8_SA(1, 1), a1 + hstepA, voffA);
            PG8_WAIT_V(8); PG8_WAIT_L(0); PG8_BAR; PG8_MMA(0, 0, At, B0); PG8_MMA(0, 1, At, B1); PG8_BAR; PG8_SCHED;
            if (!F8 || full) PG8_LDA(At, 0, 1); PG8_STAGE(PG8_SB(0, 0), b2, voffB); PG8_STAGE(PG8_SB(0, 1), b2 + hstepB, voffB); PG8_STAGE(PG8_SA(0, 0), a2, voffA);
            PG8_WAIT_V(8); PG8_WAIT_L(0); PG8_BAR; if (!F8 || full) { PG8_MMA(1, 0, At, B0); PG8_MMA(1, 1, At, B1); } PG8_BAR; PG8_SCHED;
            PG8_LDB(B0, 1, 0); PG8_LDB(B1, 1, 1); PG8_SCHED; PG8_LDA(At, 1, 0); PG8_STAGE(PG8_SA(0, 1), a2 + hstepA, voffA);
            PG8_WAIT_V(8); PG8_WAIT_L(0); PG8_BAR; PG8_MMA(0, 0, At, B0); PG8_MMA(0, 1, At, B1); PG8_BAR; PG8_SCHED;
            if (!F8 || full) PG8_LDA(At, 1, 1); PG8_STAGE(PG8_SB(1, 0), b3, voffB); PG8_STAGE(PG8_SB(1, 1), b3 + hstepB, voffB); PG8_STAGE(PG8_SA(1, 0), a3, voffA);
            PG8_WAIT_V(8); PG8_WAIT_L(0); PG8_BAR; if (!F8 || full) { PG8_MMA(1, 0, At, B0); PG8_MMA(1, 1, At, B1); } PG8_BAR; PG8_SCHED;
        }
        if constexpr (F8) asm volatile("s_nop 15\n\ts_nop 15\n\ts_nop 7" ::: "memory");
        if (wr == 0) PG8_BAR;
        E(acc, cur, wr, wc, fr, fq);
        if (!has_next) break;
        if (!(Epi::CHAIN && cur.kind == 0)) {
#pragma unroll
        for (int a = 0; a < 2; ++a)
#pragma unroll
            for (int b = 0; b < 2; ++b)
#pragma unroll
                for (int m = 0; m < 4; ++m)
#pragma unroll
                    for (int n = 0; n < 2; ++n) acc[a][b][m][n] = (f32x4){0.f, 0.f, 0.f, 0.f};
        }
        cur = nxt; cA = nA; cB = nB; ++ui;
        if (wr == 1) PG8_BAR;
    }
    PG8_WAIT_V(0);
    PG8_BAR;
#undef PG8_SA
#undef PG8_SB
#undef PG8_STAGE
#undef PG8_LDA
#undef PG8_LDB
#undef PG8_MMA
#undef PG8_WAIT_V
#undef PG8_WAIT_L
#undef PG8_BAR
#undef PG8_SCHED
}
}
using pg8::Unit;

#define XB_TMO      128
#define XB_XCNT(j)  (256  + 64 * (j))
#define XB_XSUB(j)  (1280 + 64 * (j))
#define XB_XGEN(j)  (2304 + 64 * (j))
#define XB_TOP      3328
#define XB_TOPGEN   3392
#define XCD_BAR_WORDS 3456
#define XB_SPIN_CAP (1u << 18)
__device__ __forceinline__ unsigned xb_ld(unsigned* p)              { return __hip_atomic_load(p, __ATOMIC_RELAXED, __HIP_MEMORY_SCOPE_AGENT); }
__device__ __forceinline__ unsigned xb_add(unsigned* p, unsigned v) { return __hip_atomic_fetch_add(p, v, __ATOMIC_RELAXED, __HIP_MEMORY_SCOPE_AGENT); }
__device__ __forceinline__ unsigned xb_xcc_id() { return (unsigned)__builtin_amdgcn_s_getreg((3 << 11) | 20) & 0xFu; }
#define XB_SPIN(cond, bar) do { unsigned _sp = 0; while (cond) { __builtin_amdgcn_s_sleep(1); \
    if ((++_sp & 255u) == 0u) { if (xb_ld(&(bar)[XB_TMO])) break; if (_sp > XB_SPIN_CAP) { atomicAdd(&(bar)[XB_TMO], 1u); break; } } } } while (0)
struct XcdBarrier { unsigned* bar; unsigned x; volatile LAS unsigned* st; };
__device__ __forceinline__ XcdBarrier xcd_barrier_post(unsigned* bar, volatile LAS unsigned* st) {
    XcdBarrier b; b.bar = bar; b.x = xb_xcc_id(); b.st = st;
    if (threadIdx.x == 0) (void)xb_add(&bar[XB_XCNT(b.x)], 1u);
    return b;
}
__device__ __forceinline__ void xcd_barrier_complete(unsigned* bar, unsigned x, unsigned& nloc, unsigned& nx) {
    const unsigned G = gridDim.x * gridDim.y * gridDim.z;
    unsigned sum, cnt, mine, sp = 0u;
    for (;;) {
        sum = 0u; cnt = 0u; mine = 0u;
#pragma unroll
        for (unsigned j = 0; j < 16; ++j) { const unsigned c = xb_ld(&bar[XB_XCNT(j)]); sum += c; cnt += (c > 0u) ? 1u : 0u; mine = (j == x) ? c : mine; }
        if (sum == G) break;
        __builtin_amdgcn_s_sleep(1);
        if ((++sp & 255u) == 0u) { if (xb_ld(&bar[XB_TMO])) break; if (sp > XB_SPIN_CAP) { atomicAdd(&bar[XB_TMO], 1u); break; } }
    }
    nloc = mine > 0u ? mine : 1u; nx = cnt > 0u ? cnt : 1u;
}
__device__ __forceinline__ void xcd_barrier(const XcdBarrier& b) {
    asm volatile("s_waitcnt vmcnt(0)" ::: "memory");
    __syncthreads();
    if (threadIdx.x == 0) {
        unsigned* bar = b.bar;
        __builtin_amdgcn_s_waitcnt(0);
        unsigned nloc = b.st[0], nx = b.st[1];
        if (nloc == 0u) { xcd_barrier_complete(bar, b.x, nloc, nx); b.st[0] = nloc; b.st[1] = nx; }
        const unsigned old = xb_add(&bar[XB_XSUB(b.x)], 1u);
        const unsigned gen = old / nloc;
        if (old + 1u == (gen + 1u) * nloc) {
            __builtin_amdgcn_fence(__ATOMIC_RELEASE, "agent");
            asm volatile("s_waitcnt vmcnt(0)" ::: "memory");
            const unsigned og = xb_add(&bar[XB_TOP], 1u);
            const unsigned tg = og / nx;
            if (og + 1u == (tg + 1u) * nx) xb_add(&bar[XB_TOPGEN], 1u);
            else XB_SPIN(xb_ld(&bar[XB_TOPGEN]) == tg, bar);
            __builtin_amdgcn_fence(__ATOMIC_ACQUIRE, "agent");
            xb_add(&bar[XB_XGEN(b.x)], 1u);
            asm volatile("s_waitcnt vmcnt(0)" ::: "memory");
        } else {
            XB_SPIN(xb_ld(&bar[XB_XGEN(b.x)]) == gen, bar);
            __builtin_amdgcn_fence(__ATOMIC_ACQUIRE, "agent");
            asm volatile("s_waitcnt vmcnt(0)" ::: "memory");
        }
    }
    __syncthreads();
}

struct Args { const float* in[18]; float* out; unsigned char* ws; };

constexpr int I_UP1 = (D / 128) * (2 * DE / 32);
constexpr int I_DN1 = (DE / 128) * (D / 32);
constexpr int MOE_ITEMS = NE * (I_UP1 + I_DN1);
struct MoeItem { const float* src; unsigned char* dst; int ldw; };
__device__ __forceinline__ MoeItem moe_item(const Args& a, int r) {
    MoeItem m; unsigned char* ws = a.ws;
    if (r < NE * I_UP1) { const int e = r / I_UP1, q = r % I_UP1; const int nblk = 2 * DE / 32, kb = q / nblk, nb = q % nblk, k0 = kb * 128, n0 = nb * 32;
        const int nn = n0 < DE ? n0 : n0 - DE; const int row = (nn >> 7) * 256 + (nn & 127) + (n0 < DE ? 0 : 128);
        m.src = a.in[14] + ((size_t)e * D + k0) * (2 * DE) + n0; m.ldw = 2 * DE; m.dst = ws + WS_WUT + ((size_t)e * 2 * DE + row) * D + k0; }
    else { r -= NE * I_UP1; const int e = r / I_DN1, q = r % I_DN1; const int nblk = D / 32, kb = q / nblk, nb = q % nblk, k0 = kb * 128, n0 = nb * 32;
        m.src = a.in[16] + ((size_t)e * DE + k0) * D + n0; m.ldw = D; m.dst = ws + WS_WDT + ((size_t)e * D + n0) * DE + k0; }
    return m;
}
__device__ __forceinline__ void moe_load(f32x4 (&v)[16], const MoeItem& m, int lane) {
#pragma unroll
    for (int j = 0; j < 16; ++j) v[j] = __builtin_nontemporal_load((const f32x4*)(m.src + (size_t)(16 * (lane >> 3) + j) * m.ldw + 4 * (lane & 7)));
}
__device__ __forceinline__ void moe_store(const f32x4 (&v)[16], unsigned char* dst, int lane) {
#pragma unroll
    for (int i = 0; i < 4; ++i) { u32x4 o;
        o.x = pk4_fp8(v[0][i] * SC_W8, v[1][i] * SC_W8, v[2][i] * SC_W8, v[3][i] * SC_W8); o.y = pk4_fp8(v[4][i] * SC_W8, v[5][i] * SC_W8, v[6][i] * SC_W8, v[7][i] * SC_W8);
        o.z = pk4_fp8(v[8][i] * SC_W8, v[9][i] * SC_W8, v[10][i] * SC_W8, v[11][i] * SC_W8); o.w = pk4_fp8(v[12][i] * SC_W8, v[13][i] * SC_W8, v[14][i] * SC_W8, v[15][i] * SC_W8);
        __builtin_nontemporal_store(o, (u32x4*)(dst + (size_t)(4 * (lane & 7) + i) * DE + 16 * (lane >> 3))); }
}
__device__ __forceinline__ void moe_convert(const Args& a, LAS unsigned char* lds, int begin, int end, int wave, int lane) {
    int it = begin + wave;
    if (it >= end) return;
    f32x4 cur[16], nxt[16];
    MoeItem mc = moe_item(a, it);
    moe_load(cur, mc, lane);
    for (;;) {
        const int itn = it + NWAVES; const bool more = itn < end;
        MoeItem mn = mc;
        if (more) { mn = moe_item(a, itn); moe_load(nxt, mn, lane); }
        moe_store(cur, mc.dst, lane);
        if (!more) break;
#pragma unroll
        for (int j = 0; j < 16; ++j) cur[j] = nxt[j];
        mc = mn; it = itn;
    }
}

struct P0Item { const float* src; bf16* dst; int ldw, ldt; };
__device__ __forceinline__ P0Item p0_item(const Args& a, int r) {
    constexpr int I_IN = (D / 64) * (PW / 32), I_A = (AW / 64) * (D / 32);
    unsigned char* ws = a.ws; bf16* W1T = (bf16*)(ws + WS_W1T); bf16* W2T = (bf16*)(ws + WS_W2T);
    P0Item m;
    if (r < I_IN) { const int nblk = PW / 32, kb = r / nblk, nb = r % nblk, k0 = kb * 64, n0 = nb * 32;
        bf16* dst;
        if (n0 < 2048) dst = W1T + (size_t)n0 * D; else if (n0 < 3072) dst = W2T + (size_t)(n0 - 2048) * D; else if (n0 < 4096) dst = W1T + (size_t)(n0 - 1024) * D;
        else if (n0 < 5120) dst = W2T + (size_t)(n0 - 3072) * D; else dst = W1T + (size_t)(n0 - 2048) * D;
        m.src = a.in[2] + (size_t)k0 * PW + n0; m.ldw = PW; m.dst = dst + k0; m.ldt = D; return m; }
    r -= I_IN;
    const int nblk = D / 32;
    if (r < I_A) { const int kb2 = r / nblk, nb = r % nblk, k0 = kb2 * 64, n0 = nb * 32; m.src = a.in[8] + (size_t)k0 * D + n0; m.ldw = D; m.dst = (bf16*)(ws + WS_WAT) + (size_t)n0 * AW + k0; m.ldt = AW; return m; }
    r -= I_A;
    if (r < I_A) { const int kb2 = r / nblk, nb = r % nblk, k0 = kb2 * 64, n0 = nb * 32; m.src = a.in[9] + (size_t)k0 * D + n0; m.ldw = D; m.dst = (bf16*)(ws + WS_WBT) + (size_t)n0 * SW + k0; m.ldt = SW; return m; }
    r -= I_A;
    { const int kb2 = r / nblk, nb = r % nblk, k0 = kb2 * 64, n0 = nb * 32; m.src = a.in[10] + (size_t)k0 * D + n0; m.ldw = D; m.dst = (bf16*)(ws + WS_WOT) + (size_t)n0 * D + k0; m.ldt = D; return m; }
}
__device__ __forceinline__ void p0_load(f32x4 (&v)[8], const P0Item& m, int lane) {
#pragma unroll
    for (int j = 0; j < 8; ++j) v[j] = __builtin_nontemporal_load((const f32x4*)(m.src + (size_t)(8 * (lane >> 3) + j) * m.ldw + 4 * (lane & 7)));
}
__device__ __forceinline__ void p0_store(const f32x4 (&v)[8], const P0Item& m, int lane) {
#pragma unroll
    for (int i = 0; i < 4; ++i) { u32x4 o; o.x = cvt_pk_bf16(v[0][i], v[1][i]); o.y = cvt_pk_bf16(v[2][i], v[3][i]); o.z = cvt_pk_bf16(v[4][i], v[5][i]); o.w = cvt_pk_bf16(v[6][i], v[7][i]);
        *(u32x4*)(m.dst + (size_t)(4 * (lane & 7) + i) * m.ldt + 8 * (lane >> 3)) = o; }
}
__device__ __forceinline__ void p0_prologue(const Args& a, LAS unsigned char* lds, int vcu, int G, int wave, int lane) {
    unsigned char* ws = a.ws;
    const int gw = vcu * NWAVES + wave, NGW = G * NWAVES;
    constexpr int NITEMS = (D / 64) * (PW / 32) + 2 * (AW / 64) * (D / 32) + (D / 64) * (D / 32);
    if (gw < NITEMS) {
        int it = gw; f32x4 cur[8], nxt[8]; P0Item mc = p0_item(a, it); p0_load(cur, mc, lane);
        for (;;) { const int itn = it + NGW; const bool more = itn < NITEMS; P0Item mn = mc;
            if (more) { mn = p0_item(a, itn); p0_load(nxt, mn, lane); }
            p0_store(cur, mc, lane);
            if (!more) break;
#pragma unroll
            for (int j = 0; j < 8; ++j) cur[j] = nxt[j];
            mc = mn; it = itn; }
    }
    const float* g1 = a.in[1];
    if (gw < T) {
        int m = gw; f32x4 v[8], vn[8];
        { const f32x4* xr = (const f32x4*)(a.in[0] + (size_t)m * D) + lane;
#pragma unroll
          for (int j = 0; j < 8; ++j) v[j] = __builtin_nontemporal_load(xr + 64 * j); }
        for (;;) { const int mn = m + NGW; const bool more = mn < T;
            if (more) { const f32x4* xr = (const f32x4*)(a.in[0] + (size_t)mn * D) + lane;
#pragma unroll
                for (int j = 0; j < 8; ++j) vn[j] = __builtin_nontemporal_load(xr + 64 * j); }
            float s = 0.f;
#pragma unroll
            for (int j = 0; j < 8; ++j) s += (v[j].x * v[j].x + v[j].y * v[j].y) + (v[j].z * v[j].z + v[j].w * v[j].w);
            const float rstd = rsqrtf(wave_sum(s) * (1.f / D) + EPS);
            u32x2* o8 = (u32x2*)((bf16*)(ws + WS_XN) + (size_t)m * D) + lane;
#pragma unroll
            for (int j = 0; j < 8; ++j) { const f32x4 gg = *((const f32x4*)g1 + lane + 64 * j);
                u32x2 o; o.x = cvt_pk_bf16(v[j].x * rstd * gg.x, v[j].y * rstd * gg.y); o.y = cvt_pk_bf16(v[j].z * rstd * gg.z, v[j].w * rstd * gg.w); o8[64 * j] = o; }
            if (!more) break;
#pragma unroll
            for (int j = 0; j < 8; ++j) v[j] = vn[j];
            m = mn; }
    }
}

struct Epi1 {
    static constexpr bool PERM = true, CHAIN = false;
    bf16* PB; bf16* VT; bf16* QB; bf16* KB; float* stats; const float* gq; const float* gk; LAS float* scr;
    __device__ __forceinline__ void operator()(f32x4 (&acc)[2][2][4][2], const Unit& u, int wr, int wc, int fr, int fq) const {
        if (u.kind == 0) {
            const int pn = u.pn;
            bf16* base = PB + (size_t)(u.pm * 256 + wr * 64 + fr) * N1 + pn * 256 + wc * 32 + 8 * fq;
            if (pn < 8) {
#pragma unroll
                for (int ai = 0; ai < 2; ++ai)
#pragma unroll
                    for (int m = 0; m < 4; ++m)
#pragma unroll
                        for (int bj = 0; bj < 2; ++bj) { const f32x4 x0 = acc[ai][bj][m][0], x1 = acc[ai][bj][m][1];
                            float s = (x0.x * x0.x + x0.y * x0.y) + (x0.z * x0.z + x0.w * x0.w) + (x1.x * x1.x + x1.y * x1.y) + (x1.z * x1.z + x1.w * x1.w);
                            s += __shfl_xor(s, 16); s += __shfl_xor(s, 32);
                            if (fq == 0) scr[(ai * 128 + wr * 64 + m * 16 + fr) * 8 + bj * 4 + wc] = s; }
                LDS_WAIT(); __builtin_amdgcn_s_barrier(); asm volatile("" ::: "memory");
                const float* gn = (pn < 4) ? gq : gk; const float sc = (pn < 4) ? 0.12751743082459868f : 1.f;
                const f32x4 g0 = *(const f32x4*)(gn + wc * 32 + 8 * fq), g1 = *(const f32x4*)(gn + wc * 32 + 8 * fq + 4);
                bf16* qkb = (pn < 4 ? QB : KB) + ((size_t)(((u.pm * 256) >> 12) * NH + (pn & 3) * 2) * SEQ + ((u.pm * 256) & (SEQ - 1)) + wr * 64 + fr) * HD + wc * 32 + 8 * fq;
#pragma unroll
                for (int ai = 0; ai < 2; ++ai)
#pragma unroll
                    for (int m = 0; m < 4; ++m) { const int row = ai * 128 + wr * 64 + m * 16 + fr;
#pragma unroll
                        for (int bj = 0; bj < 2; ++bj) { const f32x4 p = *(const LAS f32x4*)(scr + row * 8 + bj * 4);
                            const float rinv = rsqrtf(((p.x + p.y) + (p.z + p.w)) * (1.f / HD) + EPS) * sc;
                            const f32x4 v0 = acc[ai][bj][m][0] * rinv * g0, v1 = acc[ai][bj][m][1] * rinv * g1;
                            u32x4 w; w.x = cvt_pk_bf16(v0.x, v0.y); w.y = cvt_pk_bf16(v0.z, v0.w); w.z = cvt_pk_bf16(v1.x, v1.y); w.w = cvt_pk_bf16(v1.z, v1.w);
                            *(u32x4*)(qkb + (size_t)(ai * 128 + m * 16) * HD + (size_t)bj * SEQ * HD) = w; } __builtin_amdgcn_sched_barrier(0); }
                LDS_WAIT();
            } else {
                const bool is_gelu = pn < 12;
#pragma unroll
                for (int ai = 0; ai < 2; ++ai)
#pragma unroll
                    for (int m = 0; m < 4; ++m)
#pragma unroll
                        for (int bj = 0; bj < 2; ++bj) { f32x4 v0 = acc[ai][bj][m][0], v1 = acc[ai][bj][m][1];
                            if (is_gelu) {
#pragma unroll
                                for (int j = 0; j < 4; ++j) { v0[j] = gelu_tanh_f(v0[j]); v1[j] = gelu_tanh_f(v1[j]); }
                            } else {
#pragma unroll
                                for (int j = 0; j < 4; ++j) { v0[j] = sigmoid_f(v0[j]); v1[j] = sigmoid_f(v1[j]); }
                            }
                            u32x4 w; w.x = cvt_pk_bf16(v0.x, v0.y); w.y = cvt_pk_bf16(v0.z, v0.w); w.z = cvt_pk_bf16(v1.x, v1.y); w.w = cvt_pk_bf16(v1.z, v1.w);
                            *(u32x4*)(base + (size_t)(ai * 128 + m * 16) * N1 + bj * 128) = w; __builtin_amdgcn_sched_barrier(0); }
            }
        } else {
            const bool is_vv = u.pm >= 4;
            bf16* vtb = VT + ((((size_t)(((u.pn * 256) >> 12) * 16 + u.pm * 2) * 128 + (((u.pn * 256) & (SEQ - 1)) >> 5) + wc) * 128 + wr * 64 + fr) * 32 + 8 * fq);
            if (is_vv) {
#pragma unroll
                for (int bj = 0; bj < 2; ++bj)
#pragma unroll
                    for (int n = 0; n < 2; ++n) { f32x4 s = (f32x4){0.f, 0.f, 0.f, 0.f}, q = s;
#pragma unroll
                        for (int ai = 0; ai < 2; ++ai)
#pragma unroll
                            for (int m = 0; m < 4; ++m) { f32x4 x = acc[ai][bj][m][n];
#pragma unroll
                                for (int j = 0; j < 4; ++j) x[j] = gelu_tanh_f(x[j]);
                                s += x; q += x * x; }
#pragma unroll
                        for (int o = 1; o < 16; o <<= 1) {
#pragma unroll
                            for (int j = 0; j < 4; ++j) { s[j] += __shfl_xor(s[j], o); q[j] += __shfl_xor(q[j], o); } }
                        if (fr == 0) { const int slot = (u.pm - 4) * 2 + wr; float* sp = stats + ((size_t)(u.pn * 256 + bj * 128 + wc * 32 + 8 * fq + 4 * n) * 8 + slot) * 2;
#pragma unroll
                            for (int j = 0; j < 4; ++j) *(f32x2*)(sp + 16 * j) = (f32x2){s[j], q[j]}; }
                        __builtin_amdgcn_sched_barrier(0); }
            }
#pragma unroll
            for (int ai = 0; ai < 2; ++ai)
#pragma unroll
                for (int m = 0; m < 4; ++m)
#pragma unroll
                    for (int bj = 0; bj < 2; ++bj) { f32x4 v0 = acc[ai][bj][m][0], v1 = acc[ai][bj][m][1];
                        if (is_vv) {
#pragma unroll
                            for (int j = 0; j < 4; ++j) { v0[j] = gelu_tanh_f(v0[j]); v1[j] = gelu_tanh_f(v1[j]); } }
                        u32x4 w; w.x = cvt_pk_bf16(v0.x, v0.y); w.y = cvt_pk_bf16(v0.z, v0.w); w.z = cvt_pk_bf16(v1.x, v1.y); w.w = cvt_pk_bf16(v1.z, v1.w);
                        *(u32x4*)(vtb + (size_t)ai * (128 * 128 * 32) + bj * (4 * 128 * 32) + m * (16 * 32)) = w; __builtin_amdgcn_sched_barrier(0); }
        }
    }
};
struct Sched1 {
    int G, c; const char* XN; const char* W1T; const char* W2T;
    __device__ __forceinline__ bool next(int i, Unit& u) const {
        const int L = i * G + c; if (L >= 1152) return false;
        u.e = 0; u.nvalid = 256; u.rbase = 0;
        if (L < 896) { pg8::tile_order(L, 32, 28, u.pm, u.pn); u.kind = 0; u.A = XN + (size_t)u.pm * 256 * D * 2; u.B = W1T + (size_t)u.pn * 256 * D * 2; }
        else { pg8::tile_order(L - 896, 8, 32, u.pm, u.pn); u.kind = 1; u.A = W2T + (size_t)u.pm * 256 * D * 2; u.B = XN + (size_t)u.pn * 256 * D * 2; }
        return true;
    }
};

__device__ __forceinline__ void attn_task(const bf16* QB, const bf16* KB, const bf16* VT, bf16* OA, int task, int lane) {
    const int bh = task >> 7, qb = task & 127, b = bh >> 3, h = bh & 7;
    const int c = lane & 31, hh = lane >> 5;
    const size_t tokbase = (size_t)b * SEQ;
    const int t0 = qb * 32;
    bf16x8 qf[8];
    { const bf16* qp = QB + ((size_t)bh * SEQ + t0 + c) * HD + 8 * hh;
#pragma unroll
      for (int s = 0; s < 8; ++s) qf[s] = *(const bf16x8*)(qp + 16 * s); }
    f32x16 o[4];
#pragma unroll
    for (int d = 0; d < 4; ++d)
#pragma unroll
        for (int r = 0; r < 16; ++r) o[d][r] = 0.f;
    float crun = 0.f;
    const int kap = 16 * ((c >> 2) & 1) + 4 * (c >> 3) + (c & 3);
    const bf16* kp0 = KB + ((size_t)bh * SEQ + kap) * HD + 8 * hh;
    const bf16* vp0 = VT + ((size_t)(b * 16 + h) * 128 * 128 + c) * 32 + 16 * hh;
    bf16x8 kf[8];
#pragma unroll
    for (int s = 0; s < 8; ++s) kf[s] = *(const bf16x8*)(kp0 + (size_t)t0 * HD + 16 * s);
    for (int j = qb; j >= 0; --j) {
        const int kbase = j * 32;
        bf16x8 vf[4][2];
#pragma unroll
        for (int d = 0; d < 4; ++d)
#pragma unroll
            for (int s = 0; s < 2; ++s) vf[d][s] = *(const bf16x8*)(vp0 + (size_t)j * 4096 + d * 1024 + 8 * s);
        f32x16 S;
#pragma unroll
        for (int r = 0; r < 16; ++r) S[r] = 0.f;
#pragma unroll
        for (int s = 0; s < 8; ++s) S = __builtin_amdgcn_mfma_f32_32x32x16_bf16(kf[s], qf[s], S, 0, 0, 0);
        if (j > 0) {
#pragma unroll
            for (int s = 0; s < 8; ++s) kf[s] = *(const bf16x8*)(kp0 + (size_t)(kbase - 32) * HD + 16 * s);
        }
        const int tq = t0 + c, k0 = kbase + 16 * hh;
        float Lk[16], run = 0.f;
        if (j == qb) {
#pragma unroll
            for (int r = 0; r < 16; ++r) { const float z = S[r]; const float sp = fmaxf(z, 0.f) + __builtin_amdgcn_logf(1.f + __builtin_amdgcn_exp2f(-fabsf(z)));
                const bool past = (k0 + r) < tq; Lk[r] = past ? -sp : 0.f; S[r] = past ? z : -1e30f; run += Lk[r]; }
        } else {
#pragma unroll
            for (int r = 0; r < 16; ++r) { const float z = S[r]; const float sp = fmaxf(z, 0.f) + __builtin_amdgcn_logf(1.f + __builtin_amdgcn_exp2f(-fabsf(z))); Lk[r] = -sp; run += Lk[r]; }
        }
        const float other = __shfl_xor(run, 32);
        float acc_after = crun + (hh == 0 ? other : 0.f);
        float w[16];
#pragma unroll
        for (int r = 15; r >= 0; --r) { w[r] = __builtin_amdgcn_exp2f((S[r] + Lk[r]) + acc_after); acc_after += Lk[r]; }
        crun += run + other;
        bf16x8 pf[2];
#pragma unroll
        for (int s = 0; s < 2; ++s) { u32x4 pk; pk.x = cvt_pk_bf16(w[8 * s + 0], w[8 * s + 1]); pk.y = cvt_pk_bf16(w[8 * s + 2], w[8 * s + 3]); pk.z = cvt_pk_bf16(w[8 * s + 4], w[8 * s + 5]); pk.w = cvt_pk_bf16(w[8 * s + 6], w[8 * s + 7]);
            pf[s] = __builtin_bit_cast(bf16x8, pk); }
#pragma unroll
        for (int d = 0; d < 4; ++d)
#pragma unroll
            for (int s = 0; s < 2; ++s) o[d] = __builtin_amdgcn_mfma_f32_32x32x16_bf16(vf[d][s], pf[s], o[d], 0, 0, 0);
        if (__all(crun < -151.f)) break;
    }
    bf16* op = OA + (tokbase + t0 + c) * AW + h * HD + 4 * hh;
#pragma unroll
    for (int d = 0; d < 4; ++d)
#pragma unroll
        for (int g = 0; g < 4; ++g) { u32x2 pk; pk.x = cvt_pk_bf16(o[d][4 * g + 0], o[d][4 * g + 1]); pk.y = cvt_pk_bf16(o[d][4 * g + 2], o[d][4 * g + 3]);
            *(u32x2*)(op + d * 32 + 8 * g) = pk; }
}

__device__ __forceinline__ void sgu_task(const Args& a, const bf16* PB, const bf16* VT, const float* stats, bf16* OB, int idx, int lane) {
    const int ib = idx & 3, g = (idx >> 2) & 7, n = idx >> 5;
    const int c = lane & 31, hh = lane >> 5;
    const float* wsp = a.in[6] + ((size_t)g * 128 + ib * 32 + c) * 128 + 8 * hh;
    const bf16* vvp = VT + (((size_t)((n >> 5) * 16 + 8 + g) * 128 + (n & 31) * 4) * 128 + c) * 32 + 8 * hh;
    f32x16 acc[4];
#pragma unroll
    for (int d = 0; d < 4; ++d)
#pragma unroll
        for (int r = 0; r < 16; ++r) acc[d][r] = 0.f;
    const int nks = ib < 2 ? 4 : 8;
    for (int ks = 0; ks < nks; ++ks) {
        float mu[8], rs[8];
        { const f32x4 st = *(const f32x4*)(stats + ((size_t)(n * 128 + 16 * ks + (lane >> 2)) * 8 + 2 * (lane & 3)) * 2);
          float S = st.x + st.z, Q = st.y + st.w;
          S += __shfl_xor(S, 1); Q += __shfl_xor(Q, 1); S += __shfl_xor(S, 2); Q += __shfl_xor(Q, 2);
          const float m_ = S * (1.f / SW), r_ = rsqrtf(fmaxf(Q * (1.f / SW) - m_ * m_, 0.f) + EPS);
#pragma unroll
          for (int j = 0; j < 8; ++j) { mu[j] = __shfl(m_, 4 * (8 * hh + j)); rs[j] = __shfl(r_, 4 * (8 * hh + j)); } }
        const f32x4 w0 = *(const f32x4*)(wsp + 16 * ks), w1 = *(const f32x4*)(wsp + 16 * ks + 4);
        u32x4 bw; bw.x = cvt_pk_bf16(w0.x, w0.y); bw.y = cvt_pk_bf16(w0.z, w0.w); bw.z = cvt_pk_bf16(w1.x, w1.y); bw.w = cvt_pk_bf16(w1.z, w1.w);
        const bf16x8 bfrag = __builtin_bit_cast(bf16x8, bw);
#pragma unroll
        for (int cbk = 0; cbk < 4; ++cbk) {
            const u32x4 raw = *(const u32x4*)(vvp + (size_t)(ks >> 1) * 4096 + cbk * 1024 + 16 * (ks & 1));
            u32x4 nv;
            nv.x = cvt_pk_bf16((bf_lo(raw.x) - mu[0]) * rs[0], (bf_hi(raw.x) - mu[1]) * rs[1]);
            nv.y = cvt_pk_bf16((bf_lo(raw.y) - mu[2]) * rs[2], (bf_hi(raw.y) - mu[3]) * rs[3]);
            nv.z = cvt_pk_bf16((bf_lo(raw.z) - mu[4]) * rs[4], (bf_hi(raw.z) - mu[5]) * rs[5]);
            nv.w = cvt_pk_bf16((bf_lo(raw.w) - mu[6]) * rs[6], (bf_hi(raw.w) - mu[7]) * rs[7]);
            acc[cbk] = __builtin_amdgcn_mfma_f32_32x32x16_bf16(__builtin_bit_cast(bf16x8, nv), bfrag, acc[cbk], 0, 0, 0);
        }
    }
    const int tok = n * 128 + ib * 32 + c;
    const float bsp = a.in[7][g * 128 + ib * 32 + c];
    const float* gam = a.in[5] + g * 128 + 4 * hh;
    const bf16* up = PB + (size_t)tok * N1 + C_U + g * 128 + 4 * hh;
    bf16* op = OB + (size_t)tok * SW + g * 128 + 4 * hh;
#pragma unroll
    for (int d = 0; d < 4; ++d)
#pragma unroll
        for (int gg = 0; gg < 4; ++gg) { const f32x4 gm = *(const f32x4*)(gam + d * 32 + 8 * gg); const u32x2 uu = *(const u32x2*)(up + d * 32 + 8 * gg);
            const float r0 = bf_lo(uu.x) * (gm.x * acc[d][4 * gg + 0] + bsp), r1 = bf_hi(uu.x) * (gm.y * acc[d][4 * gg + 1] + bsp);
            const float r2 = bf_lo(uu.y) * (gm.z * acc[d][4 * gg + 2] + bsp), r3 = bf_hi(uu.y) * (gm.w * acc[d][4 * gg + 3] + bsp);
            u32x2 pk; pk.x = cvt_pk_bf16(r0, r1); pk.y = cvt_pk_bf16(r2, r3); *(u32x2*)(op + d * 32 + 8 * gg) = pk; }
}

struct Epi3 {
    static constexpr bool PERM = true, CHAIN = true;
    const bf16* PB; bf16* Y;
    __device__ __forceinline__ void operator()(f32x4 (&acc)[2][2][4][2], const Unit& u, int wr, int wc, int fr, int fq) const {
        const int row0 = u.pm * 256 + wr * 64 + fr, col0 = u.pn * 256 + wc * 32 + 8 * fq;
        const bf16* gpa = PB + (size_t)row0 * N1 + C_GA + col0; const bf16* gpb = PB + (size_t)row0 * N1 + C_GB + col0;
#pragma unroll
        for (int ai = 0; ai < 2; ++ai)
#pragma unroll
            for (int m = 0; m < 4; ++m)
#pragma unroll
                for (int bj = 0; bj < 2; ++bj) { const size_t ro = (size_t)(ai * 128 + m * 16);
                    const u32x4 gb = *(const u32x4*)(gpb + ro * N1 + bj * 128);
                    f32x4 b0, b1;
                    b0.x = fmaxf(bf_lo(gb.x), 1e-20f); b0.y = fmaxf(bf_hi(gb.x), 1e-20f); b0.z = fmaxf(bf_lo(gb.y), 1e-20f); b0.w = fmaxf(bf_hi(gb.y), 1e-20f);
                    b1.x = fmaxf(bf_lo(gb.z), 1e-20f); b1.y = fmaxf(bf_hi(gb.z), 1e-20f); b1.z = fmaxf(bf_lo(gb.w), 1e-20f); b1.w = fmaxf(bf_hi(gb.w), 1e-20f);
                    if (u.kind == 0) {
                        const u32x4 ga = *(const u32x4*)(gpa + ro * N1 + bj * 128);
                        f32x4 r0, r1;
                        r0.x = bf_lo(ga.x) * fast_rcp(b0.x); r0.y = bf_hi(ga.x) * fast_rcp(b0.y); r0.z = bf_lo(ga.y) * fast_rcp(b0.z); r0.w = bf_hi(ga.y) * fast_rcp(b0.w);
                        r1.x = bf_lo(ga.z) * fast_rcp(b1.x); r1.y = bf_hi(ga.z) * fast_rcp(b1.y); r1.z = bf_lo(ga.w) * fast_rcp(b1.z); r1.w = bf_hi(ga.w) * fast_rcp(b1.w);
                        acc[ai][bj][m][0] *= r0; acc[ai][bj][m][1] *= r1;
                    } else {
                        const f32x4 v0 = acc[ai][bj][m][0] * b0, v1 = acc[ai][bj][m][1] * b1;
                        u32x4 w; w.x = cvt_pk_bf16(v0.x, v0.y); w.y = cvt_pk_bf16(v0.z, v0.w); w.z = cvt_pk_bf16(v1.x, v1.y); w.w = cvt_pk_bf16(v1.z, v1.w);
                        *(u32x4*)(Y + (size_t)(row0 + ro) * D + col0 + bj * 128) = w; } }
    }
};
struct Sched3 {
    int G, c; const char* OA; const char* OB; const char* WAT; const char* WBT;
    __device__ __forceinline__ bool next(int i, Unit& u) const {
        const int tile = c + (i >> 1) * G; if (tile >= 256) return false;
        pg8::tile_order(tile, 32, 8, u.pm, u.pn); u.kind = i & 1; u.e = 0; u.nvalid = 256; u.rbase = 0;
        u.A = (u.kind == 0 ? OA : OB) + (size_t)u.pm * 256 * AW * 2; u.B = (u.kind == 0 ? WAT : WBT) + (size_t)u.pn * 256 * AW * 2;
        return true;
    }
};

struct Epi4 {
    static constexpr bool PERM = false, CHAIN = false;
    const float* X; float* OUT;
    __device__ __forceinline__ void operator()(f32x4 (&acc)[2][2][4][2], const Unit& u, int wr, int wc, int fr, int fq) const {
        const size_t o0 = (size_t)(u.pm * 256 + wr * 64 + fr) * D + u.pn * 256 + wc * 32 + 4 * fq;
#pragma unroll
        for (int ai = 0; ai < 2; ++ai)
#pragma unroll
            for (int m = 0; m < 4; ++m)
#pragma unroll
                for (int bj = 0; bj < 2; ++bj)
#pragma unroll
                    for (int n = 0; n < 2; ++n) { const size_t o = o0 + (size_t)(ai * 128 + m * 16) * D + bj * 128 + n * 16;
                        *(f32x4*)(OUT + o) = *(const f32x4*)(X + o) + acc[ai][bj][m][n]; }
    }
};
struct Sched4 {
    int G, c; const char* Y; const char* WOT;
    __device__ __forceinline__ bool next(int i, Unit& u) const {
        const int tile = c + i * G; if (tile >= 256) return false;
        pg8::tile_order(tile, 32, 8, u.pm, u.pn); u.kind = 0; u.e = 0; u.nvalid = 256; u.rbase = 0;
        u.A = Y + (size_t)u.pm * 256 * D * 2; u.B = WOT + (size_t)u.pn * 256 * D * 2;
        return true;
    }
};

template <int PH> struct SchedMoE {
    int G, vcu; const volatile LAS unsigned* misc; const char* Abase; const char* Bbase; int ncu;
    __device__ __forceinline__ bool next(int i, Unit& u) const {
        const volatile LAS unsigned* us = misc + (PH == 6 ? MW_US6 : MW_US7);
        const int total = __builtin_amdgcn_readfirstlane((int)us[NE]);
        int L;
        if ((G & 255) == 0) { const int nx = G >> 5, chunk = (total + nx - 1) / nx, x = vcu >> 5, j = vcu & 31;
            if (ncu == 32) { L = x * chunk + i * 32 + j; if (L >= (x + 1) * chunk) return false; }
            else {
                int len = total - x * chunk; len = len < 0 ? 0 : (len > chunk ? chunk : len);
                const int R = len / ncu - MOE_TAIL_TEST;
                if (j < ncu) { if (i >= R) return false; L = x * chunk + i * ncu + j; }
                else { const int p = i * (32 - ncu) + (j - ncu); if (p >= len - R * ncu) return false; L = x * chunk + R * ncu + p; } } }
        else L = i * G + vcu;
        if (L >= total) return false;
        const int ln = (int)(threadIdx.x & 63);
        const unsigned mine = us[ln < NE ? ln : NE];
        const unsigned long long mk = __ballot((unsigned)L >= mine);
        const int e = __builtin_amdgcn_readfirstlane(63 - __builtin_clzll(mk | 1ull));
        const int ne = __builtin_amdgcn_readfirstlane((int)misc[MW_CNT + e]), off = __builtin_amdgcn_readfirstlane((int)misc[MW_OFF + e]);
        const int st = __builtin_amdgcn_readfirstlane((int)us[e]);
        const int mte = (ne + 255) >> 8, rem = L - st, mt = rem % mte, ntl = rem / mte;
        u.kind = 0; u.pm = mt; u.pn = ntl; u.e = e; u.nvalid = ne - mt * 256; u.rbase = off + mt * 256;
        if (PH == 6) { u.A = Abase + ((size_t)e * T + (size_t)mt * 256) * D; u.B = Bbase + ((size_t)e * 2 * DE + (size_t)ntl * 256) * D; }
        else { u.A = Abase + (size_t)u.rbase * DE; u.B = Bbase + ((size_t)e * D + (size_t)ntl * 256) * DE; }
        return true;
    }
};
__device__ __forceinline__ f32x2 swiglu_pk(f32x2 g, f32x2 u) {
    const f32x2 ga = __builtin_elementwise_min(g, (f32x2){7.f, 7.f});
    const f32x2 ua = __builtin_elementwise_min(__builtin_elementwise_max(u, (f32x2){-7.f, -7.f}), (f32x2){7.f, 7.f});
    const f32x2 t = ga * (-1.702f * 1.4426950408889634f);
    f32x2 d; d.x = __builtin_amdgcn_exp2f(t.x); d.y = __builtin_amdgcn_exp2f(t.y); d = d + 1.0f;
    f32x2 r; r.x = __builtin_amdgcn_rcpf(d.x); r.y = __builtin_amdgcn_rcpf(d.y);
    return (ga * r) * (ua * SC_A8 + SC_A8);
}
__device__ __forceinline__ unsigned pk4_fp8_nc(float a, float b, float c, float d) { int r = 0; r = __builtin_amdgcn_cvt_pk_fp8_f32(a, b, r, false); r = __builtin_amdgcn_cvt_pk_fp8_f32(c, d, r, true); return (unsigned)r; }
struct Epi6 {
    static constexpr bool PERM = true, CHAIN = false;
    const float* bup; unsigned char* ACT;
    __device__ __forceinline__ void operator()(f32x4 (&acc)[2][2][4][2], const Unit& u, int wr, int wc, int fr, int fq) const {
        const int cc = u.pn * 128 + wc * 32 + 8 * fq;
        const float* bg = bup + (size_t)u.e * 2 * DE + cc;
        const f32x4 bg0 = *(const f32x4*)bg, bg1 = *(const f32x4*)(bg + 4), bu0 = *(const f32x4*)(bg + DE), bu1 = *(const f32x4*)(bg + DE + 4);
        constexpr float ds = 1.f / (SC_W8 * SC_X8);
#pragma unroll
        for (int ai = 0; ai < 2; ++ai)
#pragma unroll
            for (int m = 0; m < 4; ++m) { const int row = ai * 128 + wr * 64 + m * 16 + fr;
                const f32x4 g0 = acc[ai][0][m][0] * ds + bg0, g1 = acc[ai][0][m][1] * ds + bg1, u0 = acc[ai][1][m][0] * ds + bu0, u1 = acc[ai][1][m][1] * ds + bu1;
                const f32x2 a0 = swiglu_pk((f32x2){g0.x, g0.y}, (f32x2){u0.x, u0.y}), a1 = swiglu_pk((f32x2){g0.z, g0.w}, (f32x2){u0.z, u0.w});
                const f32x2 a2 = swiglu_pk((f32x2){g1.x, g1.y}, (f32x2){u1.x, u1.y}), a3 = swiglu_pk((f32x2){g1.z, g1.w}, (f32x2){u1.z, u1.w});
                if (row < u.nvalid) { u32x2 w; w.x = pk4_fp8_nc(a0.x, a0.y, a1.x, a1.y); w.y = pk4_fp8_nc(a2.x, a2.y, a3.x, a3.y);
                    *(u32x2*)(ACT + (size_t)(u.rbase + row) * DE + cc) = w; } }
    }
};
struct Epi7 {
    static constexpr bool PERM = true, CHAIN = false;
    const float* bdn; bf16* YM;
    __device__ __forceinline__ void operator()(f32x4 (&acc)[2][2][4][2], const Unit& u, int wr, int wc, int fr, int fq) const {
        const int cc = u.pn * 256 + wc * 32 + 8 * fq;
        const float* bp = bdn + (size_t)u.e * D + cc;
        f32x4 bb[2][2];
#pragma unroll
        for (int bj = 0; bj < 2; ++bj) { bb[bj][0] = *(const f32x4*)(bp + bj * 128); bb[bj][1] = *(const f32x4*)(bp + bj * 128 + 4); }
#pragma unroll
        for (int ai = 0; ai < 2; ++ai)
#pragma unroll
            for (int m = 0; m < 4; ++m) { const int row = ai * 128 + wr * 64 + m * 16 + fr;
                if (row < u.nvalid) {
#pragma unroll
                    for (int bj = 0; bj < 2; ++bj) { constexpr float ds = 1.f / (SC_W8 * SC_A8); const f32x4 v0 = acc[ai][bj][m][0] * ds + bb[bj][0], v1 = acc[ai][bj][m][1] * ds + bb[bj][1];
                        u32x4 w; w.x = cvt_pk_bf16(v0.x, v0.y); w.y = cvt_pk_bf16(v0.z, v0.w); w.z = cvt_pk_bf16(v1.x, v1.y); w.w = cvt_pk_bf16(v1.z, v1.w);
                        *(u32x4*)(YM + (size_t)(u.rbase + row) * D + cc + bj * 128) = w; } } }
    }
};

__global__ void __launch_bounds__(NWAVES * 64, 2) fwd(Args a) {
    extern __shared__ __attribute__((aligned(16))) unsigned char lds_raw[];
    LAS unsigned char* lds = (LAS unsigned char*)lds_raw;
    volatile LAS unsigned* MISC = (volatile LAS unsigned*)(lds + MISC_OFF);
    const int tid = threadIdx.x, lane = tid & 63, wave = __builtin_amdgcn_readfirstlane(tid >> 6);
    const int G = gridDim.x, bx = blockIdx.x;
    const int vcu = (G % 8 == 0) ? (bx % 8) * (G / 8) + bx / 8 : bx;
    unsigned char* ws = a.ws;
    unsigned* ctl = (unsigned*)(ws + WS_CTL);
    for (int u = tid; u < 512; u += NWAVES * 64) MISC[u] = 0u;
    __syncthreads();
    XcdBarrier bar = xcd_barrier_post(ctl + CW_BAR, MISC + MW_BAR);
    const int gw = vcu * NWAVES + wave, NGW = G * NWAVES;

    bf16* PB = (bf16*)(ws + WS_PB); bf16* VT = (bf16*)(ws + WS_VT); bf16* OA = (bf16*)(ws + WS_OA); bf16* OB = (bf16*)(ws + WS_OB);
    float* stats = (float*)(ws + WS_STATS);
    int* tok_e = (int*)(ws + WS_ROUTE); int* tok_rank = tok_e + T * TOPK; float* tok_gate = (float*)(tok_rank + T * TOPK);

    if (PH_ON(0)) p0_prologue(a, lds, vcu, G, wave, lane);
    xcd_barrier(bar);

    if (PH_ON(1)) {
        int cbeg, cend;
        constexpr int NUP = NE * I_UP1;
        const bool split6 = (G == 256);
        const int CONV1 = split6 ? NUP : MOE_ITEMS;
        if (G == 256) { constexpr int S5 = 220, S4 = 292; static_assert(128 * (S5 + S4) == NUP, "conversion shares");
            cbeg = bx < 128 ? bx * S5 : 128 * S5 + (bx - 128) * S4; cend = cbeg + (bx < 128 ? S5 : S4); }
        else { const int per = (CONV1 + G - 1) / G; cbeg = bx * per; cend = cbeg + per < CONV1 ? cbeg + per : CONV1; if (cbeg > CONV1) cbeg = CONV1; }
        const bool conv_first = ((bx >> 3) & 1) != 0;
        if (conv_first) { moe_convert(a, lds, cbeg, cend, wave, lane); __syncthreads(); }
        pg8::Gemm g{D, D, D};
        Sched1 S{G, bx, (const char*)(ws + WS_XN), (const char*)(ws + WS_W1T), (const char*)(ws + WS_W2T)};
        Epi1 E{PB, VT, (bf16*)(ws + WS_QB), (bf16*)(ws + WS_KB), stats, a.in[3], a.in[4], (LAS float*)(lds + SCR_OFF)};
        pg8::gemm_phase<Epi1, Sched1>(lds, g, S, E);
        if (!conv_first) moe_convert(a, lds, cbeg, cend, wave, lane);
    }
    xcd_barrier(bar);

    if (PH_ON(2)) for (int task = gw; task < 4096; task += NGW) {
        if (task < 2048) attn_task((const bf16*)(ws + WS_QB), (const bf16*)(ws + WS_KB), VT, OA, task, lane);
        else sgu_task(a, PB, VT, stats, OB, task - 2048, lane);
    }
    xcd_barrier(bar);

    if (PH_ON(3)) {
        pg8::Gemm g{AW, AW, AW};
        Sched3 S{G, bx, (const char*)(ws + WS_OA), (const char*)(ws + WS_OB), (const char*)(ws + WS_WAT), (const char*)(ws + WS_WBT)};
        Epi3 E{PB, (bf16*)(ws + WS_Y)};
        pg8::gemm_phase<Epi3, Sched3>(lds, g, S, E);
    }
    xcd_barrier(bar);

    if (PH_ON(4)) {
        pg8::Gemm g{D, D, D};
        Sched4 S{G, bx, (const char*)(ws + WS_Y), (const char*)(ws + WS_WOT)};
        Epi4 E{a.in[0], a.out};
        pg8::gemm_phase<Epi4, Sched4>(lds, g, S, E);
    }
#if DBG_STAGE >= 5
    xcd_barrier(bar);

    if (PH_ON(5)) {
        LAS float* red = (LAS float*)lds;
        LAS float* ssqp = (LAS float*)(lds + 8 * 1056 * 4);
        LAS float* rinfo = ssqp + 256;
        LAS unsigned* lcnt = (LAS unsigned*)(rinfo + 384); LAS unsigned* lbase = lcnt + 32;
        const float* g2 = a.in[11]; const float* wrt = a.in[12]; const float* brt = a.in[13];
        for (int rb = bx; rb < T / 32; rb += G) {
            const int row0 = rb * 32, i = lane & 31, hk = lane >> 5, kb = wave * 256 + hk * 128;
            if (tid < 32) lcnt[tid] = 0u;
            const float* xr = a.out + (size_t)(row0 + i) * D + kb;
            f32x16 acc;
#pragma unroll
            for (int r = 0; r < 16; ++r) acc[r] = 0.f;
            float ssq = 0.f;
            for (int ch = 0; ch < 4; ++ch) {
                f32x4 xv[8];
#pragma unroll
                for (int q = 0; q < 8; ++q) xv[q] = *(const f32x4*)(xr + ch * 32 + q * 4);
#pragma unroll
                for (int q = 0; q < 8; ++q)
#pragma unroll
                    for (int jj = 0; jj < 4; ++jj) { const int k = kb + ch * 32 + q * 4 + jj; const float x = xv[q][jj];
                        const float bw = wrt[(size_t)k * NE + i] * g2[k];
                        acc = __builtin_amdgcn_mfma_f32_32x32x2f32(x, bw, acc, 0, 0, 0); ssq += x * x; }
            }
            ssq += __shfl_xor(ssq, 32);
            if (lane < 32) ssqp[wave * 32 + i] = ssq;
#pragma unroll
            for (int r = 0; r < 16; ++r) red[wave * 1056 + i * 33 + (r & 3) + 8 * (r >> 2) + 4 * hk] = acc[r];
            LDS_WAIT(); __syncthreads();
            if (tid < 32) {
                float sq = 0.f;
#pragma unroll
                for (int w = 0; w < 8; ++w) sq += ssqp[w * 32 + tid];
                const float rstd = rsqrtf(sq * (1.f / D) + EPS);
                float v0 = -3.0e38f, v1 = -3.0e38f, v2 = -3.0e38f, v3 = -3.0e38f; int i0 = 0, i1 = 0, i2 = 0, i3 = 0;
                for (int e = 0; e < NE; ++e) { float v = 0.f;
#pragma unroll
                    for (int w = 0; w < 8; ++w) v += red[w * 1056 + e * 33 + tid];
                    const float x = v * rstd + brt[e];
                    if (x > v3) { if (x > v2) { v3 = v2; i3 = i2; if (x > v1) { v2 = v1; i2 = i1; if (x > v0) { v1 = v0; i1 = i0; v0 = x; i0 = e; } else { v1 = x; i1 = e; } } else { v2 = x; i2 = e; } } else { v3 = x; i3 = e; } } }
                const float p1 = __expf(v1 - v0), p2 = __expf(v2 - v0), p3 = __expf(v3 - v0), inv = 1.f / (1.f + p1 + p2 + p3);
                const int t = row0 + tid;
                const unsigned l0 = __hip_atomic_fetch_add(lcnt + i0, 1u, __ATOMIC_RELAXED, __HIP_MEMORY_SCOPE_WORKGROUP), l1 = __hip_atomic_fetch_add(lcnt + i1, 1u, __ATOMIC_RELAXED, __HIP_MEMORY_SCOPE_WORKGROUP);
                const unsigned l2 = __hip_atomic_fetch_add(lcnt + i2, 1u, __ATOMIC_RELAXED, __HIP_MEMORY_SCOPE_WORKGROUP), l3 = __hip_atomic_fetch_add(lcnt + i3, 1u, __ATOMIC_RELAXED, __HIP_MEMORY_SCOPE_WORKGROUP);
                LDS_WAIT(); asm volatile("" ::: "memory");
                { const unsigned ne_ = lcnt[tid]; unsigned base_ = 0u; if (ne_) base_ = atomicAdd(ctl + CW_CNT + 64 * tid, ne_); lbase[tid] = base_; }
                LDS_WAIT(); asm volatile("" ::: "memory");
                const int r0 = (int)(lbase[i0] + l0), r1 = (int)(lbase[i1] + l1), r2 = (int)(lbase[i2] + l2), r3 = (int)(lbase[i3] + l3);
                tok_e[t * 4 + 0] = i0; tok_e[t * 4 + 1] = i1; tok_e[t * 4 + 2] = i2; tok_e[t * 4 + 3] = i3;
                tok_rank[t * 4 + 0] = r0; tok_rank[t * 4 + 1] = r1; tok_rank[t * 4 + 2] = r2; tok_rank[t * 4 + 3] = r3;
                tok_gate[t * 4 + 0] = inv; tok_gate[t * 4 + 1] = p1 * inv; tok_gate[t * 4 + 2] = p2 * inv; tok_gate[t * 4 + 3] = p3 * inv;
                LAS float* ri = rinfo + tid * 12; ri[0] = rstd;
                ri[1] = __int_as_float(i0); ri[2] = __int_as_float(i1); ri[3] = __int_as_float(i2); ri[4] = __int_as_float(i3);
                ri[5] = __int_as_float(r0); ri[6] = __int_as_float(r1); ri[7] = __int_as_float(r2); ri[8] = __int_as_float(r3);
            }
            LDS_WAIT(); __syncthreads();
            unsigned char* XG = ws + WS_XG;
            for (int rr = 0; rr < 4; ++rr) { const int il = wave * 4 + rr; const LAS float* ri = rinfo + il * 12;
                const float rstd = ri[0];
                size_t dsto[4];
#pragma unroll
                for (int k = 0; k < 4; ++k) dsto[k] = ((size_t)__float_as_int(ri[1 + k]) * T + (size_t)__float_as_int(ri[5 + k])) * D;
                const f32x4* hr = (const f32x4*)(a.out + (size_t)(row0 + il) * D) + lane;
#pragma unroll
                for (int j = 0; j < 8; ++j) { const f32x4 v = hr[64 * j]; const f32x4 gg = *((const f32x4*)g2 + lane + 64 * j);
                    const float rs8 = rstd * SC_X8; const unsigned o = pk4_fp8(v.x * rs8 * gg.x, v.y * rs8 * gg.y, v.z * rs8 * gg.z, v.w * rs8 * gg.w);
#pragma unroll
                    for (int k = 0; k < 4; ++k) *((unsigned*)(XG + dsto[k]) + lane + 64 * j) = o; } }
            LDS_WAIT(); __syncthreads();
        }
    }
    xcd_barrier(bar);

    if (tid < NE) MISC[MW_CNT + tid] = __hip_atomic_load(ctl + CW_CNT + 64 * tid, __ATOMIC_RELAXED, __HIP_MEMORY_SCOPE_AGENT);
    LDS_WAIT(); __syncthreads();
    if (tid < 64) {
        const unsigned n = tid < NE ? MISC[MW_CNT + tid] : 0u, mt = (n + 255u) >> 8;
        unsigned so = n, su = mt;
#pragma unroll
        for (int o = 1; o < 32; o <<= 1) { const unsigned a_ = __shfl_up(so, o), b_ = __shfl_up(su, o); if ((tid & 63) >= o) { so += a_; su += b_; } }
        if (tid < NE) { MISC[MW_OFF + tid] = so - n; MISC[MW_US6 + tid] = (su - mt) * 16u; MISC[MW_US7 + tid] = (su - mt) * 8u; }
        if (tid == NE - 1) { MISC[MW_US6 + NE] = su * 16u; MISC[MW_US7 + NE] = su * 8u; }
    }
    LDS_WAIT(); __syncthreads();

    if (PH_ON(6)) {
        pg8::Gemm g{D / 2, D / 2, D / 2};
        constexpr int NSTREAM = 8;
        const bool split = (G == 256);
        SchedMoE<6> S{G, vcu, MISC, (const char*)(ws + WS_XG), (const char*)(ws + WS_WUT), split ? 32 - NSTREAM : 32};
        Epi6 E{a.in[15], ws + WS_ACT};
        if (split && (vcu & 31) >= 32 - NSTREAM) { constexpr int NUP6 = NE * I_UP1, NDN6 = NE * I_DN1, PER = NDN6 / (8 * NSTREAM); static_assert(PER * 8 * NSTREAM == NDN6, "w_down shares");
            const int sidx = (vcu >> 5) * NSTREAM + ((vcu & 31) - (32 - NSTREAM)); moe_convert(a, lds, NUP6 + sidx * PER, NUP6 + (sidx + 1) * PER, wave, lane); __syncthreads(); }
        pg8::gemm_phase<Epi6, SchedMoE<6>, true>(lds, g, S, E);
    }
    xcd_barrier(bar);

    if (PH_ON(7)) {
        pg8::Gemm g{DE / 2, DE / 2, DE / 2};
        SchedMoE<7> S{G, vcu, MISC, (const char*)(ws + WS_ACT), (const char*)(ws + WS_WDT), 32};
        Epi7 E{a.in[17], (bf16*)(ws + WS_YM)};
        pg8::gemm_phase<Epi7, SchedMoE<7>, true>(lds, g, S, E);
    }
    xcd_barrier(bar);

    if (PH_ON(8)) {
        const bf16* YM = (const bf16*)(ws + WS_YM);
        for (int t = gw; t < T; t += NGW) {
            size_t pos[4]; float gt[4];
#pragma unroll
            for (int k = 0; k < 4; ++k) { const int e = tok_e[t * 4 + k], rk = tok_rank[t * 4 + k]; gt[k] = tok_gate[t * 4 + k]; pos[k] = ((size_t)MISC[MW_OFF + e] + (size_t)rk) * D; }
            f32x4* orow = (f32x4*)(a.out + (size_t)t * D) + lane;
#pragma unroll
            for (int j = 0; j < 8; ++j) { f32x4 o = orow[64 * j];
#pragma unroll
                for (int k = 0; k < 4; ++k) { const u32x2 y = __builtin_nontemporal_load((const u32x2*)(YM + pos[k]) + lane + 64 * j);
                    o.x += gt[k] * bf_lo(y.x); o.y += gt[k] * bf_hi(y.x); o.z += gt[k] * bf_lo(y.y); o.w += gt[k] * bf_hi(y.y); }
                __builtin_nontemporal_store(o, orow + 64 * j); }
        }
    }
#endif
}

extern "C" void kernel_launch(void* const* d_in, const int* in_sizes, int n_in, void* d_out, int out_size, void* d_ws, size_t ws_size, hipStream_t stream) {
    static int grid = 0;
    if (grid == 0) {
        if (n_in != 18 || out_size != T * D || ws_size < WS_END) { fprintf(stderr, "kernel_launch: unexpected shapes (n_in %d, out %d, ws %zu)\n", n_in, out_size, ws_size); grid = -1; return; }
        int dev = 0, cus = 0, per_cu = 0;
        if (hipGetDevice(&dev) != hipSuccess || hipDeviceGetAttribute(&cus, hipDeviceAttributeMultiprocessorCount, dev) != hipSuccess) { grid = -1; return; }
        if (hipFuncSetAttribute((const void*)fwd, hipFuncAttributeMaxDynamicSharedMemorySize, LDS_BYTES) != hipSuccess) { fprintf(stderr, "kernel_launch: hipFuncSetAttribute failed\n"); grid = -1; return; }
        if (hipOccupancyMaxActiveBlocksPerMultiprocessor(&per_cu, (const void*)fwd, NWAVES * 64, LDS_BYTES) != hipSuccess || per_cu < 1) { fprintf(stderr, "kernel_launch: occupancy query says %d\n", per_cu); }
        (void)hipGetLastError();
        grid = cus;
        if (per_cu < 1) grid = -1;
    }
    if (grid < 0) return;
    if (hipMemsetAsync((char*)d_ws + WS_CTL, 0, CTL_ZERO_BYTES, stream) != hipSuccess) return;
    Args a{};
    for (int i = 0; i < 18; ++i) a.in[i] = (const float*)d_in[i];
    a.out = (float*)d_out; a.ws = (unsigned char*)d_ws;
    hipLaunchKernelGGL(fwd, dim3(grid), dim3(NWAVES * 64), LDS_BYTES, stream, a);
}
```

```cpp
#ifndef MOE_TAIL_TEST
#define MOE_TAIL_TEST 0
#endif
#include <hip/hip_runtime.h>
#include <cstdio>
#include <cstdint>

#ifndef DBG_STAGE
#define DBG_STAGE 99
#endif
#ifndef PH_MASK
#define PH_MASK 0x1ff
#endif
#define PH_ON(p) ((PH_MASK >> (p)) & 1)

#define LAS __attribute__((address_space(3)))
#define GAS __attribute__((address_space(1)))
typedef unsigned short bf16;
typedef short bf16x8 __attribute__((ext_vector_type(8)));
typedef float f32x4 __attribute__((ext_vector_type(4)));
typedef float f32x2 __attribute__((ext_vector_type(2)));
typedef float f32x16 __attribute__((ext_vector_type(16)));
typedef unsigned u32x4 __attribute__((ext_vector_type(4)));
typedef unsigned u32x2 __attribute__((ext_vector_type(2)));
typedef int i32x8 __attribute__((ext_vector_type(8)));
typedef int i32x4 __attribute__((ext_vector_type(4)));

constexpr int T = 8192, D = 2048, SEQ = 4096, NH = 8, HD = 128, AW = 1024, SW = 1024, PW = 9216, NE = 32, TOPK = 4, DE = 2048;
constexpr int C_GB_END_BF = 5120;
constexpr int N1 = 7168;
constexpr int C_Q = 0, C_K = 1024, C_U = 2048, C_GA = 3072, C_GB = 5120;
constexpr float EPS = 1e-6f;
constexpr int NWAVES = 8;

constexpr size_t MiB = 1u << 20;
constexpr size_t WS_CTL = 0, CTL_ZERO_BYTES = 64 * 1024;
constexpr size_t WS_W1T = 2 * MiB;
constexpr size_t WS_W2T = 32 * MiB;
constexpr size_t WS_WAT = 40 * MiB;
constexpr size_t WS_WBT = 44 * MiB;
constexpr size_t WS_WOT = 48 * MiB;
constexpr size_t WS_WG8 = 56 * MiB;
constexpr size_t WS_XN = 64 * MiB;
constexpr size_t WS_PB = 96 * MiB;
constexpr size_t WS_VT = 208 * MiB;
constexpr size_t WS_OA = 240 * MiB;
constexpr size_t WS_OB = 256 * MiB;
constexpr size_t WS_QB = 272 * MiB;
constexpr size_t WS_KB = 288 * MiB;
constexpr size_t WS_XN8 = 304 * MiB;
constexpr size_t WS_Y = 336 * MiB;
constexpr size_t WS_ROUTE = 368 * MiB;
constexpr size_t WS_STATS = 369 * MiB;
constexpr size_t WS_ACT = 370 * MiB;
constexpr size_t WS_YM = 500 * MiB;
constexpr size_t WS_WUT = 640 * MiB;
constexpr size_t WS_WDT = 1152 * MiB;
constexpr size_t WS_XG = 1408 * MiB;
constexpr size_t WS_END = 2432 * MiB;
constexpr int CW_BAR = 4096;
constexpr int CW_CNT = 8192;
constexpr int CW_STATS = 16384;

constexpr int RING_BYTES = 131072;
constexpr int SCR_OFF = RING_BYTES;
constexpr int MISC_OFF = RING_BYTES + 8192;
constexpr int LDS_BYTES = RING_BYTES + 8192 + 2048;
constexpr int MW_BAR = 8;
constexpr int MW_CNT = 32, MW_OFF = 64, MW_US6 = 96, MW_US7 = 160;

#define LDS_WAIT() asm volatile("s_waitcnt lgkmcnt(0)" ::: "memory")
#define VM_WAIT() asm volatile("s_waitcnt vmcnt(0)" ::: "memory")

__device__ __forceinline__ unsigned cvt_pk_bf16(float lo, float hi) { unsigned r; asm volatile("v_cvt_pk_bf16_f32 %0, %1, %2" : "=v"(r) : "v"(lo), "v"(hi)); return r; }
__device__ __forceinline__ unsigned pk4_fp8(float a, float b, float c, float d) {
    a = __builtin_amdgcn_fmed3f(a, -448.f, 448.f); b = __builtin_amdgcn_fmed3f(b, -448.f, 448.f); c = __builtin_amdgcn_fmed3f(c, -448.f, 448.f); d = __builtin_amdgcn_fmed3f(d, -448.f, 448.f);
    int r = 0; r = __builtin_amdgcn_cvt_pk_fp8_f32(a, b, r, false); r = __builtin_amdgcn_cvt_pk_fp8_f32(c, d, r, true); return (unsigned)r; }
constexpr float SC_W8 = 64.f, SC_X8 = 4.f, SC_A8 = 2.f, SC_XN8 = 16.f;
__device__ __forceinline__ float bf_lo(unsigned u) { return __uint_as_float(u << 16); }
__device__ __forceinline__ float bf_hi(unsigned u) { return __uint_as_float(u & 0xffff0000u); }
__device__ __forceinline__ float fast_rcp(float x) { return __builtin_amdgcn_rcpf(x); }
__device__ __forceinline__ float sigmoid_f(float x) { return fast_rcp(1.f + __builtin_amdgcn_exp2f(-1.4426950408889634f * x)); }
__device__ __forceinline__ float gelu_tanh_f(float x) { const float in = -2.302208198f * (x + 0.044715f * x * x * x); return x * fast_rcp(1.f + __builtin_amdgcn_exp2f(in)); }
__device__ __forceinline__ float wave_sum(float v) {
#pragma unroll
    for (int o = 1; o < 64; o <<= 1) v += __shfl_xor(v, o);
    return v;
}

namespace pg8 {
constexpr int BM = 256, BK = 64, HALF = 128, HTB = HALF * BK * 2, STAGE_BYTES = 8 * HTB;
__host__ __device__ __forceinline__ int lds_byte(int r, int c) { const int st = (r >> 4) * 2 + (c >> 5), rr = r & 15, cc = c & 31, ob = rr * 64 + cc * 2; return st * 1024 + (ob ^ (((ob >> 9) & 1) << 5)); }
__host__ __device__ __forceinline__ void stage_rc(int b, int& R, int& C) { const int st = b / 1024, sb = b % 1024, swz = sb ^ (((sb >> 9) & 1) << 5); R = (st >> 1) * 16 + swz / 64; C = (st & 1) * 32 + (swz % 64) / 2; }
__host__ __device__ __forceinline__ int perm32(int rho) { const int n = rho >> 4, i = rho & 15; return 8 * (i >> 2) + 4 * n + (i & 3); }

struct Unit { const char* A; const char* B; int kind, pm, pn, e, nvalid, rbase; };
struct Gemm { int lda, ldb, K; };

__device__ __forceinline__ void tile_order(int L, int nM, int nN, int& pm, int& pn) {
    const int nwg = nM * nN; int wgid = L;
    { const int q = nwg / 8, r = nwg % 8, xcd = wgid % 8, off = wgid / 8; wgid = (xcd < r ? xcd * (q + 1) : r * (q + 1) + (xcd - r) * q) + off; }
    const int nig = 8 * nN, gid = wgid / nig, fm = gid * 8, gsz = (nM - fm) < 8 ? (nM - fm) : 8;
    pm = fm + ((wgid % nig) % gsz); pn = (wgid % nig) / gsz;
}

template <class Epi, class Sched, bool F8 = false>
__device__ __forceinline__ void gemm_phase(LAS unsigned char* lds, const Gemm g, const Sched& S, const Epi& E) {
    int tid_ = threadIdx.x; asm volatile("" : "+v"(tid_));
    const int tid = tid_, wid = __builtin_amdgcn_readfirstlane(tid >> 6), lane = tid & 63, wr = wid >> 2, wc = wid & 3, fr = lane & 15, fq = lane >> 4;
    const int K = g.K, nt = K / BK;
    unsigned voffA[2], voffB[2];
#pragma unroll
    for (int i = 0; i < 2; ++i) { int R, C; stage_rc(tid * 16 + i * 8192, R, C); const int Rb = Epi::PERM ? ((R & ~31) + perm32(R & 31)) : R;
        voffA[i] = (unsigned)(R * g.lda + C) * 2u; voffB[i] = (unsigned)(Rb * g.ldb + C) * 2u; }
    const size_t kstep = (size_t)(BK * 2);
    const size_t hstepA = (size_t)HALF * g.lda * 2, hstepB = (size_t)HALF * g.ldb * 2;
    const unsigned ldsw = (unsigned)wid * 1024u;
    const int aoff = lds_byte(wr * 64 + fr, fq * 8), boff = lds_byte(wc * 32 + fr, fq * 8);
#define PG8_SA(b, h) (((b) * 2 + (h)) * HTB)
#define PG8_SB(b, h) ((4 + (b) * 2 + (h)) * HTB)
#define PG8_STAGE(bufoff, gbase, voff) do { _Pragma("unroll") for (int _i = 0; _i < 2; ++_i) \
        __builtin_amdgcn_global_load_lds((const unsigned*)((const char*)(gbase) + (voff)[_i]), (LAS unsigned*)(lds + (bufoff) + ldsw + _i * 8192), 16, 0, 0); } while (0)
#define PG8_LDA(dst, b, h) do { _Pragma("unroll") for (int m = 0; m < 4; ++m) { const i32x4 lo_ = *(const LAS i32x4*)(lds + PG8_SA(b, h) + aoff + m * 2048), hi_ = *(const LAS i32x4*)(lds + PG8_SA(b, h) + aoff + m * 2048 + 1024); \
        dst[m] = __builtin_shufflevector(lo_, hi_, 0, 1, 2, 3, 4, 5, 6, 7); } } while (0)
#define PG8_LDB(dst, b, h) do { _Pragma("unroll") for (int n = 0; n < 2; ++n) { const i32x4 lo_ = *(const LAS i32x4*)(lds + PG8_SB(b, h) + boff + n * 2048), hi_ = *(const LAS i32x4*)(lds + PG8_SB(b, h) + boff + n * 2048 + 1024); \
        dst[n] = __builtin_shufflevector(lo_, hi_, 0, 1, 2, 3, 4, 5, 6, 7); } } while (0)
#define PG8_MMA(ai, bj, At, Bt) do { __builtin_amdgcn_s_setprio(1); _Pragma("unroll") for (int m = 0; m < 4; ++m) _Pragma("unroll") for (int n = 0; n < 2; ++n) { \
        if constexpr (F8) { asm volatile("v_mfma_f32_16x16x128_f8f6f4 %0, %1, %2, %0" : "+v"(acc[ai][bj][m][n]) : "v"(Bt[n]), "v"(At[m])); } \
        else { acc[ai][bj][m][n] = __builtin_amdgcn_mfma_f32_16x16x32_bf16(__builtin_bit_cast(bf16x8, __builtin_shufflevector(Bt[n], Bt[n], 0, 1, 2, 3)), __builtin_bit_cast(bf16x8, __builtin_shufflevector(At[m], At[m], 0, 1, 2, 3)), acc[ai][bj][m][n], 0, 0, 0); \
               acc[ai][bj][m][n] = __builtin_amdgcn_mfma_f32_16x16x32_bf16(__builtin_bit_cast(bf16x8, __builtin_shufflevector(Bt[n], Bt[n], 4, 5, 6, 7)), __builtin_bit_cast(bf16x8, __builtin_shufflevector(At[m], At[m], 4, 5, 6, 7)), acc[ai][bj][m][n], 0, 0, 0); } } \
        __builtin_amdgcn_s_setprio(0); } while (0)
#define PG8_WAIT_V(n) asm volatile("s_waitcnt vmcnt(" #n ")" ::: "memory")
#define PG8_WAIT_L(n) asm volatile("s_waitcnt lgkmcnt(" #n ")" ::: "memory")
#define PG8_BAR __builtin_amdgcn_s_barrier()
#define PG8_SCHED __builtin_amdgcn_sched_barrier(0)
    Unit cur, nxt; int ui = 0;
    if (!S.next(0, cur)) return;
    f32x4 acc[2][2][4][2];
#pragma unroll
    for (int a = 0; a < 2; ++a)
#pragma unroll
        for (int b = 0; b < 2; ++b)
#pragma unroll
            for (int m = 0; m < 4; ++m)
#pragma unroll
                for (int n = 0; n < 2; ++n) acc[a][b][m][n] = (f32x4){0.f, 0.f, 0.f, 0.f};
    i32x8 At[4], B0[2], B1[2];
    const char* cA = cur.A; const char* cB = cur.B;
    PG8_STAGE(PG8_SB(0, 0), cB, voffB); PG8_STAGE(PG8_SB(0, 1), cB + hstepB, voffB); PG8_STAGE(PG8_SA(0, 0), cA, voffA); PG8_STAGE(PG8_SA(0, 1), cA + hstepA, voffA);
    if (wr == 1) PG8_BAR;
    PG8_WAIT_V(2); PG8_BAR;
    PG8_STAGE(PG8_SB(1, 0), cB + kstep, voffB); PG8_STAGE(PG8_SA(1, 0), cA + kstep, voffA); PG8_STAGE(PG8_SB(1, 1), cB + hstepB + kstep, voffB);
    PG8_WAIT_V(6); PG8_BAR;
    for (;;) {
        const bool has_next = S.next(ui + 1, nxt);
        const char* nA = has_next ? nxt.A : cA; const char* nB = has_next ? nxt.B : cB;
        const bool full = cur.nvalid > HALF;
        for (int t = 0; t < nt; t += 2) {
            const bool last = (t == nt - 2);
            const char* a1 = cA + (size_t)(t + 1) * kstep;
            const char* a2 = last ? nA : cA + (size_t)(t + 2) * kstep; const char* b2 = last ? nB : cB + (size_t)(t + 2) * kstep;
            const char* a3 = a2 + kstep; const char* b3 = b2 + kstep;
            PG8_LDB(B0, 0, 0); PG8_LDB(B1, 0, 1); PG8_SCHED; PG8_LDA(At, 0, 0); PG8_STAGE(PG8_SA(1, 1), a1 + hstepA, voffA);
            PG8_WAIT_V(8); PG8_WAIT_L(0); PG8_BAR; PG8_MMA(0, 0, At, B0); PG8_MMA(0, 1, At, B1); PG8_BAR; PG8_SCHED;
            if (!F8 || full) PG8_LDA(At, 0, 1); PG8_STAGE(PG8_SB(0, 0), b2, voffB); PG8_STAGE(PG8_SB(0, 1), b2 + hstepB, voffB); PG8_STAGE(PG8_SA(0, 0), a2, voffA);
            PG8_WAIT_V(8); PG8_WAIT_L(0); PG8_BAR; if (!F8 || full) { PG8_MMA(1, 0, At, B0); PG8_MMA(1, 1, At, B1); } PG8_BAR; PG8_SCHED;
            PG8_LDB(B0, 1, 0); PG8_LDB(B1, 1, 1); PG8_SCHED; PG8_LDA(At, 1, 0); PG8_STAGE(PG8_SA(0, 1), a2 + hstepA, voffA);
            PG8_WAIT_V(8); PG8_WAIT_L(0); PG8_BAR; PG8_MMA(0, 0, At, B0); PG8_MMA(0, 1, At, B1); PG8_BAR; PG8_SCHED;
            if (!F8 || full) PG8_LDA(At, 1, 1); PG8_STAGE(PG8_SB(1, 0), b3, voffB); PG8_STAGE(PG8_SB(1, 1), b3 + hstepB, voffB); PG8_STAGE(PG8_SA(1, 0), a3, voffA);
            PG8_WAIT_V(8); PG8_WAIT_L(0); PG8_BAR; if (!F8 || full) { PG8_MMA(1, 0, At, B0); PG8_MMA(1, 1, At, B1); } PG8_BAR; PG8_SCHED;
        }
        if constexpr (F8) asm volatile("s_nop 15\n\ts_nop 15\n\ts_nop 7" ::: "memory");
        if (wr == 0) PG8_BAR;
        E(acc, cur, wr, wc, fr, fq);
        if (!has_next) break;
        if (!(Epi::CHAIN && cur.kind == 0)) {
#pragma unroll
        for (int a = 0; a < 2; ++a)
#pragma unroll
            for (int b = 0; b < 2; ++b)
#pragma unroll
                for (int m = 0; m < 4; ++m)
#pragma unroll
                    for (int n = 0; n < 2; ++n) acc[a][b][m][n] = (f32x4){0.f, 0.f, 0.f, 0.f};
        }
        cur = nxt; cA = nA; cB = nB; ++ui;
        if (wr == 1) PG8_BAR;
    }
    PG8_WAIT_V(0);
    PG8_BAR;
#undef PG8_SA
#undef PG8_SB
#undef PG8_STAGE
#undef PG8_LDA
#undef PG8_LDB
#undef PG8_MMA
#undef PG8_WAIT_V
#undef PG8_WAIT_L
#undef PG8_BAR
#undef PG8_SCHED
}
}
using pg8::Unit;

#define XB_TMO      128
#define XB_XCNT(j)  (256  + 64 * (j))
#define XB_XSUB(j)  (1280 + 64 * (j))
#define XB_XGEN(j)  (2304 + 64 * (j))
#define XB_TOP      3328
#define XB_TOPGEN   3392
#define XCD_BAR_WORDS 3456
#define XB_SPIN_CAP (1u << 18)
__device__ __forceinline__ unsigned xb_ld(unsigned* p)              { return __hip_atomic_load(p, __ATOMIC_RELAXED, __HIP_MEMORY_SCOPE_AGENT); }
__device__ __forceinline__ unsigned xb_add(unsigned* p, unsigned v) { return __hip_atomic_fetch_add(p, v, __ATOMIC_RELAXED, __HIP_MEMORY_SCOPE_AGENT); }
__device__ __forceinline__ unsigned xb_xcc_id() { return (unsigned)__builtin_amdgcn_s_getreg((3 << 11) | 20) & 0xFu; }
#define XB_SPIN(cond, bar) do { unsigned _sp = 0; while (cond) { __builtin_amdgcn_s_sleep(1); \
    if ((++_sp & 255u) == 0u) { if (xb_ld(&(bar)[XB_TMO])) break; if (_sp > XB_SPIN_CAP) { atomicAdd(&(bar)[XB_TMO], 1u); break; } } } } while (0)
struct XcdBarrier { unsigned* bar; unsigned x; volatile LAS unsigned* st; };
__device__ __forceinline__ XcdBarrier xcd_barrier_post(unsigned* bar, volatile LAS unsigned* st) {
    XcdBarrier b; b.bar = bar; b.x = xb_xcc_id(); b.st = st;
    if (threadIdx.x == 0) (void)xb_add(&bar[XB_XCNT(b.x)], 1u);
    return b;
}
__device__ __forceinline__ void xcd_barrier_complete(unsigned* bar, unsigned x, unsigned& nloc, unsigned& nx) {
    const unsigned G = gridDim.x * gridDim.y * gridDim.z;
    unsigned sum, cnt, mine, sp = 0u;
    for (;;) {
        sum = 0u; cnt = 0u; mine = 0u;
#pragma unroll
        for (unsigned j = 0; j < 16; ++j) { const unsigned c = xb_ld(&bar[XB_XCNT(j)]); sum += c; cnt += (c > 0u) ? 1u : 0u; mine = (j == x) ? c : mine; }
        if (sum == G) break;
        __builtin_amdgcn_s_sleep(1);
        if ((++sp & 255u) == 0u) { if (xb_ld(&bar[XB_TMO])) break; if (sp > XB_SPIN_CAP) { atomicAdd(&bar[XB_TMO], 1u); break; } }
    }
    nloc = mine > 0u ? mine : 1u; nx = cnt > 0u ? cnt : 1u;
}
__device__ __forceinline__ void xcd_barrier(const XcdBarrier& b) {
    asm volatile("s_waitcnt vmcnt(0)" ::: "memory");
    __syncthreads();
    if (threadIdx.x == 0) {
        unsigned* bar = b.bar;
        __builtin_amdgcn_s_waitcnt(0);
        unsigned nloc = b.st[0], nx = b.st[1];
        if (nloc == 0u) { xcd_barrier_complete(bar, b.x, nloc, nx); b.st[0] = nloc; b.st[1] = nx; }
        const unsigned old = xb_add(&bar[XB_XSUB(b.x)], 1u);
        const unsigned gen = old / nloc;
        if (old + 1u == (gen + 1u) * nloc) {
            __builtin_amdgcn_fence(__ATOMIC_RELEASE, "agent");
            asm volatile("s_waitcnt vmcnt(0)" ::: "memory");
            const unsigned og = xb_add(&bar[XB_TOP], 1u);
            const unsigned tg = og / nx;
            if (og + 1u == (tg + 1u) * nx) xb_add(&bar[XB_TOPGEN], 1u);
            else XB_SPIN(xb_ld(&bar[XB_TOPGEN]) == tg, bar);
            __builtin_amdgcn_fence(__ATOMIC_ACQUIRE, "agent");
            xb_add(&bar[XB_XGEN(b.x)], 1u);
            asm volatile("s_waitcnt vmcnt(0)" ::: "memory");
        } else {
            XB_SPIN(xb_ld(&bar[XB_XGEN(b.x)]) == gen, bar);
            __builtin_amdgcn_fence(__ATOMIC_ACQUIRE, "agent");
            asm volatile("s_waitcnt vmcnt(0)" ::: "memory");
        }
    }
    __syncthreads();
}

struct Args { const float* in[18]; float* out; unsigned char* ws; };

constexpr int I_UP1 = (D / 128) * (2 * DE / 32);
constexpr int I_DN1 = (DE / 128) * (D / 32);
constexpr int MOE_ITEMS = NE * (I_UP1 + I_DN1);
struct MoeItem { const float* src; unsigned char* dst; int ldw; };
__device__ __forceinline__ MoeItem moe_item(const Args& a, int r) {
    MoeItem m; unsigned char* ws = a.ws;
    if (r < NE * I_UP1) { const int e = r / I_UP1, q = r % I_UP1; const int nblk = 2 * DE / 32, kb = q / nblk, nb = q % nblk, k0 = kb * 128, n0 = nb * 32;
        const int nn = n0 < DE ? n0 : n0 - DE; const int row = (nn >> 7) * 256 + (nn & 127) + (n0 < DE ? 0 : 128);
        m.src = a.in[14] + ((size_t)e * D + k0) * (2 * DE) + n0; m.ldw = 2 * DE; m.dst = ws + WS_WUT + ((size_t)e * 2 * DE + row) * D + k0; }
    else { r -= NE * I_UP1; const int e = r / I_DN1, q = r % I_DN1; const int nblk = D / 32, kb = q / nblk, nb = q % nblk, k0 = kb * 128, n0 = nb * 32;
        m.src = a.in[16] + ((size_t)e * DE + k0) * D + n0; m.ldw = D; m.dst = ws + WS_WDT + ((size_t)e * D + n0) * DE + k0; }
    return m;
}
__device__ __forceinline__ void moe_load(f32x4 (&v)[16], const MoeItem& m, int lane) {
#pragma unroll
    for (int j = 0; j < 16; ++j) v[j] = __builtin_nontemporal_load((const f32x4*)(m.src + (size_t)(16 * (lane >> 3) + j) * m.ldw + 4 * (lane & 7)));
}
__device__ __forceinline__ void moe_store(const f32x4 (&v)[16], unsigned char* dst, int lane) {
#pragma unroll
    for (int i = 0; i < 4; ++i) { u32x4 o;
        o.x = pk4_fp8(v[0][i] * SC_W8, v[1][i] * SC_W8, v[2][i] * SC_W8, v[3][i] * SC_W8); o.y = pk4_fp8(v[4][i] * SC_W8, v[5][i] * SC_W8, v[6][i] * SC_W8, v[7][i] * SC_W8);
        o.z = pk4_fp8(v[8][i] * SC_W8, v[9][i] * SC_W8, v[10][i] * SC_W8, v[11][i] * SC_W8); o.w = pk4_fp8(v[12][i] * SC_W8, v[13][i] * SC_W8, v[14][i] * SC_W8, v[15][i] * SC_W8);
        __builtin_nontemporal_store(o, (u32x4*)(dst + (size_t)(4 * (lane & 7) + i) * DE + 16 * (lane >> 3))); }
}
__device__ __forceinline__ void moe_convert(const Args& a, LAS unsigned char* lds, int begin, int end, int wave, int lane) {
    int it = begin + wave;
    if (it >= end) return;
    f32x4 cur[16], nxt[16];
    MoeItem mc = moe_item(a, it);
    moe_load(cur, mc, lane);
    for (;;) {
        const int itn = it + NWAVES; const bool more = itn < end;
        MoeItem mn = mc;
        if (more) { mn = moe_item(a, itn); moe_load(nxt, mn, lane); }
        moe_store(cur, mc.dst, lane);
        if (!more) break;
#pragma unroll
        for (int j = 0; j < 16; ++j) cur[j] = nxt[j];
        mc = mn; it = itn;
    }
}

struct P0Item { const float* src; bf16* dst; int ldw, ldt; };
__device__ __forceinline__ P0Item p0_item(const Args& a, int r) {
    constexpr int I_IN = (D / 64) * (C_GB_END_BF / 32), I_A = (AW / 64) * (D / 32);
    unsigned char* ws = a.ws; bf16* W1T = (bf16*)(ws + WS_W1T); bf16* W2T = (bf16*)(ws + WS_W2T);
    P0Item m;
    if (r < I_IN) { const int nblk = C_GB_END_BF / 32, kb = r / nblk, nb = r % nblk, k0 = kb * 64, n0 = nb * 32;
        bf16* dst;
        if (n0 < 2048) dst = W1T + (size_t)n0 * D; else if (n0 < 3072) dst = W2T + (size_t)(n0 - 2048) * D; else if (n0 < 4096) dst = W1T + (size_t)(n0 - 1024) * D;
        else dst = W2T + (size_t)(n0 - 3072) * D;
        m.src = a.in[2] + (size_t)k0 * PW + n0; m.ldw = PW; m.dst = dst + k0; m.ldt = D; return m; }
    r -= I_IN;
    const int nblk = D / 32;
    if (r < I_A) { const int kb2 = r / nblk, nb = r % nblk, k0 = kb2 * 64, n0 = nb * 32; m.src = a.in[8] + (size_t)k0 * D + n0; m.ldw = D; m.dst = (bf16*)(ws + WS_WAT) + (size_t)n0 * AW + k0; m.ldt = AW; return m; }
    r -= I_A;
    if (r < I_A) { const int kb2 = r / nblk, nb = r % nblk, k0 = kb2 * 64, n0 = nb * 32; m.src = a.in[9] + (size_t)k0 * D + n0; m.ldw = D; m.dst = (bf16*)(ws + WS_WBT) + (size_t)n0 * SW + k0; m.ldt = SW; return m; }
    r -= I_A;
    { const int kb2 = r / nblk, nb = r % nblk, k0 = kb2 * 64, n0 = nb * 32; m.src = a.in[10] + (size_t)k0 * D + n0; m.ldw = D; m.dst = (bf16*)(ws + WS_WOT) + (size_t)n0 * D + k0; m.ldt = D; return m; }
}
__device__ __forceinline__ void p0_load(f32x4 (&v)[8], const P0Item& m, int lane) {
#pragma unroll
    for (int j = 0; j < 8; ++j) v[j] = __builtin_nontemporal_load((const f32x4*)(m.src + (size_t)(8 * (lane >> 3) + j) * m.ldw + 4 * (lane & 7)));
}
__device__ __forceinline__ void p0_store(const f32x4 (&v)[8], const P0Item& m, int lane) {
#pragma unroll
    for (int i = 0; i < 4; ++i) { u32x4 o; o.x = cvt_pk_bf16(v[0][i], v[1][i]); o.y = cvt_pk_bf16(v[2][i], v[3][i]); o.z = cvt_pk_bf16(v[4][i], v[5][i]); o.w = cvt_pk_bf16(v[6][i], v[7][i]);
        *(u32x4*)(m.dst + (size_t)(4 * (lane & 7) + i) * m.ldt + 8 * (lane >> 3)) = o; }
}
__device__ __forceinline__ void p0_prologue(const Args& a, LAS unsigned char* lds, int vcu, int G, int wave, int lane) {
    unsigned char* ws = a.ws;
    const int gw = vcu * NWAVES + wave, NGW = G * NWAVES;
    constexpr int NITEMS = (D / 64) * (C_GB_END_BF / 32) + 2 * (AW / 64) * (D / 32) + (D / 64) * (D / 32);
    for (int it = gw; it < (D / 128) * ((PW - C_GB_END_BF) / 32); it += NGW) { const int nblk = (PW - C_GB_END_BF) / 32, kb = it / nblk, nb = it % nblk;
        MoeItem m; m.src = a.in[2] + (size_t)(kb * 128) * PW + C_GB_END_BF + nb * 32; m.ldw = PW; m.dst = ws + WS_WG8 + (size_t)(nb * 32) * D + kb * 128;
        f32x4 v[16]; moe_load(v, m, lane); moe_store(v, m.dst, lane); }
    if (gw < NITEMS) {
        int it = gw; f32x4 cur[8], nxt[8]; P0Item mc = p0_item(a, it); p0_load(cur, mc, lane);
        for (;;) { const int itn = it + NGW; const bool more = itn < NITEMS; P0Item mn = mc;
            if (more) { mn = p0_item(a, itn); p0_load(nxt, mn, lane); }
            p0_store(cur, mc, lane);
            if (!more) break;
#pragma unroll
            for (int j = 0; j < 8; ++j) cur[j] = nxt[j];
            mc = mn; it = itn; }
    }
    const float* g1 = a.in[1];
    if (gw < T) {
        int m = gw; f32x4 v[8], vn[8];
        { const f32x4* xr = (const f32x4*)(a.in[0] + (size_t)m * D) + lane;
#pragma unroll
          for (int j = 0; j < 8; ++j) v[j] = __builtin_nontemporal_load(xr + 64 * j); }
        for (;;) { const int mn = m + NGW; const bool more = mn < T;
            if (more) { const f32x4* xr = (const f32x4*)(a.in[0] + (size_t)mn * D) + lane;
#pragma unroll
                for (int j = 0; j < 8; ++j) vn[j] = __builtin_nontemporal_load(xr + 64 * j); }
            float s = 0.f;
#pragma unroll
            for (int j = 0; j < 8; ++j) s += (v[j].x * v[j].x + v[j].y * v[j].y) + (v[j].z * v[j].z + v[j].w * v[j].w);
            const float rstd = rsqrtf(wave_sum(s) * (1.f / D) + EPS);
            u32x2* o8 = (u32x2*)((bf16*)(ws + WS_XN) + (size_t)m * D) + lane; unsigned* o4 = (unsigned*)(ws + WS_XN8 + (size_t)m * D) + lane;
#pragma unroll
            for (int j = 0; j < 8; ++j) { const f32x4 gg = *((const f32x4*)g1 + lane + 64 * j);
                const float y0 = v[j].x * rstd * gg.x, y1 = v[j].y * rstd * gg.y, y2 = v[j].z * rstd * gg.z, y3 = v[j].w * rstd * gg.w;
                u32x2 o; o.x = cvt_pk_bf16(y0, y1); o.y = cvt_pk_bf16(y2, y3); o8[64 * j] = o;
                o4[64 * j] = pk4_fp8(y0 * SC_XN8, y1 * SC_XN8, y2 * SC_XN8, y3 * SC_XN8); }
            if (!more) break;
#pragma unroll
            for (int j = 0; j < 8; ++j) v[j] = vn[j];
            m = mn; }
    }
}

struct Epi1 {
    static constexpr bool PERM = true, CHAIN = false;
    bf16* PB; bf16* VT; bf16* QB; bf16* KB; float* stats; const float* gq; const float* gk; LAS float* scr;
    __device__ __forceinline__ void operator()(f32x4 (&acc)[2][2][4][2], const Unit& u, int wr, int wc, int fr, int fq) const {
        if (u.kind == 0) {
            const int pn = u.pn;
            bf16* base = PB + (size_t)(u.pm * 256 + wr * 64 + fr) * N1 + pn * 256 + wc * 32 + 8 * fq;
            if (pn < 8) {
#pragma unroll
                for (int ai = 0; ai < 2; ++ai)
#pragma unroll
                    for (int m = 0; m < 4; ++m)
#pragma unroll
                        for (int bj = 0; bj < 2; ++bj) { const f32x4 x0 = acc[ai][bj][m][0], x1 = acc[ai][bj][m][1];
                            float s = (x0.x * x0.x + x0.y * x0.y) + (x0.z * x0.z + x0.w * x0.w) + (x1.x * x1.x + x1.y * x1.y) + (x1.z * x1.z + x1.w * x1.w);
                            s += __shfl_xor(s, 16); s += __shfl_xor(s, 32);
                            if (fq == 0) scr[(ai * 128 + wr * 64 + m * 16 + fr) * 8 + bj * 4 + wc] = s; }
                LDS_WAIT(); __builtin_amdgcn_s_barrier(); asm volatile("" ::: "memory");
                const float* gn = (pn < 4) ? gq : gk; const float sc = (pn < 4) ? 0.12751743082459868f : 1.f;
                const f32x4 g0 = *(const f32x4*)(gn + wc * 32 + 8 * fq), g1 = *(const f32x4*)(gn + wc * 32 + 8 * fq + 4);
                bf16* qkb = (pn < 4 ? QB : KB) + ((size_t)(((u.pm * 256) >> 12) * NH + (pn & 3) * 2) * SEQ + ((u.pm * 256) & (SEQ - 1)) + wr * 64 + fr) * HD + wc * 32 + 8 * fq;
#pragma unroll
                for (int ai = 0; ai < 2; ++ai)
#pragma unroll
                    for (int m = 0; m < 4; ++m) { const int row = ai * 128 + wr * 64 + m * 16 + fr;
#pragma unroll
                        for (int bj = 0; bj < 2; ++bj) { const f32x4 p = *(const LAS f32x4*)(scr + row * 8 + bj * 4);
                            const float rinv = rsqrtf(((p.x + p.y) + (p.z + p.w)) * (1.f / HD) + EPS) * sc;
                            const f32x4 v0 = acc[ai][bj][m][0] * rinv * g0, v1 = acc[ai][bj][m][1] * rinv * g1;
                            u32x4 w; w.x = cvt_pk_bf16(v0.x, v0.y); w.y = cvt_pk_bf16(v0.z, v0.w); w.z = cvt_pk_bf16(v1.x, v1.y); w.w = cvt_pk_bf16(v1.z, v1.w);
                            *(u32x4*)(qkb + (size_t)(ai * 128 + m * 16) * HD + (size_t)bj * SEQ * HD) = w; } __builtin_amdgcn_sched_barrier(0); }
                LDS_WAIT();
            } else {
#pragma unroll
                for (int ai = 0; ai < 2; ++ai)
#pragma unroll
                    for (int m = 0; m < 4; ++m)
#pragma unroll
                        for (int bj = 0; bj < 2; ++bj) { f32x4 v0 = acc[ai][bj][m][0], v1 = acc[ai][bj][m][1];
#pragma unroll
                            for (int j = 0; j < 4; ++j) { v0[j] = gelu_tanh_f(v0[j]); v1[j] = gelu_tanh_f(v1[j]); }
                            u32x4 w; w.x = cvt_pk_bf16(v0.x, v0.y); w.y = cvt_pk_bf16(v0.z, v0.w); w.z = cvt_pk_bf16(v1.x, v1.y); w.w = cvt_pk_bf16(v1.z, v1.w);
                            *(u32x4*)(base + (size_t)(ai * 128 + m * 16) * N1 + bj * 128) = w; __builtin_amdgcn_sched_barrier(0); }
            }
        } else {
            const bool is_vv = u.pm >= 4;
            bf16* vtb = VT + ((((size_t)(((u.pn * 256) >> 12) * 16 + u.pm * 2) * 128 + (((u.pn * 256) & (SEQ - 1)) >> 5) + wc) * 128 + wr * 64 + fr) * 32 + 8 * fq);
            if (is_vv) {
#pragma unroll
                for (int bj = 0; bj < 2; ++bj)
#pragma unroll
                    for (int n = 0; n < 2; ++n) { f32x4 s = (f32x4){0.f, 0.f, 0.f, 0.f}, q = s;
#pragma unroll
                        for (int ai = 0; ai < 2; ++ai)
#pragma unroll
                            for (int m = 0; m < 4; ++m) { f32x4 x = acc[ai][bj][m][n];
#pragma unroll
                                for (int j = 0; j < 4; ++j) x[j] = gelu_tanh_f(x[j]);
                                s += x; q += x * x; }
#pragma unroll
                        for (int o = 1; o < 16; o <<= 1) {
#pragma unroll
                            for (int j = 0; j < 4; ++j) { s[j] += __shfl_xor(s[j], o); q[j] += __shfl_xor(q[j], o); } }
                        if (fr == 0) { const int slot = (u.pm - 4) * 2 + wr; float* sp = stats + ((size_t)(u.pn * 256 + bj * 128 + wc * 32 + 8 * fq + 4 * n) * 8 + slot) * 2;
#pragma unroll
                            for (int j = 0; j < 4; ++j) *(f32x2*)(sp + 16 * j) = (f32x2){s[j], q[j]}; }
                        __builtin_amdgcn_sched_barrier(0); }
            }
#pragma unroll
            for (int ai = 0; ai < 2; ++ai)
#pragma unroll
                for (int m = 0; m < 4; ++m)
#pragma unroll
                    for (int bj = 0; bj < 2; ++bj) { f32x4 v0 = acc[ai][bj][m][0], v1 = acc[ai][bj][m][1];
                        if (is_vv) {
#pragma unroll
                            for (int j = 0; j < 4; ++j) { v0[j] = gelu_tanh_f(v0[j]); v1[j] = gelu_tanh_f(v1[j]); } }
                        u32x4 w; w.x = cvt_pk_bf16(v0.x, v0.y); w.y = cvt_pk_bf16(v0.z, v0.w); w.z = cvt_pk_bf16(v1.x, v1.y); w.w = cvt_pk_bf16(v1.z, v1.w);
                        *(u32x4*)(vtb + (size_t)ai * (128 * 128 * 32) + bj * (4 * 128 * 32) + m * (16 * 32)) = w; __builtin_amdgcn_sched_barrier(0); }
        }
    }
};
struct Sched1 {
    int G, c; const char* XN; const char* W1T; const char* W2T;
    __device__ __forceinline__ bool next(int i, Unit& u) const {
        const int L = i * G + c; if (L >= 640) return false;
        u.e = 0; u.nvalid = 256; u.rbase = 0;
        if (L < 384) { pg8::tile_order(L, 32, 12, u.pm, u.pn); u.kind = 0; u.A = XN + (size_t)u.pm * 256 * D * 2; u.B = W1T + (size_t)u.pn * 256 * D * 2; }
        else { pg8::tile_order(L - 384, 8, 32, u.pm, u.pn); u.kind = 1; u.A = W2T + (size_t)u.pm * 256 * D * 2; u.B = XN + (size_t)u.pn * 256 * D * 2; }
        return true;
    }
};
struct Epi1g {
    static constexpr bool PERM = true, CHAIN = false;
    bf16* PB;
    __device__ __forceinline__ void operator()(f32x4 (&acc)[2][2][4][2], const Unit& u, int wr, int wc, int fr, int fq) const {
        constexpr float ds = 1.f / (SC_XN8 * SC_W8);
        bf16* base = PB + (size_t)(u.pm * 256 + wr * 64 + fr) * N1 + C_GA + u.pn * 256 + wc * 32 + 8 * fq;
#pragma unroll
        for (int ai = 0; ai < 2; ++ai)
#pragma unroll
            for (int m = 0; m < 4; ++m)
#pragma unroll
                for (int bj = 0; bj < 2; ++bj) { f32x4 v0 = acc[ai][bj][m][0] * ds, v1 = acc[ai][bj][m][1] * ds;
#pragma unroll
                    for (int j = 0; j < 4; ++j) { v0[j] = sigmoid_f(v0[j]); v1[j] = sigmoid_f(v1[j]); }
                    u32x4 w; w.x = cvt_pk_bf16(v0.x, v0.y); w.y = cvt_pk_bf16(v0.z, v0.w); w.z = cvt_pk_bf16(v1.x, v1.y); w.w = cvt_pk_bf16(v1.z, v1.w);
                    *(u32x4*)(base + (size_t)(ai * 128 + m * 16) * N1 + bj * 128) = w; __builtin_amdgcn_sched_barrier(0); }
    }
};
struct Sched1g {
    int G, c; const char* XN8; const char* WG8;
    __device__ __forceinline__ bool next(int i, Unit& u) const {
        const int L = i * G + c; if (L >= 512) return false;
        u.e = 0; u.nvalid = 256; u.rbase = 0; u.kind = 0;
        pg8::tile_order(L, 32, 16, u.pm, u.pn); u.A = XN8 + (size_t)u.pm * 256 * D; u.B = WG8 + (size_t)u.pn * 256 * D;
        return true;
    }
};

__device__ __forceinline__ void attn_task(const bf16* QB, const bf16* KB, const bf16* VT, bf16* OA, int task, int lane) {
    const int bh = task >> 7, qb = task & 127, b = bh >> 3, h = bh & 7;
    const int c = lane & 31, hh = lane >> 5;
    const size_t tokbase = (size_t)b * SEQ;
    const int t0 = qb * 32;
    bf16x8 qf[8];
    { const bf16* qp = QB + ((size_t)bh * SEQ + t0 + c) * HD + 8 * hh;
#pragma unroll
      for (int s = 0; s < 8; ++s) qf[s] = *(const bf16x8*)(qp + 16 * s); }
    f32x16 o[4];
#pragma unroll
    for (int d = 0; d < 4; ++d)
#pragma unroll
        for (int r = 0; r < 16; ++r) o[d][r] = 0.f;
    float crun = 0.f;
    const int kap = 16 * ((c >> 2) & 1) + 4 * (c >> 3) + (c & 3);
    const bf16* kp0 = KB + ((size_t)bh * SEQ + kap) * HD + 8 * hh;
    const bf16* vp0 = VT + ((size_t)(b * 16 + h) * 128 * 128 + c) * 32 + 16 * hh;
    bf16x8 kf[8];
#pragma unroll
    for (int s = 0; s < 8; ++s) kf[s] = *(const bf16x8*)(kp0 + (size_t)t0 * HD + 16 * s);
    for (int j = qb; j >= 0; --j) {
        const int kbase = j * 32;
        bf16x8 vf[4][2];
#pragma unroll
        for (int d = 0; d < 4; ++d)
#pragma unroll
            for (int s = 0; s < 2; ++s) vf[d][s] = *(const bf16x8*)(vp0 + (size_t)j * 4096 + d * 1024 + 8 * s);
        f32x16 S;
#pragma unroll
        for (int r = 0; r < 16; ++r) S[r] = 0.f;
#pragma unroll
        for (int s = 0; s < 8; ++s) S = __builtin_amdgcn_mfma_f32_32x32x16_bf16(kf[s], qf[s], S, 0, 0, 0);
        if (j > 0) {
#pragma unroll
            for (int s = 0; s < 8; ++s) kf[s] = *(const bf16x8*)(kp0 + (size_t)(kbase - 32) * HD + 16 * s);
        }
        const int tq = t0 + c, k0 = kbase + 16 * hh;
        float Lk[16], run = 0.f;
        if (j == qb) {
#pragma unroll
            for (int r = 0; r < 16; ++r) { const float z = S[r]; const float sp = fmaxf(z, 0.f) + __builtin_amdgcn_logf(1.f + __builtin_amdgcn_exp2f(-fabsf(z)));
                const bool past = (k0 + r) < tq; Lk[r] = past ? -sp : 0.f; S[r] = past ? z : -1e30f; run += Lk[r]; }
        } else {
#pragma unroll
            for (int r = 0; r < 16; ++r) { const float z = S[r]; const float sp = fmaxf(z, 0.f) + __builtin_amdgcn_logf(1.f + __builtin_amdgcn_exp2f(-fabsf(z))); Lk[r] = -sp; run += Lk[r]; }
        }
        const float other = __shfl_xor(run, 32);
        float acc_after = crun + (hh == 0 ? other : 0.f);
        float w[16];
#pragma unroll
        for (int r = 15; r >= 0; --r) { w[r] = __builtin_amdgcn_exp2f((S[r] + Lk[r]) + acc_after); acc_after += Lk[r]; }
        crun += run + other;
        bf16x8 pf[2];
#pragma unroll
        for (int s = 0; s < 2; ++s) { u32x4 pk; pk.x = cvt_pk_bf16(w[8 * s + 0], w[8 * s + 1]); pk.y = cvt_pk_bf16(w[8 * s + 2], w[8 * s + 3]); pk.z = cvt_pk_bf16(w[8 * s + 4], w[8 * s + 5]); pk.w = cvt_pk_bf16(w[8 * s + 6], w[8 * s + 7]);
            pf[s] = __builtin_bit_cast(bf16x8, pk); }
#pragma unroll
        for (int d = 0; d < 4; ++d)
#pragma unroll
            for (int s = 0; s < 2; ++s) o[d] = __builtin_amdgcn_mfma_f32_32x32x16_bf16(vf[d][s], pf[s], o[d], 0, 0, 0);
        if (__all(crun < -151.f)) break;
    }
    bf16* op = OA + (tokbase + t0 + c) * AW + h * HD + 4 * hh;
#pragma unroll
    for (int d = 0; d < 4; ++d)
#pragma unroll
        for (int g = 0; g < 4; ++g) { u32x2 pk; pk.x = cvt_pk_bf16(o[d][4 * g + 0], o[d][4 * g + 1]); pk.y = cvt_pk_bf16(o[d][4 * g + 2], o[d][4 * g + 3]);
            *(u32x2*)(op + d * 32 + 8 * g) = pk; }
}

__device__ __forceinline__ void sgu_task(const Args& a, const bf16* PB, const bf16* VT, const float* stats, bf16* OB, int idx, int lane) {
    const int ib = idx & 3, g = (idx >> 2) & 7, n = idx >> 5;
    const int c = lane & 31, hh = lane >> 5;
    const float* wsp = a.in[6] + ((size_t)g * 128 + ib * 32 + c) * 128 + 8 * hh;
    const bf16* vvp = VT + (((size_t)((n >> 5) * 16 + 8 + g) * 128 + (n & 31) * 4) * 128 + c) * 32 + 8 * hh;
    f32x16 acc[4];
#pragma unroll
    for (int d = 0; d < 4; ++d)
#pragma unroll
        for (int r = 0; r < 16; ++r) acc[d][r] = 0.f;
    const int nks = ib < 2 ? 4 : 8;
    for (int ks = 0; ks < nks; ++ks) {
        float mu[8], rs[8];
        { const f32x4 st = *(const f32x4*)(stats + ((size_t)(n * 128 + 16 * ks + (lane >> 2)) * 8 + 2 * (lane & 3)) * 2);
          float S = st.x + st.z, Q = st.y + st.w;
          S += __shfl_xor(S, 1); Q += __shfl_xor(Q, 1); S += __shfl_xor(S, 2); Q += __shfl_xor(Q, 2);
          const float m_ = S * (1.f / SW), r_ = rsqrtf(fmaxf(Q * (1.f / SW) - m_ * m_, 0.f) + EPS);
#pragma unroll
          for (int j = 0; j < 8; ++j) { mu[j] = __shfl(m_, 4 * (8 * hh + j)); rs[j] = __shfl(r_, 4 * (8 * hh + j)); } }
        const f32x4 w0 = *(const f32x4*)(wsp + 16 * ks), w1 = *(const f32x4*)(wsp + 16 * ks + 4);
        u32x4 bw; bw.x = cvt_pk_bf16(w0.x, w0.y); bw.y = cvt_pk_bf16(w0.z, w0.w); bw.z = cvt_pk_bf16(w1.x, w1.y); bw.w = cvt_pk_bf16(w1.z, w1.w);
        const bf16x8 bfrag = __builtin_bit_cast(bf16x8, bw);
#pragma unroll
        for (int cbk = 0; cbk < 4; ++cbk) {
            const u32x4 raw = *(const u32x4*)(vvp + (size_t)(ks >> 1) * 4096 + cbk * 1024 + 16 * (ks & 1));
            u32x4 nv;
            nv.x = cvt_pk_bf16((bf_lo(raw.x) - mu[0]) * rs[0], (bf_hi(raw.x) - mu[1]) * rs[1]);
            nv.y = cvt_pk_bf16((bf_lo(raw.y) - mu[2]) * rs[2], (bf_hi(raw.y) - mu[3]) * rs[3]);
            nv.z = cvt_pk_bf16((bf_lo(raw.z) - mu[4]) * rs[4], (bf_hi(raw.z) - mu[5]) * rs[5]);
            nv.w = cvt_pk_bf16((bf_lo(raw.w) - mu[6]) * rs[6], (bf_hi(raw.w) - mu[7]) * rs[7]);
            acc[cbk] = __builtin_amdgcn_mfma_f32_32x32x16_bf16(__builtin_bit_cast(bf16x8, nv), bfrag, acc[cbk], 0, 0, 0);
        }
    }
    const int tok = n * 128 + ib * 32 + c;
    const float bsp = a.in[7][g * 128 + ib * 32 + c];
    const float* gam = a.in[5] + g * 128 + 4 * hh;
    const bf16* up = PB + (size_t)tok * N1 + C_U + g * 128 + 4 * hh;
    bf16* op = OB + (size_t)tok * SW + g * 128 + 4 * hh;
#pragma unroll
    for (int d = 0; d < 4; ++d)
#pragma unroll
        for (int gg = 0; gg < 4; ++gg) { const f32x4 gm = *(const f32x4*)(gam + d * 32 + 8 * gg); const u32x2 uu = *(const u32x2*)(up + d * 32 + 8 * gg);
            const float r0 = bf_lo(uu.x) * (gm.x * acc[d][4 * gg + 0] + bsp), r1 = bf_hi(uu.x) * (gm.y * acc[d][4 * gg + 1] + bsp);
            const float r2 = bf_lo(uu.y) * (gm.z * acc[d][4 * gg + 2] + bsp), r3 = bf_hi(uu.y) * (gm.w * acc[d][4 * gg + 3] + bsp);
            u32x2 pk; pk.x = cvt_pk_bf16(r0, r1); pk.y = cvt_pk_bf16(r2, r3); *(u32x2*)(op + d * 32 + 8 * gg) = pk; }
}

struct Epi3 {
    static constexpr bool PERM = true, CHAIN = true;
    const bf16* PB; bf16* Y;
    __device__ __forceinline__ void operator()(f32x4 (&acc)[2][2][4][2], const Unit& u, int wr, int wc, int fr, int fq) const {
        const int row0 = u.pm * 256 + wr * 64 + fr, col0 = u.pn * 256 + wc * 32 + 8 * fq;
        const bf16* gpa = PB + (size_t)row0 * N1 + C_GA + col0; const bf16* gpb = PB + (size_t)row0 * N1 + C_GB + col0;
#pragma unroll
        for (int ai = 0; ai < 2; ++ai)
#pragma unroll
            for (int m = 0; m < 4; ++m)
#pragma unroll
                for (int bj = 0; bj < 2; ++bj) { const size_t ro = (size_t)(ai * 128 + m * 16);
                    const u32x4 gb = *(const u32x4*)(gpb + ro * N1 + bj * 128);
                    f32x4 b0, b1;
                    b0.x = fmaxf(bf_lo(gb.x), 1e-20f); b0.y = fmaxf(bf_hi(gb.x), 1e-20f); b0.z = fmaxf(bf_lo(gb.y), 1e-20f); b0.w = fmaxf(bf_hi(gb.y), 1e-20f);
                    b1.x = fmaxf(bf_lo(gb.z), 1e-20f); b1.y = fmaxf(bf_hi(gb.z), 1e-20f); b1.z = fmaxf(bf_lo(gb.w), 1e-20f); b1.w = fmaxf(bf_hi(gb.w), 1e-20f);
                    if (u.kind == 0) {
                        const u32x4 ga = *(const u32x4*)(gpa + ro * N1 + bj * 128);
                        f32x4 r0, r1;
                        r0.x = bf_lo(ga.x) * fast_rcp(b0.x); r0.y = bf_hi(ga.x) * fast_rcp(b0.y); r0.z = bf_lo(ga.y) * fast_rcp(b0.z); r0.w = bf_hi(ga.y) * fast_rcp(b0.w);
                        r1.x = bf_lo(ga.z) * fast_rcp(b1.x); r1.y = bf_hi(ga.z) * fast_rcp(b1.y); r1.z = bf_lo(ga.w) * fast_rcp(b1.z); r1.w = bf_hi(ga.w) * fast_rcp(b1.w);
                        acc[ai][bj][m][0] *= r0; acc[ai][bj][m][1] *= r1;
                    } else {
                        const f32x4 v0 = acc[ai][bj][m][0] * b0, v1 = acc[ai][bj][m][1] * b1;
                        u32x4 w; w.x = cvt_pk_bf16(v0.x, v0.y); w.y = cvt_pk_bf16(v0.z, v0.w); w.z = cvt_pk_bf16(v1.x, v1.y); w.w = cvt_pk_bf16(v1.z, v1.w);
                        *(u32x4*)(Y + (size_t)(row0 + ro) * D + col0 + bj * 128) = w; } }
    }
};
struct Sched3 {
    int G, c; const char* OA; const char* OB; const char* WAT; const char* WBT;
    __device__ __forceinline__ bool next(int i, Unit& u) const {
        const int tile = c + (i >> 1) * G; if (tile >= 256) return false;
        pg8::tile_order(tile, 32, 8, u.pm, u.pn); u.kind = i & 1; u.e = 0; u.nvalid = 256; u.rbase = 0;
        u.A = (u.kind == 0 ? OA : OB) + (size_t)u.pm * 256 * AW * 2; u.B = (u.kind == 0 ? WAT : WBT) + (size_t)u.pn * 256 * AW * 2;
        return true;
    }
};

struct Epi4 {
    static constexpr bool PERM = false, CHAIN = false;
    const float* X; float* OUT;
    __device__ __forceinline__ void operator()(f32x4 (&acc)[2][2][4][2], const Unit& u, int wr, int wc, int fr, int fq) const {
        const size_t o0 = (size_t)(u.pm * 256 + wr * 64 + fr) * D + u.pn * 256 + wc * 32 + 4 * fq;
#pragma unroll
        for (int ai = 0; ai < 2; ++ai)
#pragma unroll
            for (int m = 0; m < 4; ++m)
#pragma unroll
                for (int bj = 0; bj < 2; ++bj)
#pragma unroll
                    for (int n = 0; n < 2; ++n) { const size_t o = o0 + (size_t)(ai * 128 + m * 16) * D + bj * 128 + n * 16;
                        *(f32x4*)(OUT + o) = *(const f32x4*)(X + o) + acc[ai][bj][m][n]; }
    }
};
struct Sched4 {
    int G, c; const char* Y; const char* WOT;
    __device__ __forceinline__ bool next(int i, Unit& u) const {
        const int tile = c + i * G; if (tile >= 256) return false;
        pg8::tile_order(tile, 32, 8, u.pm, u.pn); u.kind = 0; u.e = 0; u.nvalid = 256; u.rbase = 0;
        u.A = Y + (size_t)u.pm * 256 * D * 2; u.B = WOT + (size_t)u.pn * 256 * D * 2;
        return true;
    }
};

template <int PH> struct SchedMoE {
    int G, vcu; const volatile LAS unsigned* misc; const char* Abase; const char* Bbase; int ncu;
    __device__ __forceinline__ bool next(int i, Unit& u) const {
        const volatile LAS unsigned* us = misc + (PH == 6 ? MW_US6 : MW_US7);
        const int total = __builtin_amdgcn_readfirstlane((int)us[NE]);
        int L;
        if ((G & 255) == 0) { const int nx = G >> 5, chunk = (total + nx - 1) / nx, x = vcu >> 5, j = vcu & 31;
            if (ncu == 32) { L = x * chunk + i * 32 + j; if (L >= (x + 1) * chunk) return false; }
            else {
                int len = total - x * chunk; len = len < 0 ? 0 : (len > chunk ? chunk : len);
                const int R = len / ncu - MOE_TAIL_TEST;
                if (j < ncu) { if (i >= R) return false; L = x * chunk + i * ncu + j; }
                else { const int p = i * (32 - ncu) + (j - ncu); if (p >= len - R * ncu) return false; L = x * chunk + R * ncu + p; } } }
        else L = i * G + vcu;
        if (L >= total) return false;
        const int ln = (int)(threadIdx.x & 63);
        const unsigned mine = us[ln < NE ? ln : NE];
        const unsigned long long mk = __ballot((unsigned)L >= mine);
        const int e = __builtin_amdgcn_readfirstlane(63 - __builtin_clzll(mk | 1ull));
        const int ne = __builtin_amdgcn_readfirstlane((int)misc[MW_CNT + e]), off = __builtin_amdgcn_readfirstlane((int)misc[MW_OFF + e]);
        const int st = __builtin_amdgcn_readfirstlane((int)us[e]);
        const int mte = (ne + 255) >> 8, rem = L - st, mt = rem % mte, ntl = rem / mte;
        u.kind = 0; u.pm = mt; u.pn = ntl; u.e = e; u.nvalid = ne - mt * 256; u.rbase = off + mt * 256;
        if (PH == 6) { u.A = Abase + ((size_t)e * T + (size_t)mt * 256) * D; u.B = Bbase + ((size_t)e * 2 * DE + (size_t)ntl * 256) * D; }
        else { u.A = Abase + (size_t)u.rbase * DE; u.B = Bbase + ((size_t)e * D + (size_t)ntl * 256) * DE; }
        return true;
    }
};
__device__ __forceinline__ f32x2 swiglu_pk(f32x2 g, f32x2 u) {
    const f32x2 ga = __builtin_elementwise_min(g, (f32x2){7.f, 7.f});
    const f32x2 ua = __builtin_elementwise_min(__builtin_elementwise_max(u, (f32x2){-7.f, -7.f}), (f32x2){7.f, 7.f});
    const f32x2 t = ga * (-1.702f * 1.4426950408889634f);
    f32x2 d; d.x = __builtin_amdgcn_exp2f(t.x); d.y = __builtin_amdgcn_exp2f(t.y); d = d + 1.0f;
    f32x2 r; r.x = __builtin_amdgcn_rcpf(d.x); r.y = __builtin_amdgcn_rcpf(d.y);
    return (ga * r) * (ua * SC_A8 + SC_A8);
}
__device__ __forceinline__ unsigned pk4_fp8_nc(float a, float b, float c, float d) { int r = 0; r = __builtin_amdgcn_cvt_pk_fp8_f32(a, b, r, false); r = __builtin_amdgcn_cvt_pk_fp8_f32(c, d, r, true); return (unsigned)r; }
struct Epi6 {
    static constexpr bool PERM = true, CHAIN = false;
    const float* bup; unsigned char* ACT;
    __device__ __forceinline__ void operator()(f32x4 (&acc)[2][2][4][2], const Unit& u, int wr, int wc, int fr, int fq) const {
        const int cc = u.pn * 128 + wc * 32 + 8 * fq;
        const float* bg = bup + (size_t)u.e * 2 * DE + cc;
        const f32x4 bg0 = *(const f32x4*)bg, bg1 = *(const f32x4*)(bg + 4), bu0 = *(const f32x4*)(bg + DE), bu1 = *(const f32x4*)(bg + DE + 4);
        constexpr float ds = 1.f / (SC_W8 * SC_X8);
#pragma unroll
        for (int ai = 0; ai < 2; ++ai)
#pragma unroll
            for (int m = 0; m < 4; ++m) { const int row = ai * 128 + wr * 64 + m * 16 + fr;
                const f32x4 g0 = acc[ai][0][m][0] * ds + bg0, g1 = acc[ai][0][m][1] * ds + bg1, u0 = acc[ai][1][m][0] * ds + bu0, u1 = acc[ai][1][m][1] * ds + bu1;
                const f32x2 a0 = swiglu_pk((f32x2){g0.x, g0.y}, (f32x2){u0.x, u0.y}), a1 = swiglu_pk((f32x2){g0.z, g0.w}, (f32x2){u0.z, u0.w});
                const f32x2 a2 = swiglu_pk((f32x2){g1.x, g1.y}, (f32x2){u1.x, u1.y}), a3 = swiglu_pk((f32x2){g1.z, g1.w}, (f32x2){u1.z, u1.w});
                if (row < u.nvalid) { u32x2 w; w.x = pk4_fp8_nc(a0.x, a0.y, a1.x, a1.y); w.y = pk4_fp8_nc(a2.x, a2.y, a3.x, a3.y);
                    *(u32x2*)(ACT + (size_t)(u.rbase + row) * DE + cc) = w; } }
    }
};
struct Epi7 {
    static constexpr bool PERM = true, CHAIN = false;
    const float* bdn; bf16* YM;
    __device__ __forceinline__ void operator()(f32x4 (&acc)[2][2][4][2], const Unit& u, int wr, int wc, int fr, int fq) const {
        const int cc = u.pn * 256 + wc * 32 + 8 * fq;
        const float* bp = bdn + (size_t)u.e * D + cc;
        f32x4 bb[2][2];
#pragma unroll
        for (int bj = 0; bj < 2; ++bj) { bb[bj][0] = *(const f32x4*)(bp + bj * 128); bb[bj][1] = *(const f32x4*)(bp + bj * 128 + 4); }
#pragma unroll
        for (int ai = 0; ai < 2; ++ai)
#pragma unroll
            for (int m = 0; m < 4; ++m) { const int row = ai * 128 + wr * 64 + m * 16 + fr;
                if (row < u.nvalid) {
#pragma unroll
                    for (int bj = 0; bj < 2; ++bj) { constexpr float ds = 1.f / (SC_W8 * SC_A8); const f32x4 v0 = acc[ai][bj][m][0] * ds + bb[bj][0], v1 = acc[ai][bj][m][1] * ds + bb[bj][1];
                        u32x4 w; w.x = cvt_pk_bf16(v0.x, v0.y); w.y = cvt_pk_bf16(v0.z, v0.w); w.z = cvt_pk_bf16(v1.x, v1.y); w.w = cvt_pk_bf16(v1.z, v1.w);
                        *(u32x4*)(YM + (size_t)(u.rbase + row) * D + cc + bj * 128) = w; } } }
    }
};

__global__ void __launch_bounds__(NWAVES * 64, 2) fwd(Args a) {
    extern __shared__ __attribute__((aligned(16))) unsigned char lds_raw[];
    LAS unsigned char* lds = (LAS unsigned char*)lds_raw;
    volatile LAS unsigned* MISC = (volatile LAS unsigned*)(lds + MISC_OFF);
    const int tid = threadIdx.x, lane = tid & 63, wave = __builtin_amdgcn_readfirstlane(tid >> 6);
    const int G = gridDim.x, bx = blockIdx.x;
    const int vcu = (G % 8 == 0) ? (bx % 8) * (G / 8) + bx / 8 : bx;
    unsigned char* ws = a.ws;
    unsigned* ctl = (unsigned*)(ws + WS_CTL);
    for (int u = tid; u < 512; u += NWAVES * 64) MISC[u] = 0u;
    __syncthreads();
    XcdBarrier bar = xcd_barrier_post(ctl + CW_BAR, MISC + MW_BAR);
    const int gw = vcu * NWAVES + wave, NGW = G * NWAVES;

    bf16* PB = (bf16*)(ws + WS_PB); bf16* VT = (bf16*)(ws + WS_VT); bf16* OA = (bf16*)(ws + WS_OA); bf16* OB = (bf16*)(ws + WS_OB);
    float* stats = (float*)(ws + WS_STATS);
    int* tok_e = (int*)(ws + WS_ROUTE); int* tok_rank = tok_e + T * TOPK; float* tok_gate = (float*)(tok_rank + T * TOPK);

    if (PH_ON(0)) p0_prologue(a, lds, vcu, G, wave, lane);
    xcd_barrier(bar);

    if (PH_ON(1)) {
        int cbeg, cend;
        constexpr int NUP = NE * I_UP1;
        const bool split6 = (G == 256);
        const int CONV1 = split6 ? NUP : MOE_ITEMS;
        if (G == 256) { constexpr int S5 = 220, S4 = 292; static_assert(128 * (S5 + S4) == NUP, "conversion shares");
            cbeg = bx < 128 ? bx * S5 : 128 * S5 + (bx - 128) * S4; cend = cbeg + (bx < 128 ? S5 : S4); }
        else { const int per = (CONV1 + G - 1) / G; cbeg = bx * per; cend = cbeg + per < CONV1 ? cbeg + per : CONV1; if (cbeg > CONV1) cbeg = CONV1; }
        const bool conv_first = ((bx >> 3) & 1) != 0;
        if (conv_first) { moe_convert(a, lds, cbeg, cend, wave, lane); __syncthreads(); }
        pg8::Gemm g{D, D, D};
        Sched1 S{G, bx, (const char*)(ws + WS_XN), (const char*)(ws + WS_W1T), (const char*)(ws + WS_W2T)};
        Epi1 E{PB, VT, (bf16*)(ws + WS_QB), (bf16*)(ws + WS_KB), stats, a.in[3], a.in[4], (LAS float*)(lds + SCR_OFF)};
        pg8::gemm_phase<Epi1, Sched1>(lds, g, S, E);
        { pg8::Gemm g8{D / 2, D / 2, D / 2};
          Sched1g S8{G, bx, (const char*)(ws + WS_XN8), (const char*)(ws + WS_WG8)};
          Epi1g E8{PB};
          pg8::gemm_phase<Epi1g, Sched1g, true>(lds, g8, S8, E8); }
        if (!conv_first) moe_convert(a, lds, cbeg, cend, wave, lane);
    }
    xcd_barrier(bar);

    if (PH_ON(2)) for (int task = gw; task < 4096; task += NGW) {
        if (task < 2048) attn_task((const bf16*)(ws + WS_QB), (const bf16*)(ws + WS_KB), VT, OA, task, lane);
        else sgu_task(a, PB, VT, stats, OB, task - 2048, lane);
    }
    xcd_barrier(bar);

    if (PH_ON(3)) {
        pg8::Gemm g{AW, AW, AW};
        Sched3 S{G, bx, (const char*)(ws + WS_OA), (const char*)(ws + WS_OB), (const char*)(ws + WS_WAT), (const char*)(ws + WS_WBT)};
        Epi3 E{PB, (bf16*)(ws + WS_Y)};
        pg8::gemm_phase<Epi3, Sched3>(lds, g, S, E);
    }
    xcd_barrier(bar);

    if (PH_ON(4)) {
        pg8::Gemm g{D, D, D};
        Sched4 S{G, bx, (const char*)(ws + WS_Y), (const char*)(ws + WS_WOT)};
        Epi4 E{a.in[0], a.out};
        pg8::gemm_phase<Epi4, Sched4>(lds, g, S, E);
    }
#if DBG_STAGE >= 5
    xcd_barrier(bar);

    if (PH_ON(5)) {
        LAS float* red = (LAS float*)lds;
        LAS float* ssqp = (LAS float*)(lds + 8 * 1056 * 4);
        LAS float* rinfo = ssqp + 256;
        LAS unsigned* lcnt = (LAS unsigned*)(rinfo + 384); LAS unsigned* lbase = lcnt + 32;
        const float* g2 = a.in[11]; const float* wrt = a.in[12]; const float* brt = a.in[13];
        for (int rb = bx; rb < T / 32; rb += G) {
            const int row0 = rb * 32, i = lane & 31, hk = lane >> 5, kb = wave * 256 + hk * 128;
            if (tid < 32) lcnt[tid] = 0u;
            const float* xr = a.out + (size_t)(row0 + i) * D + kb;
            f32x16 acc;
#pragma unroll
            for (int r = 0; r < 16; ++r) acc[r] = 0.f;
            float ssq = 0.f;
            for (int ch = 0; ch < 4; ++ch) {
                f32x4 xv[8];
#pragma unroll
                for (int q = 0; q < 8; ++q) xv[q] = *(const f32x4*)(xr + ch * 32 + q * 4);
#pragma unroll
                for (int q = 0; q < 8; ++q)
#pragma unroll
                    for (int jj = 0; jj < 4; ++jj) { const int k = kb + ch * 32 + q * 4 + jj; const float x = xv[q][jj];
                        const float bw = wrt[(size_t)k * NE + i] * g2[k];
                        acc = __builtin_amdgcn_mfma_f32_32x32x2f32(x, bw, acc, 0, 0, 0); ssq += x * x; }
            }
            ssq += __shfl_xor(ssq, 32);
            if (lane < 32) ssqp[wave * 32 + i] = ssq;
#pragma unroll
            for (int r = 0; r < 16; ++r) red[wave * 1056 + i * 33 + (r & 3) + 8 * (r >> 2) + 4 * hk] = acc[r];
            LDS_WAIT(); __syncthreads();
            if (tid < 32) {
                float sq = 0.f;
#pragma unroll
                for (int w = 0; w < 8; ++w) sq += ssqp[w * 32 + tid];
                const float rstd = rsqrtf(sq * (1.f / D) + EPS);
                float v0 = -3.0e38f, v1 = -3.0e38f, v2 = -3.0e38f, v3 = -3.0e38f; int i0 = 0, i1 = 0, i2 = 0, i3 = 0;
                for (int e = 0; e < NE; ++e) { float v = 0.f;
#pragma unroll
                    for (int w = 0; w < 8; ++w) v += red[w * 1056 + e * 33 + tid];
                    const float x = v * rstd + brt[e];
                    if (x > v3) { if (x > v2) { v3 = v2; i3 = i2; if (x > v1) { v2 = v1; i2 = i1; if (x > v0) { v1 = v0; i1 = i0; v0 = x; i0 = e; } else { v1 = x; i1 = e; } } else { v2 = x; i2 = e; } } else { v3 = x; i3 = e; } } }
                const float p1 = __expf(v1 - v0), p2 = __expf(v2 - v0), p3 = __expf(v3 - v0), inv = 1.f / (1.f + p1 + p2 + p3);
                const int t = row0 + tid;
                const unsigned l0 = __hip_atomic_fetch_add(lcnt + i0, 1u, __ATOMIC_RELAXED, __HIP_MEMORY_SCOPE_WORKGROUP), l1 = __hip_atomic_fetch_add(lcnt + i1, 1u, __ATOMIC_RELAXED, __HIP_MEMORY_SCOPE_WORKGROUP);
                const unsigned l2 = __hip_atomic_fetch_add(lcnt + i2, 1u, __ATOMIC_RELAXED, __HIP_MEMORY_SCOPE_WORKGROUP), l3 = __hip_atomic_fetch_add(lcnt + i3, 1u, __ATOMIC_RELAXED, __HIP_MEMORY_SCOPE_WORKGROUP);
                LDS_WAIT(); asm volatile("" ::: "memory");
                { const unsigned ne_ = lcnt[tid]; unsigned base_ = 0u; if (ne_) base_ = atomicAdd(ctl + CW_CNT + 64 * tid, ne_); lbase[tid] = base_; }
                LDS_WAIT(); asm volatile("" ::: "memory");
                const int r0 = (int)(lbase[i0] + l0), r1 = (int)(lbase[i1] + l1), r2 = (int)(lbase[i2] + l2), r3 = (int)(lbase[i3] + l3);
                tok_e[t * 4 + 0] = i0; tok_e[t * 4 + 1] = i1; tok_e[t * 4 + 2] = i2; tok_e[t * 4 + 3] = i3;
                tok_rank[t * 4 + 0] = r0; tok_rank[t * 4 + 1] = r1; tok_rank[t * 4 + 2] = r2; tok_rank[t * 4 + 3] = r3;
                tok_gate[t * 4 + 0] = inv; tok_gate[t * 4 + 1] = p1 * inv; tok_gate[t * 4 + 2] = p2 * inv; tok_gate[t * 4 + 3] = p3 * inv;
                LAS float* ri = rinfo + tid * 12; ri[0] = rstd;
                ri[1] = __int_as_float(i0); ri[2] = __int_as_float(i1); ri[3] = __int_as_float(i2); ri[4] = __int_as_float(i3);
                ri[5] = __int_as_float(r0); ri[6] = __int_as_float(r1); ri[7] = __int_as_float(r2); ri[8] = __int_as_float(r3);
            }
            LDS_WAIT(); __syncthreads();
            unsigned char* XG = ws + WS_XG;
            for (int rr = 0; rr < 4; ++rr) { const int il = wave * 4 + rr; const LAS float* ri = rinfo + il * 12;
                const float rstd = ri[0];
                size_t dsto[4];
#pragma unroll
                for (int k = 0; k < 4; ++k) dsto[k] = ((size_t)__float_as_int(ri[1 + k]) * T + (size_t)__float_as_int(ri[5 + k])) * D;
                const f32x4* hr = (const f32x4*)(a.out + (size_t)(row0 + il) * D) + lane;
#pragma unroll
                for (int j = 0; j < 8; ++j) { const f32x4 v = hr[64 * j]; const f32x4 gg = *((const f32x4*)g2 + lane + 64 * j);
                    const float rs8 = rstd * SC_X8; const unsigned o = pk4_fp8(v.x * rs8 * gg.x, v.y * rs8 * gg.y, v.z * rs8 * gg.z, v.w * rs8 * gg.w);
#pragma unroll
                    for (int k = 0; k < 4; ++k) *((unsigned*)(XG + dsto[k]) + lane + 64 * j) = o; } }
            LDS_WAIT(); __syncthreads();
        }
    }
    xcd_barrier(bar);

    if (tid < NE) MISC[MW_CNT + tid] = __hip_atomic_load(ctl + CW_CNT + 64 * tid, __ATOMIC_RELAXED, __HIP_MEMORY_SCOPE_AGENT);
    LDS_WAIT(); __syncthreads();
    if (tid < 64) {
        const unsigned n = tid < NE ? MISC[MW_CNT + tid] : 0u, mt = (n + 255u) >> 8;
        unsigned so = n, su = mt;
#pragma unroll
        for (int o = 1; o < 32; o <<= 1) { const unsigned a_ = __shfl_up(so, o), b_ = __shfl_up(su, o); if ((tid & 63) >= o) { so += a_; su += b_; } }
        if (tid < NE) { MISC[MW_OFF + tid] = so - n; MISC[MW_US6 + tid] = (su - mt) * 16u; MISC[MW_US7 + tid] = (su - mt) * 8u; }
        if (tid == NE - 1) { MISC[MW_US6 + NE] = su * 16u; MISC[MW_US7 + NE] = su * 8u; }
    }
    LDS_WAIT(); __syncthreads();

    if (PH_ON(6)) {
        pg8::Gemm g{D / 2, D / 2, D / 2};
        constexpr int NSTREAM = 8;
        const bool split = (G == 256);
        SchedMoE<6> S{G, vcu, MISC, (const char*)(ws + WS_XG), (const char*)(ws + WS_WUT), split ? 32 - NSTREAM : 32};
        Epi6 E{a.in[15], ws + WS_ACT};
        if (split && (vcu & 31) >= 32 - NSTREAM) { constexpr int NUP6 = NE * I_UP1, NDN6 = NE * I_DN1, PER = NDN6 / (8 * NSTREAM); static_assert(PER * 8 * NSTREAM == NDN6, "w_down shares");
            const int sidx = (vcu >> 5) * NSTREAM + ((vcu & 31) - (32 - NSTREAM)); moe_convert(a, lds, NUP6 + sidx * PER, NUP6 + (sidx + 1) * PER, wave, lane); __syncthreads(); }
        pg8::gemm_phase<Epi6, SchedMoE<6>, true>(lds, g, S, E);
    }
    xcd_barrier(bar);

    if (PH_ON(7)) {
        pg8::Gemm g{DE / 2, DE / 2, DE / 2};
        SchedMoE<7> S{G, vcu, MISC, (const char*)(ws + WS_ACT), (const char*)(ws + WS_WDT), 32};
        Epi7 E{a.in[17], (bf16*)(ws + WS_YM)};
        pg8::gemm_phase<Epi7, SchedMoE<7>, true>(lds, g, S, E);
    }
    xcd_barrier(bar);

    if (PH_ON(8)) {
        const bf16* YM = (const bf16*)(ws + WS_YM);
        for (int t = gw; t < T; t += NGW) {
            size_t pos[4]; float gt[4];
#pragma unroll
            for (int k = 0; k < 4; ++k) { const int e = tok_e[t * 4 + k], rk = tok_rank[t * 4 + k]; gt[k] = tok_gate[t * 4 + k]; pos[k] = ((size_t)MISC[MW_OFF + e] + (size_t)rk) * D; }
            f32x4* orow = (f32x4*)(a.out + (size_t)t * D) + lane;
#pragma unroll
            for (int j = 0; j < 8; ++j) { f32x4 o = orow[64 * j];
#pragma unroll
                for (int k = 0; k < 4; ++k) { const u32x2 y = __builtin_nontemporal_load((const u32x2*)(YM + pos[k]) + lane + 64 * j);
                    o.x += gt[k] * bf_lo(y.x); o.y += gt[k] * bf_hi(y.x); o.z += gt[k] * bf_lo(y.y); o.w += gt[k] * bf_hi(y.y); }
                __builtin_nontemporal_store(o, orow + 64 * j); }
        }
    }
#endif
}

extern "C" void kernel_launch(void* const* d_in, const int* in_sizes, int n_in, void* d_out, int out_size, void* d_ws, size_t ws_size, hipStream_t stream) {
    static int grid = 0;
    if (grid == 0) {
        if (n_in != 18 || out_size != T * D || ws_size < WS_END) { fprintf(stderr, "kernel_launch: unexpected shapes (n_in %d, out %d, ws %zu)\n", n_in, out_size, ws_size); grid = -1; return; }
        int dev = 0, cus = 0, per_cu = 0;
        if (hipGetDevice(&dev) != hipSuccess || hipDeviceGetAttribute(&cus, hipDeviceAttributeMultiprocessorCount, dev) != hipSuccess) { grid = -1; return; }
        if (hipFuncSetAttribute((const void*)fwd, hipFuncAttributeMaxDynamicSharedMemorySize, LDS_BYTES) != hipSuccess) { fprintf(stderr, "kernel_launch: hipFuncSetAttribute failed\n"); grid = -1; return; }
        if (hipOccupancyMaxActiveBlocksPerMultiprocessor(&per_cu, (const void*)fwd, NWAVES * 64, LDS_BYTES) != hipSuccess || per_cu < 1) { fprintf(stderr, "kernel_launch: occupancy query says %d\n", per_cu); }
        (void)hipGetLastError();
        grid = cus;
        if (per_cu < 1) grid = -1;
    }
    if (grid < 0) return;
    if (hipMemsetAsync((char*)d_ws + WS_CTL, 0, CTL_ZERO_BYTES, stream) != hipSuccess) return;
    Args a{};
    for (int i = 0; i < 18; ++i) a.in[i] = (const float*)d_in[i];
    a.out = (float*)d_out; a.ws = (unsigned char*)d_ws;
    hipLaunchKernelGGL(fwd, dim3(grid), dim3(NWAVES * 64), LDS_BYTES, stream, a);
}
```

```cpp
#ifndef MOE_TAIL_TEST
#define MOE_TAIL_TEST 0
#endif
#include <hip/hip_runtime.h>
#include <cstdio>
#include <cstdint>

#ifndef DBG_STAGE
#define DBG_STAGE 99
#endif
#ifndef PH_MASK
#define PH_MASK 0x1ff
#endif
#define PH_ON(p) ((PH_MASK >> (p)) & 1)

#define LAS __attribute__((address_space(3)))
#define GAS __attribute__((address_space(1)))
typedef unsigned short bf16;
typedef short bf16x8 __attribute__((ext_vector_type(8)));
typedef float f32x4 __attribute__((ext_vector_type(4)));
typedef float f32x2 __attribute__((ext_vector_type(2)));
typedef float f32x16 __attribute__((ext_vector_type(16)));
typedef unsigned u32x4 __attribute__((ext_vector_type(4)));
typedef unsigned u32x2 __attribute__((ext_vector_type(2)));
typedef int i32x8 __attribute__((ext_vector_type(8)));
typedef int i32x4 __attribute__((ext_vector_type(4)));

constexpr int T = 8192, D = 2048, SEQ = 4096, NH = 8, HD = 128, AW = 1024, SW = 1024, PW = 9216, NE = 32, TOPK = 4, DE = 2048;
constexpr int C_GB_END_BF = 5120;
constexpr int N1 = 7168;
constexpr int C_Q = 0, C_K = 1024, C_U = 2048, C_GA = 3072, C_GB = 5120;
constexpr float EPS = 1e-6f;
constexpr int NWAVES = 8;

constexpr size_t MiB = 1u << 20;
constexpr size_t WS_CTL = 0, CTL_ZERO_BYTES = 64 * 1024;
constexpr size_t WS_W1T = 2 * MiB;
constexpr size_t WS_W2T = 32 * MiB;
constexpr size_t WS_WAT = 40 * MiB;
constexpr size_t WS_WBT = 44 * MiB;
constexpr size_t WS_WOT = 48 * MiB;
constexpr size_t WS_WG8 = 56 * MiB;
constexpr size_t WS_XN = 64 * MiB;
constexpr size_t WS_PB = 96 * MiB;
constexpr size_t WS_VT = 208 * MiB;
constexpr size_t WS_OA = 240 * MiB;
constexpr size_t WS_OB = 256 * MiB;
constexpr size_t WS_QB = 272 * MiB;
constexpr size_t WS_KB = 288 * MiB;
constexpr size_t WS_XN8 = 304 * MiB;
constexpr size_t WS_Y = 336 * MiB;
constexpr size_t WS_ROUTE = 368 * MiB;
constexpr size_t WS_STATS = 369 * MiB;
constexpr size_t WS_ACT = 370 * MiB;
constexpr size_t WS_YM = 500 * MiB;
constexpr size_t WS_WUT = 640 * MiB;
constexpr size_t WS_WDT = 1152 * MiB;
constexpr size_t WS_XG = 1408 * MiB;
constexpr size_t WS_END = 2432 * MiB;
constexpr int CW_BAR = 4096;
constexpr int CW_CNT = 8192;
constexpr int CW_STATS = 16384;

constexpr int RING_BYTES = 131072;
constexpr int SCR_OFF = RING_BYTES;
constexpr int MISC_OFF = RING_BYTES + 8192;
constexpr int LDS_BYTES = RING_BYTES + 8192 + 2048;
constexpr int MW_BAR = 8;
constexpr int MW_CNT = 32, MW_OFF = 64, MW_US6 = 96, MW_US7 = 160;

#define LDS_WAIT() asm volatile("s_waitcnt lgkmcnt(0)" ::: "memory")
#define VM_WAIT() asm volatile("s_waitcnt vmcnt(0)" ::: "memory")

__device__ __forceinline__ unsigned cvt_pk_bf16(float lo, float hi) { unsigned r; asm volatile("v_cvt_pk_bf16_f32 %0, %1, %2" : "=v"(r) : "v"(lo), "v"(hi)); return r; }
__device__ __forceinline__ unsigned pk4_fp8(float a, float b, float c, float d) {
    a = __builtin_amdgcn_fmed3f(a, -448.f, 448.f); b = __builtin_amdgcn_fmed3f(b, -448.f, 448.f); c = __builtin_amdgcn_fmed3f(c, -448.f, 448.f); d = __builtin_amdgcn_fmed3f(d, -448.f, 448.f);
    int r = 0; r = __builtin_amdgcn_cvt_pk_fp8_f32(a, b, r, false); r = __builtin_amdgcn_cvt_pk_fp8_f32(c, d, r, true); return (unsigned)r; }
constexpr float SC_W8 = 64.f, SC_X8 = 4.f, SC_A8 = 2.f, SC_XN8 = 16.f;
__device__ __forceinline__ float bf_lo(unsigned u) { return __uint_as_float(u << 16); }
__device__ __forceinline__ float bf_hi(unsigned u) { return __uint_as_float(u & 0xffff0000u); }
__device__ __forceinline__ float fast_rcp(float x) { return __builtin_amdgcn_rcpf(x); }
__device__ __forceinline__ float sigmoid_f(float x) { return fast_rcp(1.f + __builtin_amdgcn_exp2f(-1.4426950408889634f * x)); }
__device__ __forceinline__ float gelu_tanh_f(float x) { const float in = -2.302208198f * (x + 0.044715f * x * x * x); return x * fast_rcp(1.f + __builtin_amdgcn_exp2f(in)); }
__device__ __forceinline__ float wave_sum(float v) {
#pragma unroll
    for (int o = 1; o < 64; o <<= 1) v += __shfl_xor(v, o);
    return v;
}

namespace pg8 {
constexpr int BM = 256, BK = 64, HALF = 128, HTB = HALF * BK * 2, STAGE_BYTES = 8 * HTB;
__host__ __device__ __forceinline__ int lds_byte(int r, int c) { const int st = (r >> 4) * 2 + (c >> 5), rr = r & 15, cc = c & 31, ob = rr * 64 + cc * 2; return st * 1024 + (ob ^ (((ob >> 9) & 1) << 5)); }
__host__ __device__ __forceinline__ void stage_rc(int b, int& R, int& C) { const int st = b / 1024, sb = b % 1024, swz = sb ^ (((sb >> 9) & 1) << 5); R = (st >> 1) * 16 + swz / 64; C = (st & 1) * 32 + (swz % 64) / 2; }
__host__ __device__ __forceinline__ int perm32(int rho) { const int n = rho >> 4, i = rho & 15; return 8 * (i >> 2) + 4 * n + (i & 3); }

struct Unit { const char* A; const char* B; int kind, pm, pn, e, nvalid, rbase; };
struct Gemm { int lda, ldb, K; };

__device__ __forceinline__ void tile_order(int L, int nM, int nN, int& pm, int& pn) {
    const int nwg = nM * nN; int wgid = L;
    { const int q = nwg / 8, r = nwg % 8, xcd = wgid % 8, off = wgid / 8; wgid = (xcd < r ? xcd * (q + 1) : r * (q + 1) + (xcd - r) * q) + off; }
    const int nig = 8 * nN, gid = wgid / nig, fm = gid * 8, gsz = (nM - fm) < 8 ? (nM - fm) : 8;
    pm = fm + ((wgid % nig) % gsz); pn = (wgid % nig) / gsz;
}

template <class Epi, class Sched, bool F8 = false>
__device__ __forceinline__ void gemm_phase(LAS unsigned char* lds, const Gemm g, const Sched& S, const Epi& E) {
    int tid_ = threadIdx.x; asm volatile("" : "+v"(tid_));
    const int tid = tid_, wid = __builtin_amdgcn_readfirstlane(tid >> 6), lane = tid & 63, wr = wid >> 2, wc = wid & 3, fr = lane & 15, fq = lane >> 4;
    const int K = g.K, nt = K / BK;
    unsigned voffA[2], voffB[2];
#pragma unroll
    for (int i = 0; i < 2; ++i) { int R, C; stage_rc(tid * 16 + i * 8192, R, C); const int Rb = Epi::PERM ? ((R & ~31) + perm32(R & 31)) : R;
        voffA[i] = (unsigned)(R * g.lda + C) * 2u; voffB[i] = (unsigned)(Rb * g.ldb + C) * 2u; }
    const size_t kstep = (size_t)(BK * 2);
    const size_t hstepA = (size_t)HALF * g.lda * 2, hstepB = (size_t)HALF * g.ldb * 2;
    const unsigned ldsw = (unsigned)wid * 1024u;
    const int aoff = lds_byte(wr * 64 + fr, fq * 8), boff = lds_byte(wc * 32 + fr, fq * 8);
#define PG8_SA(b, h) (((b) * 2 + (h)) * HTB)
#define PG8_SB(b, h) ((4 + (b) * 2 + (h)) * HTB)
#define PG8_STAGE(bufoff, gbase, voff) do { _Pragma("unroll") for (int _i = 0; _i < 2; ++_i) \
        __builtin_amdgcn_global_load_lds((const unsigned*)((const char*)(gbase) + (voff)[_i]), (LAS unsigned*)(lds + (bufoff) + ldsw + _i * 8192), 16, 0, 0); } while (0)
#define PG8_LDA(dst, b, h) do { _Pragma("unroll") for (int m = 0; m < 4; ++m) { const i32x4 lo_ = *(const LAS i32x4*)(lds + PG8_SA(b, h) + aoff + m * 2048), hi_ = *(const LAS i32x4*)(lds + PG8_SA(b, h) + aoff + m * 2048 + 1024); \
        dst[m] = __builtin_shufflevector(lo_, hi_, 0, 1, 2, 3, 4, 5, 6, 7); } } while (0)
#define PG8_LDB(dst, b, h) do { _Pragma("unroll") for (int n = 0; n < 2; ++n) { const i32x4 lo_ = *(const LAS i32x4*)(lds + PG8_SB(b, h) + boff + n * 2048), hi_ = *(const LAS i32x4*)(lds + PG8_SB(b, h) + boff + n * 2048 + 1024); \
        dst[n] = __builtin_shufflevector(lo_, hi_, 0, 1, 2, 3, 4, 5, 6, 7); } } while (0)
#define PG8_MMA(ai, bj, At, Bt) do { __builtin_amdgcn_s_setprio(1); _Pragma("unroll") for (int m = 0; m < 4; ++m) _Pragma("unroll") for (int n = 0; n < 2; ++n) { \
        if constexpr (F8) { asm volatile("v_mfma_f32_16x16x128_f8f6f4 %0, %1, %2, %0" : "+v"(acc[ai][bj][m][n]) : "v"(Bt[n]), "v"(At[m])); } \
        else { acc[ai][bj][m][n] = __builtin_amdgcn_mfma_f32_16x16x32_bf16(__builtin_bit_cast(bf16x8, __builtin_shufflevector(Bt[n], Bt[n], 0, 1, 2, 3)), __builtin_bit_cast(bf16x8, __builtin_shufflevector(At[m], At[m], 0, 1, 2, 3)), acc[ai][bj][m][n], 0, 0, 0); \
               acc[ai][bj][m][n] = __builtin_amdgcn_mfma_f32_16x16x32_bf16(__builtin_bit_cast(bf16x8, __builtin_shufflevector(Bt[n], Bt[n], 4, 5, 6, 7)), __builtin_bit_cast(bf16x8, __builtin_shufflevector(At[m], At[m], 4, 5, 6, 7)), acc[ai][bj][m][n], 0, 0, 0); } } \
        __builtin_amdgcn_s_setprio(0); } while (0)
#define PG8_WAIT_V(n) asm volatile("s_waitcnt vmcnt(" #n ")" ::: "memory")
#define PG8_WAIT_L(n) asm volatile("s_waitcnt lgkmcnt(" #n ")" ::: "memory")
#define PG8_BAR __builtin_amdgcn_s_barrier()
#define PG8_SCHED __builtin_amdgcn_sched_barrier(0)
    Unit cur, nxt; int ui = 0;
    if (!S.next(0, cur)) return;
    f32x4 acc[2][2][4][2];
#pragma unroll
    for (int a = 0; a < 2; ++a)
#pragma unroll
        for (int b = 0; b < 2; ++b)
#pragma unroll
            for (int m = 0; m < 4; ++m)
#pragma unroll
                for (int n = 0; n < 2; ++n) acc[a][b][m][n] = (f32x4){0.f, 0.f, 0.f, 0.f};
    i32x8 At[4], B0[2], B1[2];
    const char* cA = cur.A; const char* cB = cur.B;
    PG8_STAGE(PG8_SB(0, 0), cB, voffB); PG8_STAGE(PG8_SB(0, 1), cB + hstepB, voffB); PG8_STAGE(PG8_SA(0, 0), cA, voffA); PG8_STAGE(PG8_SA(0, 1), cA + hstepA, voffA);
    if (wr == 1) PG8_BAR;
    PG8_WAIT_V(2); PG8_BAR;
    PG8_STAGE(PG8_SB(1, 0), cB + kstep, voffB); PG8_STAGE(PG8_SA(1, 0), cA + kstep, voffA); PG8_STAGE(PG8_SB(1, 1), cB + hstepB + kstep, voffB);
    PG8_WAIT_V(6); PG8_BAR;
    for (;;) {
        const bool has_next = S.next(ui + 1, nxt);
        const char* nA = has_next ? nxt.A : cA; const char* nB = has_next ? nxt.B : cB;
        const bool full = cur.nvalid > HALF;
        for (int t = 0; t < nt; t += 2) {
            const bool last = (t == nt - 2);
            const char* a1 = cA + (size_t)(t + 1) * kstep;
            const char* a2 = last ? nA : cA + (size_t)(t + 2) * kstep; const char* b2 = last ? nB : cB + (size_t)(t + 2) * kstep;
            const char* a3 = a2 + kstep; const char* b3 = b2 + kstep;
            PG8_LDB(B0, 0, 0); PG8_LDB(B1, 0, 1); PG8_SCHED; PG8_LDA(At, 0, 0); PG8_STAGE(PG8_SA(1, 1), a1 + hstepA, voffA);
            PG8_WAIT_V(8); PG8_WAIT_L(0); PG8_BAR; PG8_MMA(0, 0, At, B0); PG8_MMA(0, 1, At, B1); PG8_BAR; PG8_SCHED;
            if (!F8 || full) PG8_LDA(At, 0, 1); PG8_STAGE(PG8_SB(0, 0), b2, voffB); PG8_STAGE(PG8_SB(0, 1), b2 + hstepB, voffB); PG8_STAGE(PG8_SA(0, 0), a2, voffA);
            PG8_WAIT_V(8); PG8_WAIT_L(0); PG8_BAR; if (!F8 || full) { PG8_MMA(1, 0, At, B0); PG8_MMA(1, 1, At, B1); } PG8_BAR; PG8_SCHED;
            PG8_LDB(B0, 1, 0); PG8_LDB(B1, 1, 1); PG8_SCHED; PG8_LDA(At, 1, 0); PG8_STAGE(PG8_SA(0, 1), a2 + hstepA, voffA);
            PG8_WAIT_V(8); PG8_WAIT_L(0); PG8_BAR; PG8_MMA(0, 0, At, B0); PG8_MMA(0, 1, At, B1); PG8_BAR; PG8_SCHED;
            if (!F8 || full) PG8_LDA(At, 1, 1); PG8_STAGE(PG8_SB(1, 0), b3, voffB); PG8_STAGE(PG8_SB(1, 1), b3 + hstepB, voffB); PG8_STAGE(PG8_SA(1, 0), a3, voffA);
            PG8_WAIT_V(8); PG8_WAIT_L(0); PG8_BAR; if (!F8 || full) { PG8_MMA(1, 0, At, B0); PG8_MMA(1, 1, At, B1); } PG8_BAR; PG8_SCHED;
        }
        if constexpr (F8) asm volatile("s_nop 15\n\ts_nop 15\n\ts_nop 7" ::: "memory");
        if (wr == 0) PG8_BAR;
        E(acc, cur, wr, wc, fr, fq);
        if (!has_next) break;
        if (!(Epi::CHAIN && cur.kind == 0)) {
#pragma unroll
        for (int a = 0; a < 2; ++a)
#pragma unroll
            for (int b = 0; b < 2; ++b)
#pragma unroll
                for (int m = 0; m < 4; ++m)
#pragma unroll
                    for (int n = 0; n < 2; ++n) acc[a][b][m][n] = (f32x4){0.f, 0.f, 0.f, 0.f};
        }
        cur = nxt; cA = nA; cB = nB; ++ui;
        if (wr == 1) PG8_BAR;
    }
    PG8_WAIT_V(0);
    PG8_BAR;
#undef PG8_SA
#undef PG8_SB
#undef PG8_STAGE
#undef PG8_LDA
#undef PG8_LDB
#undef PG8_MMA
#undef PG8_WAIT_V
#undef PG8_WAIT_L
#undef PG8_BAR
#undef PG8_SCHED
}
}
using pg8::Unit;

#define XB_TMO      128
#define XB_XCNT(j)  (256  + 64 * (j))
#define XB_XSUB(j)  (1280 + 64 * (j))
#define XB_XGEN(j)  (2304 + 64 * (j))
#define XB_TOP      3328
#define XB_TOPGEN   3392
#define XCD_BAR_WORDS 3456
#define XB_SPIN_CAP (1u << 18)
__device__ __forceinline__ unsigned xb_ld(unsigned* p)              { return __hip_atomic_load(p, __ATOMIC_RELAXED, __HIP_MEMORY_SCOPE_AGENT); }
__device__ __forceinline__ unsigned xb_add(unsigned* p, unsigned v) { return __hip_atomic_fetch_add(p, v, __ATOMIC_RELAXED, __HIP_MEMORY_SCOPE_AGENT); }
__device__ __forceinline__ unsigned xb_xcc_id() { return (unsigned)__builtin_amdgcn_s_getreg((3 << 11) | 20) & 0xFu; }
#define XB_SPIN(cond, bar) do { unsigned _sp = 0; while (cond) { __builtin_amdgcn_s_sleep(1); \
    if ((++_sp & 255u) == 0u) { if (xb_ld(&(bar)[XB_TMO])) break; if (_sp > XB_SPIN_CAP) { atomicAdd(&(bar)[XB_TMO], 1u); break; } } } } while (0)
struct XcdBarrier { unsigned* bar; unsigned x; volatile LAS unsigned* st; };
__device__ __forceinline__ XcdBarrier xcd_barrier_post(unsigned* bar, volatile LAS unsigned* st) {
    XcdBarrier b; b.bar = bar; b.x = xb_xcc_id(); b.st = st;
    if (threadIdx.x == 0) (void)xb_add(&bar[XB_XCNT(b.x)], 1u);
    return b;
}
__device__ __forceinline__ void xcd_barrier_complete(unsigned* bar, unsigned x, unsigned& nloc, unsigned& nx) {
    const unsigned G = gridDim.x * gridDim.y * gridDim.z;
    unsigned sum, cnt, mine, sp = 0u;
    for (;;) {
        sum = 0u; cnt = 0u; mine = 0u;
#pragma unroll
        for (unsigned j = 0; j < 16; ++j) { const unsigned c = xb_ld(&bar[XB_XCNT(j)]); sum += c; cnt += (c > 0u) ? 1u : 0u; mine = (j == x) ? c : mine; }
        if (sum == G) break;
        __builtin_amdgcn_s_sleep(1);
        if ((++sp & 255u) == 0u) { if (xb_ld(&bar[XB_TMO])) break; if (sp > XB_SPIN_CAP) { atomicAdd(&bar[XB_TMO], 1u); break; } }
    }
    nloc = mine > 0u ? mine : 1u; nx = cnt > 0u ? cnt : 1u;
}
__device__ __forceinline__ void xcd_barrier(const XcdBarrier& b) {
    asm volatile("s_waitcnt vmcnt(0)" ::: "memory");
    __syncthreads();
    if (threadIdx.x == 0) {
        unsigned* bar = b.bar;
        __builtin_amdgcn_s_waitcnt(0);
        unsigned nloc = b.st[0], nx = b.st[1];
        if (nloc == 0u) { xcd_barrier_complete(bar, b.x, nloc, nx); b.st[0] = nloc; b.st[1] = nx; }
        const unsigned old = xb_add(&bar[XB_XSUB(b.x)], 1u);
        const unsigned gen = old / nloc;
        if (old + 1u == (gen + 1u) * nloc) {
            __builtin_amdgcn_fence(__ATOMIC_RELEASE, "agent");
            asm volatile("s_waitcnt vmcnt(0)" ::: "memory");
            const unsigned og = xb_add(&bar[XB_TOP], 1u);
            const unsigned tg = og / nx;
            if (og + 1u == (tg + 1u) * nx) xb_add(&bar[XB_TOPGEN], 1u);
            else XB_SPIN(xb_ld(&bar[XB_TOPGEN]) == tg, bar);
            __builtin_amdgcn_fence(__ATOMIC_ACQUIRE, "agent");
            xb_add(&bar[XB_XGEN(b.x)], 1u);
            asm volatile("s_waitcnt vmcnt(0)" ::: "memory");
        } else {
            XB_SPIN(xb_ld(&bar[XB_XGEN(b.x)]) == gen, bar);
            __builtin_amdgcn_fence(__ATOMIC_ACQUIRE, "agent");
            asm volatile("s_waitcnt vmcnt(0)" ::: "memory");
        }
    }
    __syncthreads();
}

struct Args { const float* in[18]; float* out; unsigned char* ws; };

constexpr int I_UP1 = (D / 128) * (2 * DE / 32);
constexpr int I_DN1 = (DE / 128) * (D / 32);
constexpr int MOE_ITEMS = NE * (I_UP1 + I_DN1);
struct MoeItem { const float* src; unsigned char* dst; int ldw; };
__device__ __forceinline__ MoeItem moe_item(const Args& a, int r) {
    MoeItem m; unsigned char* ws = a.ws;
    if (r < NE * I_UP1) { const int e = r / I_UP1, q = r % I_UP1; const int nblk = 2 * DE / 32, kb = q / nblk, nb = q % nblk, k0 = kb * 128, n0 = nb * 32;
        const int nn = n0 < DE ? n0 : n0 - DE; const int row = (nn >> 7) * 256 + (nn & 127) + (n0 < DE ? 0 : 128);
        m.src = a.in[14] + ((size_t)e * D + k0) * (2 * DE) + n0; m.ldw = 2 * DE; m.dst = ws + WS_WUT + ((size_t)e * 2 * DE + row) * D + k0; }
    else { r -= NE * I_UP1; const int e = r / I_DN1, q = r % I_DN1; const int nblk = D / 32, kb = q / nblk, nb = q % nblk, k0 = kb * 128, n0 = nb * 32;
        m.src = a.in[16] + ((size_t)e * DE + k0) * D + n0; m.ldw = D; m.dst = ws + WS_WDT + ((size_t)e * D + n0) * DE + k0; }
    return m;
}
__device__ __forceinline__ void moe_load(f32x4 (&v)[16], const MoeItem& m, int lane) {
#pragma unroll
    for (int j = 0; j < 16; ++j) v[j] = __builtin_nontemporal_load((const f32x4*)(m.src + (size_t)(16 * (lane >> 3) + j) * m.ldw + 4 * (lane & 7)));
}
__device__ __forceinline__ void moe_store(const f32x4 (&v)[16], unsigned char* dst, int lane) {
#pragma unroll
    for (int i = 0; i < 4; ++i) { u32x4 o;
        o.x = pk4_fp8(v[0][i] * SC_W8, v[1][i] * SC_W8, v[2][i] * SC_W8, v[3][i] * SC_W8); o.y = pk4_fp8(v[4][i] * SC_W8, v[5][i] * SC_W8, v[6][i] * SC_W8, v[7][i] * SC_W8);
        o.z = pk4_fp8(v[8][i] * SC_W8, v[9][i] * SC_W8, v[10][i] * SC_W8, v[11][i] * SC_W8); o.w = pk4_fp8(v[12][i] * SC_W8, v[13][i] * SC_W8, v[14][i] * SC_W8, v[15][i] * SC_W8);
        __builtin_nontemporal_store(o, (u32x4*)(dst + (size_t)(4 * (lane & 7) + i) * DE + 16 * (lane >> 3))); }
}
__device__ __forceinline__ void moe_convert(const Args& a, LAS unsigned char* lds, int begin, int end, int wave, int lane) {
    int it = begin + wave;
    if (it >= end) return;
    f32x4 cur[16], nxt[16];
    MoeItem mc = moe_item(a, it);
    moe_load(cur, mc, lane);
    for (;;) {
        const int itn = it + NWAVES; const bool more = itn < end;
        MoeItem mn = mc;
        if (more) { mn = moe_item(a, itn); moe_load(nxt, mn, lane); }
        moe_store(cur, mc.dst, lane);
        if (!more) break;
#pragma unroll
        for (int j = 0; j < 16; ++j) cur[j] = nxt[j];
        mc = mn; it = itn;
    }
}

struct P0Item { const float* src; bf16* dst; int ldw, ldt; };
__device__ __forceinline__ P0Item p0_item(const Args& a, int r) {
    constexpr int I_IN = (D / 64) * (C_GB_END_BF / 32), I_A = (AW / 64) * (D / 32);
    unsigned char* ws = a.ws; bf16* W1T = (bf16*)(ws + WS_W1T); bf16* W2T = (bf16*)(ws + WS_W2T);
    P0Item m;
    if (r < I_IN) { const int nblk = C_GB_END_BF / 32, kb = r / nblk, nb = r % nblk, k0 = kb * 64, n0 = nb * 32;
        bf16* dst;
        if (n0 < 2048) dst = W1T + (size_t)n0 * D; else if (n0 < 3072) dst = W2T + (size_t)(n0 - 2048) * D; else if (n0 < 4096) dst = W1T + (size_t)(n0 - 1024) * D;
        else dst = W2T + (size_t)(n0 - 3072) * D;
        m.src = a.in[2] + (size_t)k0 * PW + n0; m.ldw = PW; m.dst = dst + k0; m.ldt = D; return m; }
    r -= I_IN;
    const int nblk = D / 32;
    if (r < I_A) { const int kb2 = r / nblk, nb = r % nblk, k0 = kb2 * 64, n0 = nb * 32; m.src = a.in[8] + (size_t)k0 * D + n0; m.ldw = D; m.dst = (bf16*)(ws + WS_WAT) + (size_t)n0 * AW + k0; m.ldt = AW; return m; }
    r -= I_A;
    if (r < I_A) { const int kb2 = r / nblk, nb = r % nblk, k0 = kb2 * 64, n0 = nb * 32; m.src = a.in[9] + (size_t)k0 * D + n0; m.ldw = D; m.dst = (bf16*)(ws + WS_WBT) + (size_t)n0 * SW + k0; m.ldt = SW; return m; }
    r -= I_A;
    { const int kb2 = r / nblk, nb = r % nblk, k0 = kb2 * 64, n0 = nb * 32; m.src = a.in[10] + (size_t)k0 * D + n0; m.ldw = D; m.dst = (bf16*)(ws + WS_WOT) + (size_t)n0 * D + k0; m.ldt = D; return m; }
}
__device__ __forceinline__ void p0_load(f32x4 (&v)[8], const P0Item& m, int lane) {
#pragma unroll
    for (int j = 0; j < 8; ++j) v[j] = __builtin_nontemporal_load((const f32x4*)(m.src + (size_t)(8 * (lane >> 3) + j) * m.ldw + 4 * (lane & 7)));
}
__device__ __forceinline__ void p0_store(const f32x4 (&v)[8], const P0Item& m, int lane) {
#pragma unroll
    for (int i = 0; i < 4; ++i) { u32x4 o; o.x = cvt_pk_bf16(v[0][i], v[1][i]); o.y = cvt_pk_bf16(v[2][i], v[3][i]); o.z = cvt_pk_bf16(v[4][i], v[5][i]); o.w = cvt_pk_bf16(v[6][i], v[7][i]);
        *(u32x4*)(m.dst + (size_t)(4 * (lane & 7) + i) * m.ldt + 8 * (lane >> 3)) = o; }
}
__device__ __forceinline__ void p0_prologue(const Args& a, LAS unsigned char* lds, int vcu, int G, int wave, int lane) {
    unsigned char* ws = a.ws;
    const int gw = vcu * NWAVES + wave, NGW = G * NWAVES;
    constexpr int NITEMS = (D / 64) * (C_GB_END_BF / 32) + 2 * (AW / 64) * (D / 32) + (D / 64) * (D / 32);
    for (int it = gw; it < (D / 128) * ((PW - C_GB_END_BF) / 32); it += NGW) { const int nblk = (PW - C_GB_END_BF) / 32, kb = it / nblk, nb = it % nblk;
        MoeItem m; m.src = a.in[2] + (size_t)(kb * 128) * PW + C_GB_END_BF + nb * 32; m.ldw = PW; m.dst = ws + WS_WG8 + (size_t)(nb * 32) * D + kb * 128;
        f32x4 v[16]; moe_load(v, m, lane); moe_store(v, m.dst, lane); }
    if (gw < NITEMS) {
        int it = gw; f32x4 cur[8], nxt[8]; P0Item mc = p0_item(a, it); p0_load(cur, mc, lane);
        for (;;) { const int itn = it + NGW; const bool more = itn < NITEMS; P0Item mn = mc;
            if (more) { mn = p0_item(a, itn); p0_load(nxt, mn, lane); }
            p0_store(cur, mc, lane);
            if (!more) break;
#pragma unroll
            for (int j = 0; j < 8; ++j) cur[j] = nxt[j];
            mc = mn; it = itn; }
    }
    const float* g1 = a.in[1];
    if (gw < T) {
        int m = gw; f32x4 v[8], vn[8];
        { const f32x4* xr = (const f32x4*)(a.in[0] + (size_t)m * D) + lane;
#pragma unroll
          for (int j = 0; j < 8; ++j) v[j] = __builtin_nontemporal_load(xr + 64 * j); }
        for (;;) { const int mn = m + NGW; const bool more = mn < T;
            if (more) { const f32x4* xr = (const f32x4*)(a.in[0] + (size_t)mn * D) + lane;
#pragma unroll
                for (int j = 0; j < 8; ++j) vn[j] = __builtin_nontemporal_load(xr + 64 * j); }
            float s = 0.f;
#pragma unroll
            for (int j = 0; j < 8; ++j) s += (v[j].x * v[j].x + v[j].y * v[j].y) + (v[j].z * v[j].z + v[j].w * v[j].w);
            const float rstd = rsqrtf(wave_sum(s) * (1.f / D) + EPS);
            u32x2* o8 = (u32x2*)((bf16*)(ws + WS_XN) + (size_t)m * D) + lane; unsigned* o4 = (unsigned*)(ws + WS_XN8 + (size_t)m * D) + lane;
#pragma unroll
            for (int j = 0; j < 8; ++j) { const f32x4 gg = *((const f32x4*)g1 + lane + 64 * j);
                const float y0 = v[j].x * rstd * gg.x, y1 = v[j].y * rstd * gg.y, y2 = v[j].z * rstd * gg.z, y3 = v[j].w * rstd * gg.w;
                u32x2 o; o.x = cvt_pk_bf16(y0, y1); o.y = cvt_pk_bf16(y2, y3); o8[64 * j] = o;
                o4[64 * j] = pk4_fp8(y0 * SC_XN8, y1 * SC_XN8, y2 * SC_XN8, y3 * SC_XN8); }
            if (!more) break;
#pragma unroll
            for (int j = 0; j < 8; ++j) v[j] = vn[j];
            m = mn; }
    }
}

struct Epi1 {
    static constexpr bool PERM = true, CHAIN = false;
    bf16* PB; bf16* VT; bf16* QB; bf16* KB; float* stats; const float* gq; const float* gk; LAS float* scr;
    __device__ __forceinline__ void operator()(f32x4 (&acc)[2][2][4][2], const Unit& u, int wr, int wc, int fr, int fq) const {
        if (u.kind == 0) {
            const int pn = u.pn;
            bf16* base = PB + (size_t)(u.pm * 256 + wr * 64 + fr) * N1 + pn * 256 + wc * 32 + 8 * fq;
            if (pn < 8) {
#pragma unroll
                for (int ai = 0; ai < 2; ++ai)
#pragma unroll
                    for (int m = 0; m < 4; ++m)
#pragma unroll
                        for (int bj = 0; bj < 2; ++bj) { const f32x4 x0 = acc[ai][bj][m][0], x1 = acc[ai][bj][m][1];
                            float s = (x0.x * x0.x + x0.y * x0.y) + (x0.z * x0.z + x0.w * x0.w) + (x1.x * x1.x + x1.y * x1.y) + (x1.z * x1.z + x1.w * x1.w);
                            s += __shfl_xor(s, 16); s += __shfl_xor(s, 32);
                            if (fq == 0) scr[(ai * 128 + wr * 64 + m * 16 + fr) * 8 + bj * 4 + wc] = s; }
                LDS_WAIT(); __builtin_amdgcn_s_barrier(); asm volatile("" ::: "memory");
                const float* gn = (pn < 4) ? gq : gk; const float sc = (pn < 4) ? 0.12751743082459868f : 1.f;
                const f32x4 g0 = *(const f32x4*)(gn + wc * 32 + 8 * fq), g1 = *(const f32x4*)(gn + wc * 32 + 8 * fq + 4);
                bf16* qkb = (pn < 4 ? QB : KB) + ((size_t)(((u.pm * 256) >> 12) * NH + (pn & 3) * 2) * SEQ + ((u.pm * 256) & (SEQ - 1)) + wr * 64 + fr) * HD + wc * 32 + 8 * fq;
#pragma unroll
                for (int ai = 0; ai < 2; ++ai)
#pragma unroll
                    for (int m = 0; m < 4; ++m) { const int row = ai * 128 + wr * 64 + m * 16 + fr;
#pragma unroll
                        for (int bj = 0; bj < 2; ++bj) { const f32x4 p = *(const LAS f32x4*)(scr + row * 8 + bj * 4);
                            const float rinv = rsqrtf(((p.x + p.y) + (p.z + p.w)) * (1.f / HD) + EPS) * sc;
                            const f32x4 v0 = acc[ai][bj][m][0] * rinv * g0, v1 = acc[ai][bj][m][1] * rinv * g1;
                            u32x4 w; w.x = cvt_pk_bf16(v0.x, v0.y); w.y = cvt_pk_bf16(v0.z, v0.w); w.z = cvt_pk_bf16(v1.x, v1.y); w.w = cvt_pk_bf16(v1.z, v1.w);
                            *(u32x4*)(qkb + (size_t)(ai * 128 + m * 16) * HD + (size_t)bj * SEQ * HD) = w; } __builtin_amdgcn_sched_barrier(0); }
                LDS_WAIT();
            } else {
#pragma unroll
                for (int ai = 0; ai < 2; ++ai)
#pragma unroll
                    for (int m = 0; m < 4; ++m)
#pragma unroll
                        for (int bj = 0; bj < 2; ++bj) { f32x4 v0 = acc[ai][bj][m][0], v1 = acc[ai][bj][m][1];
#pragma unroll
                            for (int j = 0; j < 4; ++j) { v0[j] = gelu_tanh_f(v0[j]); v1[j] = gelu_tanh_f(v1[j]); }
                            u32x4 w; w.x = cvt_pk_bf16(v0.x, v0.y); w.y = cvt_pk_bf16(v0.z, v0.w); w.z = cvt_pk_bf16(v1.x, v1.y); w.w = cvt_pk_bf16(v1.z, v1.w);
                            *(u32x4*)(base + (size_t)(ai * 128 + m * 16) * N1 + bj * 128) = w; __builtin_amdgcn_sched_barrier(0); }
            }
        } else {
            const bool is_vv = u.pm >= 4;
            bf16* vtb = VT + ((((size_t)(((u.pn * 256) >> 12) * 16 + u.pm * 2) * 128 + (((u.pn * 256) & (SEQ - 1)) >> 5) + wc) * 128 + wr * 64 + fr) * 32 + 8 * fq);
            if (is_vv) {
#pragma unroll
                for (int bj = 0; bj < 2; ++bj)
#pragma unroll
                    for (int n = 0; n < 2; ++n) { f32x4 s = (f32x4){0.f, 0.f, 0.f, 0.f}, q = s;
#pragma unroll
                        for (int ai = 0; ai < 2; ++ai)
#pragma unroll
                            for (int m = 0; m < 4; ++m) { f32x4 x = acc[ai][bj][m][n];
#pragma unroll
                                for (int j = 0; j < 4; ++j) x[j] = gelu_tanh_f(x[j]);
                                s += x; q += x * x; }
#pragma unroll
                        for (int o = 1; o < 16; o <<= 1) {
#pragma unroll
                            for (int j = 0; j < 4; ++j) { s[j] += __shfl_xor(s[j], o); q[j] += __shfl_xor(q[j], o); } }
                        if (fr == 0) { const int slot = (u.pm - 4) * 2 + wr; float* sp = stats + ((size_t)(u.pn * 256 + bj * 128 + wc * 32 + 8 * fq + 4 * n) * 8 + slot) * 2;
#pragma unroll
                            for (int j = 0; j < 4; ++j) *(f32x2*)(sp + 16 * j) = (f32x2){s[j], q[j]}; }
                        __builtin_amdgcn_sched_barrier(0); }
            }
#pragma unroll
            for (int ai = 0; ai < 2; ++ai)
#pragma unroll
                for (int m = 0; m < 4; ++m)
#pragma unroll
                    for (int bj = 0; bj < 2; ++bj) { f32x4 v0 = acc[ai][bj][m][0], v1 = acc[ai][bj][m][1];
                        if (is_vv) {
#pragma unroll
                            for (int j = 0; j < 4; ++j) { v0[j] = gelu_tanh_f(v0[j]); v1[j] = gelu_tanh_f(v1[j]); } }
                        u32x4 w; w.x = cvt_pk_bf16(v0.x, v0.y); w.y = cvt_pk_bf16(v0.z, v0.w); w.z = cvt_pk_bf16(v1.x, v1.y); w.w = cvt_pk_bf16(v1.z, v1.w);
                        *(u32x4*)(vtb + (size_t)ai * (128 * 128 * 32) + bj * (4 * 128 * 32) + m * (16 * 32)) = w; __builtin_amdgcn_sched_barrier(0); }
        }
    }
};
struct Sched1 {
    int G, c; const char* XN; const char* W1T; const char* W2T;
    __device__ __forceinline__ bool next(int i, Unit& u) const {
        const int L = i * G + c; if (L >= 640) return false;
        u.e = 0; u.nvalid = 256; u.rbase = 0;
        if (L < 384) { pg8::tile_order(L, 32, 12, u.pm, u.pn); u.kind = 0; u.A = XN + (size_t)u.pm * 256 * D * 2; u.B = W1T + (size_t)u.pn * 256 * D * 2; }
        else { pg8::tile_order(L - 384, 8, 32, u.pm, u.pn); u.kind = 1; u.A = W2T + (size_t)u.pm * 256 * D * 2; u.B = XN + (size_t)u.pn * 256 * D * 2; }
        return true;
    }
};
struct Epi1g {
    static constexpr bool PERM = true, CHAIN = false;
    bf16* PB;
    __device__ __forceinline__ void operator()(f32x4 (&acc)[2][2][4][2], const Unit& u, int wr, int wc, int fr, int fq) const {
        constexpr float ds = 1.f / (SC_XN8 * SC_W8);
        bf16* base = PB + (size_t)(u.pm * 256 + wr * 64 + fr) * N1 + C_GA + u.pn * 256 + wc * 32 + 8 * fq;
#pragma unroll
        for (int ai = 0; ai < 2; ++ai)
#pragma unroll
            for (int m = 0; m < 4; ++m)
#pragma unroll
                for (int bj = 0; bj < 2; ++bj) { f32x4 v0 = acc[ai][bj][m][0] * ds, v1 = acc[ai][bj][m][1] * ds;
#pragma unroll
                    for (int j = 0; j < 4; ++j) { v0[j] = sigmoid_f(v0[j]); v1[j] = sigmoid_f(v1[j]); }
                    u32x4 w; w.x = cvt_pk_bf16(v0.x, v0.y); w.y = cvt_pk_bf16(v0.z, v0.w); w.z = cvt_pk_bf16(v1.x, v1.y); w.w = cvt_pk_bf16(v1.z, v1.w);
                    *(u32x4*)(base + (size_t)(ai * 128 + m * 16) * N1 + bj * 128) = w; __builtin_amdgcn_sched_barrier(0); }
    }
};
struct Sched1g {
    int G, c; const char* XN8; const char* WG8;
    __device__ __forceinline__ bool next(int i, Unit& u) const {
        const int L = i * G + c; if (L >= 512) return false;
        u.e = 0; u.nvalid = 256; u.rbase = 0; u.kind = 0;
        pg8::tile_order(L, 32, 16, u.pm, u.pn); u.A = XN8 + (size_t)u.pm * 256 * D; u.B = WG8 + (size_t)u.pn * 256 * D;
        return true;
    }
};

__device__ __forceinline__ void attn_task(const bf16* QB, const bf16* KB, const bf16* VT, bf16* OA, int task, int lane) {
    const int bh = task >> 7, qb = task & 127, b = bh >> 3, h = bh & 7;
    const int c = lane & 31, hh = lane >> 5;
    const size_t tokbase = (size_t)b * SEQ;
    const int t0 = qb * 32;
    bf16x8 qf[8];
    { const bf16* qp = QB + ((size_t)bh * SEQ + t0 + c) * HD + 8 * hh;
#pragma unroll
      for (int s = 0; s < 8; ++s) qf[s] = *(const bf16x8*)(qp + 16 * s); }
    f32x16 o[4];
#pragma unroll
    for (int d = 0; d < 4; ++d)
#pragma unroll
        for (int r = 0; r < 16; ++r) o[d][r] = 0.f;
    float crun = 0.f;
    const int kap = 16 * ((c >> 2) & 1) + 4 * (c >> 3) + (c & 3);
    const bf16* kp0 = KB + ((size_t)bh * SEQ + kap) * HD + 8 * hh;
    const bf16* vp0 = VT + ((size_t)(b * 16 + h) * 128 * 128 + c) * 32 + 16 * hh;
    bf16x8 kf[8];
#pragma unroll
    for (int s = 0; s < 8; ++s) kf[s] = *(const bf16x8*)(kp0 + (size_t)t0 * HD + 16 * s);
    for (int j = qb; j >= 0; --j) {
        const int kbase = j * 32;
        bf16x8 vf[4][2];
#pragma unroll
        for (int d = 0; d < 4; ++d)
#pragma unroll
            for (int s = 0; s < 2; ++s) vf[d][s] = *(const bf16x8*)(vp0 + (size_t)j * 4096 + d * 1024 + 8 * s);
        f32x16 S;
#pragma unroll
        for (int r = 0; r < 16; ++r) S[r] = 0.f;
#pragma unroll
        for (int s = 0; s < 8; ++s) S = __builtin_amdgcn_mfma_f32_32x32x16_bf16(kf[s], qf[s], S, 0, 0, 0);
        if (j > 0) {
#pragma unroll
            for (int s = 0; s < 8; ++s) kf[s] = *(const bf16x8*)(kp0 + (size_t)(kbase - 32) * HD + 16 * s);
        }
        const int tq = t0 + c, k0 = kbase + 16 * hh;
        float Lk[16], run = 0.f;
        if (j == qb) {
#pragma unroll
            for (int r = 0; r < 16; ++r) { const float z = S[r]; const float sp = fmaxf(z, 0.f) + __builtin_amdgcn_logf(1.f + __builtin_amdgcn_exp2f(-fabsf(z)));
                const bool past = (k0 + r) < tq; Lk[r] = past ? -sp : 0.f; S[r] = past ? z : -1e30f; run += Lk[r]; }
        } else {
#pragma unroll
            for (int r = 0; r < 16; ++r) { const float z = S[r]; const float sp = fmaxf(z, 0.f) + __builtin_amdgcn_logf(1.f + __builtin_amdgcn_exp2f(-fabsf(z))); Lk[r] = -sp; run += Lk[r]; }
        }
        const float other = __shfl_xor(run, 32);
        float acc_after = crun + (hh == 0 ? other : 0.f);
        float w[16];
#pragma unroll
        for (int r = 15; r >= 0; --r) { w[r] = __builtin_amdgcn_exp2f((S[r] + Lk[r]) + acc_after); acc_after += Lk[r]; }
        crun += run + other;
        bf16x8 pf[2];
#pragma unroll
        for (int s = 0; s < 2; ++s) { u32x4 pk; pk.x = cvt_pk_bf16(w[8 * s + 0], w[8 * s + 1]); pk.y = cvt_pk_bf16(w[8 * s + 2], w[8 * s + 3]); pk.z = cvt_pk_bf16(w[8 * s + 4], w[8 * s + 5]); pk.w = cvt_pk_bf16(w[8 * s + 6], w[8 * s + 7]);
            pf[s] = __builtin_bit_cast(bf16x8, pk); }
#pragma unroll
        for (int d = 0; d < 4; ++d)
#pragma unroll
            for (int s = 0; s < 2; ++s) o[d] = __builtin_amdgcn_mfma_f32_32x32x16_bf16(vf[d][s], pf[s], o[d], 0, 0, 0);
        if (__all(crun < -151.f)) break;
    }
    bf16* op = OA + (tokbase + t0 + c) * AW + h * HD + 4 * hh;
#pragma unroll
    for (int d = 0; d < 4; ++d)
#pragma unroll
        for (int g = 0; g < 4; ++g) { u32x2 pk; pk.x = cvt_pk_bf16(o[d][4 * g + 0], o[d][4 * g + 1]); pk.y = cvt_pk_bf16(o[d][4 * g + 2], o[d][4 * g + 3]);
            *(u32x2*)(op + d * 32 + 8 * g) = pk; }
}

__device__ __forceinline__ void sgu_task(const Args& a, const bf16* PB, const bf16* VT, const float* stats, bf16* OB, int idx, int lane) {
    const int ib = idx & 3, g = (idx >> 2) & 7, n = idx >> 5;
    const int c = lane & 31, hh = lane >> 5;
    const float* wsp = a.in[6] + ((size_t)g * 128 + ib * 32 + c) * 128 + 8 * hh;
    const bf16* vvp = VT + (((size_t)((n >> 5) * 16 + 8 + g) * 128 + (n & 31) * 4) * 128 + c) * 32 + 8 * hh;
    f32x16 acc[4];
#pragma unroll
    for (int d = 0; d < 4; ++d)
#pragma unroll
        for (int r = 0; r < 16; ++r) acc[d][r] = 0.f;
    const int nks = ib < 2 ? 4 : 8;
    for (int ks = 0; ks < nks; ++ks) {
        float mu[8], rs[8];
        { const f32x4 st = *(const f32x4*)(stats + ((size_t)(n * 128 + 16 * ks + (lane >> 2)) * 8 + 2 * (lane & 3)) * 2);
          float S = st.x + st.z, Q = st.y + st.w;
          S += __shfl_xor(S, 1); Q += __shfl_xor(Q, 1); S += __shfl_xor(S, 2); Q += __shfl_xor(Q, 2);
          const float m_ = S * (1.f / SW), r_ = rsqrtf(fmaxf(Q * (1.f / SW) - m_ * m_, 0.f) + EPS);
#pragma unroll
          for (int j = 0; j < 8; ++j) { mu[j] = __shfl(m_, 4 * (8 * hh + j)); rs[j] = __shfl(r_, 4 * (8 * hh + j)); } }
        const f32x4 w0 = *(const f32x4*)(wsp + 16 * ks), w1 = *(const f32x4*)(wsp + 16 * ks + 4);
        u32x4 bw; bw.x = cvt_pk_bf16(w0.x, w0.y); bw.y = cvt_pk_bf16(w0.z, w0.w); bw.z = cvt_pk_bf16(w1.x, w1.y); bw.w = cvt_pk_bf16(w1.z, w1.w);
        const bf16x8 bfrag = __builtin_bit_cast(bf16x8, bw);
#pragma unroll
        for (int cbk = 0; cbk < 4; ++cbk) {
            const u32x4 raw = *(const u32x4*)(vvp + (size_t)(ks >> 1) * 4096 + cbk * 1024 + 16 * (ks & 1));
            u32x4 nv;
            nv.x = cvt_pk_bf16((bf_lo(raw.x) - mu[0]) * rs[0], (bf_hi(raw.x) - mu[1]) * rs[1]);
            nv.y = cvt_pk_bf16((bf_lo(raw.y) - mu[2]) * rs[2], (bf_hi(raw.y) - mu[3]) * rs[3]);
            nv.z = cvt_pk_bf16((bf_lo(raw.z) - mu[4]) * rs[4], (bf_hi(raw.z) - mu[5]) * rs[5]);
            nv.w = cvt_pk_bf16((bf_lo(raw.w) - mu[6]) * rs[6], (bf_hi(raw.w) - mu[7]) * rs[7]);
            acc[cbk] = __builtin_amdgcn_mfma_f32_32x32x16_bf16(__builtin_bit_cast(bf16x8, nv), bfrag, acc[cbk], 0, 0, 0);
        }
    }
    const int tok = n * 128 + ib * 32 + c;
    const float bsp = a.in[7][g * 128 + ib * 32 + c];
    const float* gam = a.in[5] + g * 128 + 4 * hh;
    const bf16* up = PB + (size_t)tok * N1 + C_U + g * 128 + 4 * hh;
    bf16* op = OB + (size_t)tok * SW + g * 128 + 4 * hh;
#pragma unroll
    for (int d = 0; d < 4; ++d)
#pragma unroll
        for (int gg = 0; gg < 4; ++gg) { const f32x4 gm = *(const f32x4*)(gam + d * 32 + 8 * gg); const u32x2 uu = *(const u32x2*)(up + d * 32 + 8 * gg);
            const float r0 = bf_lo(uu.x) * (gm.x * acc[d][4 * gg + 0] + bsp), r1 = bf_hi(uu.x) * (gm.y * acc[d][4 * gg + 1] + bsp);
            const float r2 = bf_lo(uu.y) * (gm.z * acc[d][4 * gg + 2] + bsp), r3 = bf_hi(uu.y) * (gm.w * acc[d][4 * gg + 3] + bsp);
            u32x2 pk; pk.x = cvt_pk_bf16(r0, r1); pk.y = cvt_pk_bf16(r2, r3); *(u32x2*)(op + d * 32 + 8 * gg) = pk; }
}

struct Epi3 {
    static constexpr bool PERM = true, CHAIN = true;
    const bf16* PB; bf16* Y;
    __device__ __forceinline__ void operator()(f32x4 (&acc)[2][2][4][2], const Unit& u, int wr, int wc, int fr, int fq) const {
        const int row0 = u.pm * 256 + wr * 64 + fr, col0 = u.pn * 256 + wc * 32 + 8 * fq;
        const bf16* gpa = PB + (size_t)row0 * N1 + C_GA + col0; const bf16* gpb = PB + (size_t)row0 * N1 + C_GB + col0;
#pragma unroll
        for (int ai = 0; ai < 2; ++ai)
#pragma unroll
            for (int m = 0; m < 4; ++m)
#pragma unroll
                for (int bj = 0; bj < 2; ++bj) { const size_t ro = (size_t)(ai * 128 + m * 16);
                    const u32x4 gb = *(const u32x4*)(gpb + ro * N1 + bj * 128);
                    f32x4 b0, b1;
                    b0.x = fmaxf(bf_lo(gb.x), 1e-20f); b0.y = fmaxf(bf_hi(gb.x), 1e-20f); b0.z = fmaxf(bf_lo(gb.y), 1e-20f); b0.w = fmaxf(bf_hi(gb.y), 1e-20f);
                    b1.x = fmaxf(bf_lo(gb.z), 1e-20f); b1.y = fmaxf(bf_hi(gb.z), 1e-20f); b1.z = fmaxf(bf_lo(gb.w), 1e-20f); b1.w = fmaxf(bf_hi(gb.w), 1e-20f);
                    if (u.kind == 0) {
                        const u32x4 ga = *(const u32x4*)(gpa + ro * N1 + bj * 128);
                        f32x4 r0, r1;
                        r0.x = bf_lo(ga.x) * fast_rcp(b0.x); r0.y = bf_hi(ga.x) * fast_rcp(b0.y); r0.z = bf_lo(ga.y) * fast_rcp(b0.z); r0.w = bf_hi(ga.y) * fast_rcp(b0.w);
                        r1.x = bf_lo(ga.z) * fast_rcp(b1.x); r1.y = bf_hi(ga.z) * fast_rcp(b1.y); r1.z = bf_lo(ga.w) * fast_rcp(b1.z); r1.w = bf_hi(ga.w) * fast_rcp(b1.w);
                        acc[ai][bj][m][0] *= r0; acc[ai][bj][m][1] *= r1;
                    } else {
                        const f32x4 v0 = acc[ai][bj][m][0] * b0, v1 = acc[ai][bj][m][1] * b1;
                        u32x4 w; w.x = cvt_pk_bf16(v0.x, v0.y); w.y = cvt_pk_bf16(v0.z, v0.w); w.z = cvt_pk_bf16(v1.x, v1.y); w.w = cvt_pk_bf16(v1.z, v1.w);
                        *(u32x4*)(Y + (size_t)(row0 + ro) * D + col0 + bj * 128) = w; } }
    }
};
struct Sched3 {
    int G, c; const char* OA; const char* OB; const char* WAT; const char* WBT;
    __device__ __forceinline__ bool next(int i, Unit& u) const {
        const int tile = c + (i >> 1) * G; if (tile >= 256) return false;
        pg8::tile_order(tile, 32, 8, u.pm, u.pn); u.kind = i & 1; u.e = 0; u.nvalid = 256; u.rbase = 0;
        u.A = (u.kind == 0 ? OA : OB) + (size_t)u.pm * 256 * AW * 2; u.B = (u.kind == 0 ? WAT : WBT) + (size_t)u.pn * 256 * AW * 2;
        return true;
    }
};

struct Epi4 {
    static constexpr bool PERM = false, CHAIN = false;
    const float* X; float* OUT;
    __device__ __forceinline__ void operator()(f32x4 (&acc)[2][2][4][2], const Unit& u, int wr, int wc, int fr, int fq) const {
        const size_t o0 = (size_t)(u.pm * 256 + wr * 64 + fr) * D + u.pn * 256 + wc * 32 + 4 * fq;
#pragma unroll
        for (int ai = 0; ai < 2; ++ai)
#pragma unroll
            for (int m = 0; m < 4; ++m)
#pragma unroll
                for (int bj = 0; bj < 2; ++bj)
#pragma unroll
                    for (int n = 0; n < 2; ++n) { const size_t o = o0 + (size_t)(ai * 128 + m * 16) * D + bj * 128 + n * 16;
                        *(f32x4*)(OUT + o) = *(const f32x4*)(X + o) + acc[ai][bj][m][n]; }
    }
};
struct Sched4 {
    int G, c; const char* Y; const char* WOT;
    __device__ __forceinline__ bool next(int i, Unit& u) const {
        const int tile = c + i * G; if (tile >= 256) return false;
        pg8::tile_order(tile, 32, 8, u.pm, u.pn); u.kind = 0; u.e = 0; u.nvalid = 256; u.rbase = 0;
        u.A = Y + (size_t)u.pm * 256 * D * 2; u.B = WOT + (size_t)u.pn * 256 * D * 2;
        return true;
    }
};

template <int PH> struct SchedMoE {
    int G, vcu; const volatile LAS unsigned* misc; const char* Abase; const char* Bbase; int ncu;
    __device__ __forceinline__ bool next(int i, Unit& u) const {
        const volatile LAS unsigned* us = misc + (PH == 6 ? MW_US6 : MW_US7);
        const int total = __builtin_amdgcn_readfirstlane((int)us[NE]);
        int L;
        if ((G & 255) == 0) { const int nx = G >> 5, chunk = (total + nx - 1) / nx, x = vcu >> 5, j = vcu & 31;
            if (ncu == 32) { L = x * chunk + i * 32 + j; if (L >= (x + 1) * chunk) return false; }
            else {
                int len = total - x * chunk; len = len < 0 ? 0 : (len > chunk ? chunk : len);
                const int R = len / ncu - MOE_TAIL_TEST;
                if (j < ncu) { if (i >= R) return false; L = x * chunk + i * ncu + j; }
                else { const int p = i * (32 - ncu) + (j - ncu); if (p >= len - R * ncu) return false; L = x * chunk + R * ncu + p; } } }
        else L = i * G + vcu;
        if (L >= total) return false;
        const int ln = (int)(threadIdx.x & 63);
        const unsigned mine = us[ln < NE ? ln : NE];
        const unsigned long long mk = __ballot((unsigned)L >= mine);
        const int e = __builtin_amdgcn_readfirstlane(63 - __builtin_clzll(mk | 1ull));
        const int ne = __builtin_amdgcn_readfirstlane((int)misc[MW_CNT + e]), off = __builtin_amdgcn_readfirstlane((int)misc[MW_OFF + e]);
        const int st = __builtin_amdgcn_readfirstlane((int)us[e]);
        const int mte = (ne + 255) >> 8, rem = L - st, mt = rem % mte, ntl = rem / mte;
        u.kind = 0; u.pm = mt; u.pn = ntl; u.e = e; u.nvalid = ne - mt * 256; u.rbase = off + mt * 256;
        if (PH == 6) { u.A = Abase + ((size_t)e * T + (size_t)mt * 256) * D; u.B = Bbase + ((size_t)e * 2 * DE + (size_t)ntl * 256) * D; }
        else { u.A = Abase + (size_t)u.rbase * DE; u.B = Bbase + ((size_t)e * D + (size_t)ntl * 256) * DE; }
        return true;
    }
};
__device__ __forceinline__ f32x2 swiglu_pk(f32x2 g, f32x2 u) {
    const f32x2 ga = __builtin_elementwise_min(g, (f32x2){7.f, 7.f});
    const f32x2 ua = __builtin_elementwise_min(__builtin_elementwise_max(u, (f32x2){-7.f, -7.f}), (f32x2){7.f, 7.f});
    const f32x2 t = ga * (-1.702f * 1.4426950408889634f);
    f32x2 d; d.x = __builtin_amdgcn_exp2f(t.x); d.y = __builtin_amdgcn_exp2f(t.y); d = d + 1.0f;
    f32x2 r; r.x = __builtin_amdgcn_rcpf(d.x); r.y = __builtin_amdgcn_rcpf(d.y);
    return (ga * r) * (ua * SC_A8 + SC_A8);
}
__device__ __forceinline__ unsigned pk4_fp8_nc(float a, float b, float c, float d) { int r = 0; r = __builtin_amdgcn_cvt_pk_fp8_f32(a, b, r, false); r = __builtin_amdgcn_cvt_pk_fp8_f32(c, d, r, true); return (unsigned)r; }
struct Epi6 {
    static constexpr bool PERM = true, CHAIN = false;
    const float* bup; unsigned char* ACT;
    __device__ __forceinline__ void operator()(f32x4 (&acc)[2][2][4][2], const Unit& u, int wr, int wc, int fr, int fq) const {
        const int cc = u.pn * 128 + wc * 32 + 8 * fq;
        const float* bg = bup + (size_t)u.e * 2 * DE + cc;
        const f32x4 bg0 = *(const f32x4*)bg, bg1 = *(const f32x4*)(bg + 4), bu0 = *(const f32x4*)(bg + DE), bu1 = *(const f32x4*)(bg + DE + 4);
        constexpr float ds = 1.f / (SC_W8 * SC_X8);
#pragma unroll
        for (int ai = 0; ai < 2; ++ai)
#pragma unroll
            for (int m = 0; m < 4; ++m) { const int row = ai * 128 + wr * 64 + m * 16 + fr;
                const f32x4 g0 = acc[ai][0][m][0] * ds + bg0, g1 = acc[ai][0][m][1] * ds + bg1, u0 = acc[ai][1][m][0] * ds + bu0, u1 = acc[ai][1][m][1] * ds + bu1;
                const f32x2 a0 = swiglu_pk((f32x2){g0.x, g0.y}, (f32x2){u0.x, u0.y}), a1 = swiglu_pk((f32x2){g0.z, g0.w}, (f32x2){u0.z, u0.w});
                const f32x2 a2 = swiglu_pk((f32x2){g1.x, g1.y}, (f32x2){u1.x, u1.y}), a3 = swiglu_pk((f32x2){g1.z, g1.w}, (f32x2){u1.z, u1.w});
                if (row < u.nvalid) { u32x2 w; w.x = pk4_fp8_nc(a0.x, a0.y, a1.x, a1.y); w.y = pk4_fp8_nc(a2.x, a2.y, a3.x, a3.y);
                    *(u32x2*)(ACT + (size_t)(u.rbase + row) * DE + cc) = w; } }
    }
};
struct Epi7 {
    static constexpr bool PERM = true, CHAIN = false;
    const float* bdn; bf16* YM;
    __device__ __forceinline__ void operator()(f32x4 (&acc)[2][2][4][2], const Unit& u, int wr, int wc, int fr, int fq) const {
        const int cc = u.pn * 256 + wc * 32 + 8 * fq;
        const float* bp = bdn + (size_t)u.e * D + cc;
        f32x4 bb[2][2];
#pragma unroll
        for (int bj = 0; bj < 2; ++bj) { bb[bj][0] = *(const f32x4*)(bp + bj * 128); bb[bj][1] = *(const f32x4*)(bp + bj * 128 + 4); }
#pragma unroll
        for (int ai = 0; ai < 2; ++ai)
#pragma unroll
            for (int m = 0; m < 4; ++m) { const int row = ai * 128 + wr * 64 + m * 16 + fr;
                if (row < u.nvalid) {
#pragma unroll
                    for (int bj = 0; bj < 2; ++bj) { constexpr float ds = 1.f / (SC_W8 * SC_A8); const f32x4 v0 = acc[ai][bj][m][0] * ds + bb[bj][0], v1 = acc[ai][bj][m][1] * ds + bb[bj][1];
                        u32x4 w; w.x = cvt_pk_bf16(v0.x, v0.y); w.y = cvt_pk_bf16(v0.z, v0.w); w.z = cvt_pk_bf16(v1.x, v1.y); w.w = cvt_pk_bf16(v1.z, v1.w);
                        *(u32x4*)(YM + (size_t)(u.rbase + row) * D + cc + bj * 128) = w; } } }
    }
};

__global__ void __launch_bounds__(NWAVES * 64, 2) fwd(Args a) {
    extern __shared__ __attribute__((aligned(16))) unsigned char lds_raw[];
    LAS unsigned char* lds = (LAS unsigned char*)lds_raw;
    volatile LAS unsigned* MISC = (volatile LAS unsigned*)(lds + MISC_OFF);
    const int tid = threadIdx.x, lane = tid & 63, wave = __builtin_amdgcn_readfirstlane(tid >> 6);
    const int G = gridDim.x, bx = blockIdx.x;
    const int vcu = (G % 8 == 0) ? (bx % 8) * (G / 8) + bx / 8 : bx;
    unsigned char* ws = a.ws;
    unsigned* ctl = (unsigned*)(ws + WS_CTL);
    for (int u = tid; u < 512; u += NWAVES * 64) MISC[u] = 0u;
    __syncthreads();
    XcdBarrier bar = xcd_barrier_post(ctl + CW_BAR, MISC + MW_BAR);
    const int gw = vcu * NWAVES + wave, NGW = G * NWAVES;

    bf16* PB = (bf16*)(ws + WS_PB); bf16* VT = (bf16*)(ws + WS_VT); bf16* OA = (bf16*)(ws + WS_OA); bf16* OB = (bf16*)(ws + WS_OB);
    float* stats = (float*)(ws + WS_STATS);
    int* tok_e = (int*)(ws + WS_ROUTE); int* tok_rank = tok_e + T * TOPK; float* tok_gate = (float*)(tok_rank + T * TOPK);

    if (PH_ON(0)) p0_prologue(a, lds, vcu, G, wave, lane);
    xcd_barrier(bar);

    if (PH_ON(1)) {
        int cbeg, cend;
        constexpr int NUP = NE * I_UP1;
        const bool split6 = (G == 256);
        const int CONV1 = split6 ? NUP : MOE_ITEMS;
        if (G == 256) { constexpr int S5 = 220, S4 = 292; static_assert(128 * (S5 + S4) == NUP, "conversion shares");
            cbeg = bx < 128 ? bx * S5 : 128 * S5 + (bx - 128) * S4; cend = cbeg + (bx < 128 ? S5 : S4); }
        else { const int per = (CONV1 + G - 1) / G; cbeg = bx * per; cend = cbeg + per < CONV1 ? cbeg + per : CONV1; if (cbeg > CONV1) cbeg = CONV1; }
        const bool conv_first = ((bx >> 3) & 1) != 0;
        const bool roles = (G == 256);
        const int ridx = (bx >> 4) * 8 + (bx & 7);
        if (roles && conv_first) moe_convert(a, lds, ridx * (NUP / 128), (ridx + 1) * (NUP / 128), wave, lane);
        if (!roles && conv_first) { moe_convert(a, lds, cbeg, cend, wave, lane); __syncthreads(); }
        if (!(roles && conv_first)) {
        pg8::Gemm g{D, D, D};
        Sched1 S{roles ? 128 : G, roles ? ridx : bx, (const char*)(ws + WS_XN), (const char*)(ws + WS_W1T), (const char*)(ws + WS_W2T)};
        Epi1 E{PB, VT, (bf16*)(ws + WS_QB), (bf16*)(ws + WS_KB), stats, a.in[3], a.in[4], (LAS float*)(lds + SCR_OFF)};
        pg8::gemm_phase<Epi1, Sched1>(lds, g, S, E);
        { pg8::Gemm g8{D / 2, D / 2, D / 2};
          Sched1g S8{roles ? 128 : G, roles ? ridx : bx, (const char*)(ws + WS_XN8), (const char*)(ws + WS_WG8)};
          Epi1g E8{PB};
          pg8::gemm_phase<Epi1g, Sched1g, true>(lds, g8, S8, E8); }
        }
        if (!roles && !conv_first) moe_convert(a, lds, cbeg, cend, wave, lane);
    }
    xcd_barrier(bar);

    if (PH_ON(2)) for (int task = gw; task < 4096; task += NGW) {
        if (task < 2048) attn_task((const bf16*)(ws + WS_QB), (const bf16*)(ws + WS_KB), VT, OA, task, lane);
        else sgu_task(a, PB, VT, stats, OB, task - 2048, lane);
    }
    xcd_barrier(bar);

    if (PH_ON(3)) {
        pg8::Gemm g{AW, AW, AW};
        Sched3 S{G, bx, (const char*)(ws + WS_OA), (const char*)(ws + WS_OB), (const char*)(ws + WS_WAT), (const char*)(ws + WS_WBT)};
        Epi3 E{PB, (bf16*)(ws + WS_Y)};
        pg8::gemm_phase<Epi3, Sched3>(lds, g, S, E);
    }
    xcd_barrier(bar);

    if (PH_ON(4)) {
        pg8::Gemm g{D, D, D};
        Sched4 S{G, bx, (const char*)(ws + WS_Y), (const char*)(ws + WS_WOT)};
        Epi4 E{a.in[0], a.out};
        pg8::gemm_phase<Epi4, Sched4>(lds, g, S, E);
    }
#if DBG_STAGE >= 5
    xcd_barrier(bar);

    if (PH_ON(5)) {
        LAS float* red = (LAS float*)lds;
        LAS float* ssqp = (LAS float*)(lds + 8 * 1056 * 4);
        LAS float* rinfo = ssqp + 256;
        LAS unsigned* lcnt = (LAS unsigned*)(rinfo + 384); LAS unsigned* lbase = lcnt + 32;
        const float* g2 = a.in[11]; const float* wrt = a.in[12]; const float* brt = a.in[13];
        for (int rb = bx; rb < T / 32; rb += G) {
            const int row0 = rb * 32, i = lane & 31, hk = lane >> 5, kb = wave * 256 + hk * 128;
            if (tid < 32) lcnt[tid] = 0u;
            const float* xr = a.out + (size_t)(row0 + i) * D + kb;
            f32x16 acc;
#pragma unroll
            for (int r = 0; r < 16; ++r) acc[r] = 0.f;
            float ssq = 0.f;
            for (int ch = 0; ch < 4; ++ch) {
                f32x4 xv[8];
#pragma unroll
                for (int q = 0; q < 8; ++q) xv[q] = *(const f32x4*)(xr + ch * 32 + q * 4);
#pragma unroll
                for (int q = 0; q < 8; ++q)
#pragma unroll
                    for (int jj = 0; jj < 4; ++jj) { const int k = kb + ch * 32 + q * 4 + jj; const float x = xv[q][jj];
                        const float bw = wrt[(size_t)k * NE + i] * g2[k];
                        acc = __builtin_amdgcn_mfma_f32_32x32x2f32(x, bw, acc, 0, 0, 0); ssq += x * x; }
            }
            ssq += __shfl_xor(ssq, 32);
            if (lane < 32) ssqp[wave * 32 + i] = ssq;
#pragma unroll
            for (int r = 0; r < 16; ++r) red[wave * 1056 + i * 33 + (r & 3) + 8 * (r >> 2) + 4 * hk] = acc[r];
            LDS_WAIT(); __syncthreads();
            if (tid < 32) {
                float sq = 0.f;
#pragma unroll
                for (int w = 0; w < 8; ++w) sq += ssqp[w * 32 + tid];
                const float rstd = rsqrtf(sq * (1.f / D) + EPS);
                float v0 = -3.0e38f, v1 = -3.0e38f, v2 = -3.0e38f, v3 = -3.0e38f; int i0 = 0, i1 = 0, i2 = 0, i3 = 0;
                for (int e = 0; e < NE; ++e) { float v = 0.f;
#pragma unroll
                    for (int w = 0; w < 8; ++w) v += red[w * 1056 + e * 33 + tid];
                    const float x = v * rstd + brt[e];
                    if (x > v3) { if (x > v2) { v3 = v2; i3 = i2; if (x > v1) { v2 = v1; i2 = i1; if (x > v0) { v1 = v0; i1 = i0; v0 = x; i0 = e; } else { v1 = x; i1 = e; } } else { v2 = x; i2 = e; } } else { v3 = x; i3 = e; } } }
                const float p1 = __expf(v1 - v0), p2 = __expf(v2 - v0), p3 = __expf(v3 - v0), inv = 1.f / (1.f + p1 + p2 + p3);
                const int t = row0 + tid;
                const unsigned l0 = __hip_atomic_fetch_add(lcnt + i0, 1u, __ATOMIC_RELAXED, __HIP_MEMORY_SCOPE_WORKGROUP), l1 = __hip_atomic_fetch_add(lcnt + i1, 1u, __ATOMIC_RELAXED, __HIP_MEMORY_SCOPE_WORKGROUP);
                const unsigned l2 = __hip_atomic_fetch_add(lcnt + i2, 1u, __ATOMIC_RELAXED, __HIP_MEMORY_SCOPE_WORKGROUP), l3 = __hip_atomic_fetch_add(lcnt + i3, 1u, __ATOMIC_RELAXED, __HIP_MEMORY_SCOPE_WORKGROUP);
                LDS_WAIT(); asm volatile("" ::: "memory");
                { const unsigned ne_ = lcnt[tid]; unsigned base_ = 0u; if (ne_) base_ = atomicAdd(ctl + CW_CNT + 64 * tid, ne_); lbase[tid] = base_; }
                LDS_WAIT(); asm volatile("" ::: "memory");
                const int r0 = (int)(lbase[i0] + l0), r1 = (int)(lbase[i1] + l1), r2 = (int)(lbase[i2] + l2), r3 = (int)(lbase[i3] + l3);
                tok_e[t * 4 + 0] = i0; tok_e[t * 4 + 1] = i1; tok_e[t * 4 + 2] = i2; tok_e[t * 4 + 3] = i3;
                tok_rank[t * 4 + 0] = r0; tok_rank[t * 4 + 1] = r1; tok_rank[t * 4 + 2] = r2; tok_rank[t * 4 + 3] = r3;
                tok_gate[t * 4 + 0] = inv; tok_gate[t * 4 + 1] = p1 * inv; tok_gate[t * 4 + 2] = p2 * inv; tok_gate[t * 4 + 3] = p3 * inv;
                LAS float* ri = rinfo + tid * 12; ri[0] = rstd;
                ri[1] = __int_as_float(i0); ri[2] = __int_as_float(i1); ri[3] = __int_as_float(i2); ri[4] = __int_as_float(i3);
                ri[5] = __int_as_float(r0); ri[6] = __int_as_float(r1); ri[7] = __int_as_float(r2); ri[8] = __int_as_float(r3);
            }
            LDS_WAIT(); __syncthreads();
            unsigned char* XG = ws + WS_XG;
            for (int rr = 0; rr < 4; ++rr) { const int il = wave * 4 + rr; const LAS float* ri = rinfo + il * 12;
                const float rstd = ri[0];
                size_t dsto[4];
#pragma unroll
                for (int k = 0; k < 4; ++k) dsto[k] = ((size_t)__float_as_int(ri[1 + k]) * T + (size_t)__float_as_int(ri[5 + k])) * D;
                const f32x4* hr = (const f32x4*)(a.out + (size_t)(row0 + il) * D) + lane;
#pragma unroll
                for (int j = 0; j < 8; ++j) { const f32x4 v = hr[64 * j]; const f32x4 gg = *((const f32x4*)g2 + lane + 64 * j);
                    const float rs8 = rstd * SC_X8; const unsigned o = pk4_fp8(v.x * rs8 * gg.x, v.y * rs8 * gg.y, v.z * rs8 * gg.z, v.w * rs8 * gg.w);
#pragma unroll
                    for (int k = 0; k < 4; ++k) *((unsigned*)(XG + dsto[k]) + lane + 64 * j) = o; } }
            LDS_WAIT(); __syncthreads();
        }
    }
    xcd_barrier(bar);

    if (tid < NE) MISC[MW_CNT + tid] = __hip_atomic_load(ctl + CW_CNT + 64 * tid, __ATOMIC_RELAXED, __HIP_MEMORY_SCOPE_AGENT);
    LDS_WAIT(); __syncthreads();
    if (tid < 64) {
        const unsigned n = tid < NE ? MISC[MW_CNT + tid] : 0u, mt = (n + 255u) >> 8;
        unsigned so = n, su = mt;
#pragma unroll
        for (int o = 1; o < 32; o <<= 1) { const unsigned a_ = __shfl_up(so, o), b_ = __shfl_up(su, o); if ((tid & 63) >= o) { so += a_; su += b_; } }
        if (tid < NE) { MISC[MW_OFF + tid] = so - n; MISC[MW_US6 + tid] = (su - mt) * 16u; MISC[MW_US7 + tid] = (su - mt) * 8u; }
        if (tid == NE - 1) { MISC[MW_US6 + NE] = su * 16u; MISC[MW_US7 + NE] = su * 8u; }
    }
    LDS_WAIT(); __syncthreads();

    if (PH_ON(6)) {
        pg8::Gemm g{D / 2, D / 2, D / 2};
        constexpr int NSTREAM = 8;
        const bool split = (G == 256);
        SchedMoE<6> S{G, vcu, MISC, (const char*)(ws + WS_XG), (const char*)(ws + WS_WUT), split ? 32 - NSTREAM : 32};
        Epi6 E{a.in[15], ws + WS_ACT};
        if (split && (vcu & 31) >= 32 - NSTREAM) { constexpr int NUP6 = NE * I_UP1, NDN6 = NE * I_DN1, PER = NDN6 / (8 * NSTREAM); static_assert(PER * 8 * NSTREAM == NDN6, "w_down shares");
            const int sidx = (vcu >> 5) * NSTREAM + ((vcu & 31) - (32 - NSTREAM)); moe_convert(a, lds, NUP6 + sidx * PER, NUP6 + (sidx + 1) * PER, wave, lane); __syncthreads(); }
        pg8::gemm_phase<Epi6, SchedMoE<6>, true>(lds, g, S, E);
    }
    xcd_barrier(bar);

    if (PH_ON(7)) {
        pg8::Gemm g{DE / 2, DE / 2, DE / 2};
        SchedMoE<7> S{G, vcu, MISC, (const char*)(ws + WS_ACT), (const char*)(ws + WS_WDT), 32};
        Epi7 E{a.in[17], (bf16*)(ws + WS_YM)};
        pg8::gemm_phase<Epi7, SchedMoE<7>, true>(lds, g, S, E);
    }
    xcd_barrier(bar);

    if (PH_ON(8)) {
        const bf16* YM = (const bf16*)(ws + WS_YM);
        for (int t = gw; t < T; t += NGW) {
            size_t pos[4]; float gt[4];
#pragma unroll
            for (int k = 0; k < 4; ++k) { const int e = tok_e[t * 4 + k], rk = tok_rank[t * 4 + k]; gt[k] = tok_gate[t * 4 + k]; pos[k] = ((size_t)MISC[MW_OFF + e] + (size_t)rk) * D; }
            f32x4* orow = (f32x4*)(a.out + (size_t)t * D) + lane;
#pragma unroll
            for (int j = 0; j < 8; ++j) { f32x4 o = orow[64 * j];
#pragma unroll
                for (int k = 0; k < 4; ++k) { const u32x2 y = __builtin_nontemporal_load((const u32x2*)(YM + pos[k]) + lane + 64 * j);
                    o.x += gt[k] * bf_lo(y.x); o.y += gt[k] * bf_hi(y.x); o.z += gt[k] * bf_lo(y.y); o.w += gt[k] * bf_hi(y.y); }
                __builtin_nontemporal_store(o, orow + 64 * j); }
        }
    }
#endif
}

extern "C" void kernel_launch(void* const* d_in, const int* in_sizes, int n_in, void* d_out, int out_size, void* d_ws, size_t ws_size, hipStream_t stream) {
    static int grid = 0;
    if (grid == 0) {
        if (n_in != 18 || out_size != T * D || ws_size < WS_END) { fprintf(stderr, "kernel_launch: unexpected shapes (n_in %d, out %d, ws %zu)\n", n_in, out_size, ws_size); grid = -1; return; }
        int dev = 0, cus = 0, per_cu = 0;
        if (hipGetDevice(&dev) != hipSuccess || hipDeviceGetAttribute(&cus, hipDeviceAttributeMultiprocessorCount, dev) != hipSuccess) { grid = -1; return; }
        if (hipFuncSetAttribute((const void*)fwd, hipFuncAttributeMaxDynamicSharedMemorySize, LDS_BYTES) != hipSuccess) { fprintf(stderr, "kernel_launch: hipFuncSetAttribute failed\n"); grid = -1; return; }
        if (hipOccupancyMaxActiveBlocksPerMultiprocessor(&per_cu, (const void*)fwd, NWAVES * 64, LDS_BYTES) != hipSuccess || per_cu < 1) { fprintf(stderr, "kernel_launch: occupancy query says %d\n", per_cu); }
        (void)hipGetLastError();
        grid = cus;
        if (per_cu < 1) grid = -1;
    }
    if (grid < 0) return;
    if (hipMemsetAsync((char*)d_ws + WS_CTL, 0, CTL_ZERO_BYTES, stream) != hipSuccess) return;
    Args a{};
    for (int i = 0; i < 18; ++i) a.in[i] = (const float*)d_in[i];
    a.out = (float*)d_out; a.ws = (unsigned char*)d_ws;
    hipLaunchKernelGGL(fwd, dim3(grid), dim3(NWAVES * 64), LDS_BYTES, stream, a);
}
```

```cpp
#ifndef MOE_TAIL_TEST
#define MOE_TAIL_TEST 0
#endif
#include <hip/hip_runtime.h>
#include <cstdio>
#include <cstdint>

#ifndef DBG_STAGE
#define DBG_STAGE 99
#endif
#ifndef PH_MASK
#define PH_MASK 0x1ff
#endif
#define PH_ON(p) ((PH_MASK >> (p)) & 1)

#define LAS __attribute__((address_space(3)))
#define GAS __attribute__((address_space(1)))
typedef unsigned short bf16;
typedef short bf16x8 __attribute__((ext_vector_type(8)));
typedef float f32x4 __attribute__((ext_vector_type(4)));
typedef float f32x2 __attribute__((ext_vector_type(2)));
typedef float f32x16 __attribute__((ext_vector_type(16)));
typedef unsigned u32x4 __attribute__((ext_vector_type(4)));
typedef unsigned u32x2 __attribute__((ext_vector_type(2)));
typedef int i32x8 __attribute__((ext_vector_type(8)));
typedef int i32x4 __attribute__((ext_vector_type(4)));

constexpr int T = 8192, D = 2048, SEQ = 4096, NH = 8, HD = 128, AW = 1024, SW = 1024, PW = 9216, NE = 32, TOPK = 4, DE = 2048;
constexpr int C_GB_END_BF = 5120;
constexpr int N1 = 7168;
constexpr int C_Q = 0, C_K = 1024, C_U = 2048, C_GA = 3072, C_GB = 5120;
constexpr float EPS = 1e-6f;
constexpr int NWAVES = 8;

constexpr size_t MiB = 1u << 20;
constexpr size_t WS_CTL = 0, CTL_ZERO_BYTES = 64 * 1024;
constexpr size_t WS_W1T = 2 * MiB;
constexpr size_t WS_W2T = 32 * MiB;
constexpr size_t WS_WAT = 40 * MiB;
constexpr size_t WS_WBT = 44 * MiB;
constexpr size_t WS_WOT = 48 * MiB;
constexpr size_t WS_WG8 = 56 * MiB;
constexpr size_t WS_XN = 64 * MiB;
constexpr size_t WS_PB = 96 * MiB;
constexpr size_t WS_VT = 208 * MiB;
constexpr size_t WS_OA = 240 * MiB;
constexpr size_t WS_OB = 256 * MiB;
constexpr size_t WS_QB = 272 * MiB;
constexpr size_t WS_KB = 288 * MiB;
constexpr size_t WS_XN8 = 304 * MiB;
constexpr size_t WS_Y = 336 * MiB;
constexpr size_t WS_ROUTE = 368 * MiB;
constexpr size_t WS_STATS = 369 * MiB;
constexpr size_t WS_ACT = 370 * MiB;
constexpr size_t WS_H1 = 440 * MiB;
constexpr size_t WS_YM = 500 * MiB;
constexpr size_t WS_WUT = 640 * MiB;
constexpr size_t WS_WDT = 1152 * MiB;
constexpr size_t WS_XG = 1408 * MiB;
constexpr size_t WS_END = 2432 * MiB;
constexpr int CW_BAR = 4096;
constexpr int CW_CNT = 8192;
constexpr int CW_STATS = 16384;

constexpr int RING_BYTES = 131072;
constexpr int SCR_OFF = RING_BYTES;
constexpr int MISC_OFF = RING_BYTES + 8192;
constexpr int LDS_BYTES = RING_BYTES + 8192 + 2048;
constexpr int MW_BAR = 8;
constexpr int MW_CNT = 32, MW_OFF = 64, MW_US6 = 96, MW_US7 = 160;

#define LDS_WAIT() asm volatile("s_waitcnt lgkmcnt(0)" ::: "memory")
#define VM_WAIT() asm volatile("s_waitcnt vmcnt(0)" ::: "memory")

__device__ __forceinline__ unsigned cvt_pk_bf16(float lo, float hi) { unsigned r; asm volatile("v_cvt_pk_bf16_f32 %0, %1, %2" : "=v"(r) : "v"(lo), "v"(hi)); return r; }
__device__ __forceinline__ unsigned pk4_fp8(float a, float b, float c, float d) {
    a = __builtin_amdgcn_fmed3f(a, -448.f, 448.f); b = __builtin_amdgcn_fmed3f(b, -448.f, 448.f); c = __builtin_amdgcn_fmed3f(c, -448.f, 448.f); d = __builtin_amdgcn_fmed3f(d, -448.f, 448.f);
    int r = 0; r = __builtin_amdgcn_cvt_pk_fp8_f32(a, b, r, false); r = __builtin_amdgcn_cvt_pk_fp8_f32(c, d, r, true); return (unsigned)r; }
constexpr float SC_W8 = 64.f, SC_X8 = 4.f, SC_A8 = 2.f, SC_XN8 = 16.f;
__device__ __forceinline__ float bf_lo(unsigned u) { return __uint_as_float(u << 16); }
__device__ __forceinline__ float bf_hi(unsigned u) { return __uint_as_float(u & 0xffff0000u); }
__device__ __forceinline__ float fast_rcp(float x) { return __builtin_amdgcn_rcpf(x); }
__device__ __forceinline__ float sigmoid_f(float x) { return fast_rcp(1.f + __builtin_amdgcn_exp2f(-1.4426950408889634f * x)); }
__device__ __forceinline__ float gelu_tanh_f(float x) { const float in = -2.302208198f * (x + 0.044715f * x * x * x); return x * fast_rcp(1.f + __builtin_amdgcn_exp2f(in)); }
__device__ __forceinline__ float wave_sum(float v) {
#pragma unroll
    for (int o = 1; o < 64; o <<= 1) v += __shfl_xor(v, o);
    return v;
}

namespace pg8 {
constexpr int BM = 256, BK = 64, HALF = 128, HTB = HALF * BK * 2, STAGE_BYTES = 8 * HTB;
__host__ __device__ __forceinline__ int lds_byte(int r, int c) { const int st = (r >> 4) * 2 + (c >> 5), rr = r & 15, cc = c & 31, ob = rr * 64 + cc * 2; return st * 1024 + (ob ^ (((ob >> 9) & 1) << 5)); }
__host__ __device__ __forceinline__ void stage_rc(int b, int& R, int& C) { const int st = b / 1024, sb = b % 1024, swz = sb ^ (((sb >> 9) & 1) << 5); R = (st >> 1) * 16 + swz / 64; C = (st & 1) * 32 + (swz % 64) / 2; }
__host__ __device__ __forceinline__ int perm32(int rho) { const int n = rho >> 4, i = rho & 15; return 8 * (i >> 2) + 4 * n + (i & 3); }

struct Unit { const char* A; const char* B; int kind, pm, pn, e, nvalid, rbase; };
struct Gemm { int lda, ldb, K; };

__device__ __forceinline__ void tile_order(int L, int nM, int nN, int& pm, int& pn) {
    const int nwg = nM * nN; int wgid = L;
    { const int q = nwg / 8, r = nwg % 8, xcd = wgid % 8, off = wgid / 8; wgid = (xcd < r ? xcd * (q + 1) : r * (q + 1) + (xcd - r) * q) + off; }
    const int nig = 8 * nN, gid = wgid / nig, fm = gid * 8, gsz = (nM - fm) < 8 ? (nM - fm) : 8;
    pm = fm + ((wgid % nig) % gsz); pn = (wgid % nig) / gsz;
}

template <class Epi, class Sched, bool F8 = false>
__device__ __forceinline__ void gemm_phase(LAS unsigned char* lds, const Gemm g, const Sched& S, const Epi& E) {
    int tid_ = threadIdx.x; asm volatile("" : "+v"(tid_));
    const int tid = tid_, wid = __builtin_amdgcn_readfirstlane(tid >> 6), lane = tid & 63, wr = wid >> 2, wc = wid & 3, fr = lane & 15, fq = lane >> 4;
    const int K = g.K, nt = K / BK;
    unsigned voffA[2], voffB[2];
#pragma unroll
    for (int i = 0; i < 2; ++i) { int R, C; stage_rc(tid * 16 + i * 8192, R, C); const int Rb = Epi::PERM ? ((R & ~31) + perm32(R & 31)) : R;
        voffA[i] = (unsigned)(R * g.lda + C) * 2u; voffB[i] = (unsigned)(Rb * g.ldb + C) * 2u; }
    const size_t kstep = (size_t)(BK * 2);
    const size_t hstepA = (size_t)HALF * g.lda * 2, hstepB = (size_t)HALF * g.ldb * 2;
    const unsigned ldsw = (unsigned)wid * 1024u;
    const int aoff = lds_byte(wr * 64 + fr, fq * 8), boff = lds_byte(wc * 32 + fr, fq * 8);
#define PG8_SA(b, h) (((b) * 2 + (h)) * HTB)
#define PG8_SB(b, h) ((4 + (b) * 2 + (h)) * HTB)
#define PG8_STAGE(bufoff, gbase, voff) do { _Pragma("unroll") for (int _i = 0; _i < 2; ++_i) \
        __builtin_amdgcn_global_load_lds((const unsigned*)((const char*)(gbase) + (voff)[_i]), (LAS unsigned*)(lds + (bufoff) + ldsw + _i * 8192), 16, 0, 0); } while (0)
#define PG8_LDA(dst, b, h) do { _Pragma("unroll") for (int m = 0; m < 4; ++m) { const i32x4 lo_ = *(const LAS i32x4*)(lds + PG8_SA(b, h) + aoff + m * 2048), hi_ = *(const LAS i32x4*)(lds + PG8_SA(b, h) + aoff + m * 2048 + 1024); \
        dst[m] = __builtin_shufflevector(lo_, hi_, 0, 1, 2, 3, 4, 5, 6, 7); } } while (0)
#define PG8_LDB(dst, b, h) do { _Pragma("unroll") for (int n = 0; n < 2; ++n) { const i32x4 lo_ = *(const LAS i32x4*)(lds + PG8_SB(b, h) + boff + n * 2048), hi_ = *(const LAS i32x4*)(lds + PG8_SB(b, h) + boff + n * 2048 + 1024); \
        dst[n] = __builtin_shufflevector(lo_, hi_, 0, 1, 2, 3, 4, 5, 6, 7); } } while (0)
#define PG8_MMA(ai, bj, At, Bt) do { __builtin_amdgcn_s_setprio(1); _Pragma("unroll") for (int m = 0; m < 4; ++m) _Pragma("unroll") for (int n = 0; n < 2; ++n) { \
        if constexpr (F8) { asm volatile("v_mfma_f32_16x16x128_f8f6f4 %0, %1, %2, %0" : "+v"(acc[ai][bj][m][n]) : "v"(Bt[n]), "v"(At[m])); } \
        else { acc[ai][bj][m][n] = __builtin_amdgcn_mfma_f32_16x16x32_bf16(__builtin_bit_cast(bf16x8, __builtin_shufflevector(Bt[n], Bt[n], 0, 1, 2, 3)), __builtin_bit_cast(bf16x8, __builtin_shufflevector(At[m], At[m], 0, 1, 2, 3)), acc[ai][bj][m][n], 0, 0, 0); \
               acc[ai][bj][m][n] = __builtin_amdgcn_mfma_f32_16x16x32_bf16(__builtin_bit_cast(bf16x8, __builtin_shufflevector(Bt[n], Bt[n], 4, 5, 6, 7)), __builtin_bit_cast(bf16x8, __builtin_shufflevector(At[m], At[m], 4, 5, 6, 7)), acc[ai][bj][m][n], 0, 0, 0); } } \
        __builtin_amdgcn_s_setprio(0); } while (0)
#define PG8_WAIT_V(n) asm volatile("s_waitcnt vmcnt(" #n ")" ::: "memory")
#define PG8_WAIT_L(n) asm volatile("s_waitcnt lgkmcnt(" #n ")" ::: "memory")
#define PG8_BAR __builtin_amdgcn_s_barrier()
#define PG8_SCHED __builtin_amdgcn_sched_barrier(0)
    Unit cur, nxt; int ui = 0;
    if (!S.next(0, cur)) return;
    f32x4 acc[2][2][4][2];
#pragma unroll
    for (int a = 0; a < 2; ++a)
#pragma unroll
        for (int b = 0; b < 2; ++b)
#pragma unroll
            for (int m = 0; m < 4; ++m)
#pragma unroll
                for (int n = 0; n < 2; ++n) acc[a][b][m][n] = (f32x4){0.f, 0.f, 0.f, 0.f};
    i32x8 At[4], B0[2], B1[2];
    const char* cA = cur.A; const char* cB = cur.B;
    PG8_STAGE(PG8_SB(0, 0), cB, voffB); PG8_STAGE(PG8_SB(0, 1), cB + hstepB, voffB); PG8_STAGE(PG8_SA(0, 0), cA, voffA); PG8_STAGE(PG8_SA(0, 1), cA + hstepA, voffA);
    if (wr == 1) PG8_BAR;
    PG8_WAIT_V(2); PG8_BAR;
    PG8_STAGE(PG8_SB(1, 0), cB + kstep, voffB); PG8_STAGE(PG8_SA(1, 0), cA + kstep, voffA); PG8_STAGE(PG8_SB(1, 1), cB + hstepB + kstep, voffB);
    PG8_WAIT_V(6); PG8_BAR;
    for (;;) {
        const bool has_next = S.next(ui + 1, nxt);
        const char* nA = has_next ? nxt.A : cA; const char* nB = has_next ? nxt.B : cB;
        const bool full = cur.nvalid > HALF;
        for (int t = 0; t < nt; t += 2) {
            const bool last = (t == nt - 2);
            const char* a1 = cA + (size_t)(t + 1) * kstep;
            const char* a2 = last ? nA : cA + (size_t)(t + 2) * kstep; const char* b2 = last ? nB : cB + (size_t)(t + 2) * kstep;
            const char* a3 = a2 + kstep; const char* b3 = b2 + kstep;
            PG8_LDB(B0, 0, 0); PG8_LDB(B1, 0, 1); PG8_SCHED; PG8_LDA(At, 0, 0); PG8_STAGE(PG8_SA(1, 1), a1 + hstepA, voffA);
            PG8_WAIT_V(8); PG8_WAIT_L(0); PG8_BAR; PG8_MMA(0, 0, At, B0); PG8_MMA(0, 1, At, B1); PG8_BAR; PG8_SCHED;
            if (!F8 || full) PG8_LDA(At, 0, 1); PG8_STAGE(PG8_SB(0, 0), b2, voffB); PG8_STAGE(PG8_SB(0, 1), b2 + hstepB, voffB); PG8_STAGE(PG8_SA(0, 0), a2, voffA);
            PG8_WAIT_V(8); PG8_WAIT_L(0); PG8_BAR; if (!F8 || full) { PG8_MMA(1, 0, At, B0); PG8_MMA(1, 1, At, B1); } PG8_BAR; PG8_SCHED;
            PG8_LDB(B0, 1, 0); PG8_LDB(B1, 1, 1); PG8_SCHED; PG8_LDA(At, 1, 0); PG8_STAGE(PG8_SA(0, 1), a2 + hstepA, voffA);
            PG8_WAIT_V(8); PG8_WAIT_L(0); PG8_BAR; PG8_MMA(0, 0, At, B0); PG8_MMA(0, 1, At, B1); PG8_BAR; PG8_SCHED;
            if (!F8 || full) PG8_LDA(At, 1, 1); PG8_STAGE(PG8_SB(1, 0), b3, voffB); PG8_STAGE(PG8_SB(1, 1), b3 + hstepB, voffB); PG8_STAGE(PG8_SA(1, 0), a3, voffA);
            PG8_WAIT_V(8); PG8_WAIT_L(0); PG8_BAR; if (!F8 || full) { PG8_MMA(1, 0, At, B0); PG8_MMA(1, 1, At, B1); } PG8_BAR; PG8_SCHED;
        }
        if constexpr (F8) asm volatile("s_nop 15\n\ts_nop 15\n\ts_nop 7" ::: "memory");
        if (wr == 0) PG8_BAR;
        E(acc, cur, wr, wc, fr, fq);
        if (!has_next) break;
        if (!(Epi::CHAIN && cur.kind == 0)) {
#pragma unroll
        for (int a = 0; a < 2; ++a)
#pragma unroll
            for (int b = 0; b < 2; ++b)
#pragma unroll
                for (int m = 0; m < 4; ++m)
#pragma unroll
                    for (int n = 0; n < 2; ++n) acc[a][b][m][n] = (f32x4){0.f, 0.f, 0.f, 0.f};
        }
        cur = nxt; cA = nA; cB = nB; ++ui;
        if (wr == 1) PG8_BAR;
    }
    PG8_WAIT_V(0);
    PG8_BAR;
#undef PG8_SA
#undef PG8_SB
#undef PG8_STAGE
#undef PG8_LDA
#undef PG8_LDB
#undef PG8_MMA
#undef PG8_WAIT_V
#undef PG8_WAIT_L
#undef PG8_BAR
#undef PG8_SCHED
}
}
using pg8::Unit;

#define XB_TMO      128
#define XB_XCNT(j)  (256  + 64 * (j))
#define XB_XSUB(j)  (1280 + 64 * (j))
#define XB_XGEN(j)  (2304 + 64 * (j))
#define XB_TOP      3328
#define XB_TOPGEN   3392
#define XCD_BAR_WORDS 3456
#define XB_SPIN_CAP (1u << 18)
__device__ __forceinline__ unsigned xb_ld(unsigned* p)              { return __hip_atomic_load(p, __ATOMIC_RELAXED, __HIP_MEMORY_SCOPE_AGENT); }
__device__ __forceinline__ unsigned xb_add(unsigned* p, unsigned v) { return __hip_atomic_fetch_add(p, v, __ATOMIC_RELAXED, __HIP_MEMORY_SCOPE_AGENT); }
__device__ __forceinline__ unsigned xb_xcc_id() { return (unsigned)__builtin_amdgcn_s_getreg((3 << 11) | 20) & 0xFu; }
#define XB_SPIN(cond, bar) do { unsigned _sp = 0; while (cond) { __builtin_amdgcn_s_sleep(1); \
    if ((++_sp & 255u) == 0u) { if (xb_ld(&(bar)[XB_TMO])) break; if (_sp > XB_SPIN_CAP) { atomicAdd(&(bar)[XB_TMO], 1u); break; } } } } while (0)
struct XcdBarrier { unsigned* bar; unsigned x; volatile LAS unsigned* st; };
__device__ __forceinline__ XcdBarrier xcd_barrier_post(unsigned* bar, volatile LAS unsigned* st) {
    XcdBarrier b; b.bar = bar; b.x = xb_xcc_id(); b.st = st;
    if (threadIdx.x == 0) (void)xb_add(&bar[XB_XCNT(b.x)], 1u);
    return b;
}
__device__ __forceinline__ void xcd_barrier_complete(unsigned* bar, unsigned x, unsigned& nloc, unsigned& nx) {
    const unsigned G = gridDim.x * gridDim.y * gridDim.z;
    unsigned sum, cnt, mine, sp = 0u;
    for (;;) {
        sum = 0u; cnt = 0u; mine = 0u;
#pragma unroll
        for (unsigned j = 0; j < 16; ++j) { const unsigned c = xb_ld(&bar[XB_XCNT(j)]); sum += c; cnt += (c > 0u) ? 1u : 0u; mine = (j == x) ? c : mine; }
        if (sum == G) break;
        __builtin_amdgcn_s_sleep(1);
        if ((++sp & 255u) == 0u) { if (xb_ld(&bar[XB_TMO])) break; if (sp > XB_SPIN_CAP) { atomicAdd(&bar[XB_TMO], 1u); break; } }
    }
    nloc = mine > 0u ? mine : 1u; nx = cnt > 0u ? cnt : 1u;
}
__device__ __forceinline__ void xcd_barrier(const XcdBarrier& b) {
    asm volatile("s_waitcnt vmcnt(0)" ::: "memory");
    __syncthreads();
    if (threadIdx.x == 0) {
        unsigned* bar = b.bar;
        __builtin_amdgcn_s_waitcnt(0);
        unsigned nloc = b.st[0], nx = b.st[1];
        if (nloc == 0u) { xcd_barrier_complete(bar, b.x, nloc, nx); b.st[0] = nloc; b.st[1] = nx; }
        const unsigned old = xb_add(&bar[XB_XSUB(b.x)], 1u);
        const unsigned gen = old / nloc;
        if (old + 1u == (gen + 1u) * nloc) {
            __builtin_amdgcn_fence(__ATOMIC_RELEASE, "agent");
            asm volatile("s_waitcnt vmcnt(0)" ::: "memory");
            const unsigned og = xb_add(&bar[XB_TOP], 1u);
            const unsigned tg = og / nx;
            if (og + 1u == (tg + 1u) * nx) xb_add(&bar[XB_TOPGEN], 1u);
            else XB_SPIN(xb_ld(&bar[XB_TOPGEN]) == tg, bar);
            __builtin_amdgcn_fence(__ATOMIC_ACQUIRE, "agent");
            xb_add(&bar[XB_XGEN(b.x)], 1u);
            asm volatile("s_waitcnt vmcnt(0)" ::: "memory");
        } else {
            XB_SPIN(xb_ld(&bar[XB_XGEN(b.x)]) == gen, bar);
            __builtin_amdgcn_fence(__ATOMIC_ACQUIRE, "agent");
            asm volatile("s_waitcnt vmcnt(0)" ::: "memory");
        }
    }
    __syncthreads();
}

struct Args { const float* in[18]; float* out; unsigned char* ws; };

constexpr int I_UP1 = (D / 128) * (2 * DE / 32);
constexpr int I_DN1 = (DE / 128) * (D / 32);
constexpr int MOE_ITEMS = NE * (I_UP1 + I_DN1);
struct MoeItem { const float* src; unsigned char* dst; int ldw; };
__device__ __forceinline__ MoeItem moe_item(const Args& a, int r) {
    MoeItem m; unsigned char* ws = a.ws;
    if (r < NE * I_UP1) { const int e = r / I_UP1, q = r % I_UP1; const int nblk = 2 * DE / 32, kb = q / nblk, nb = q % nblk, k0 = kb * 128, n0 = nb * 32;
        const int nn = n0 < DE ? n0 : n0 - DE; const int row = (nn >> 7) * 256 + (nn & 127) + (n0 < DE ? 0 : 128);
        m.src = a.in[14] + ((size_t)e * D + k0) * (2 * DE) + n0; m.ldw = 2 * DE; m.dst = ws + WS_WUT + ((size_t)e * 2 * DE + row) * D + k0; }
    else { r -= NE * I_UP1; const int e = r / I_DN1, q = r % I_DN1; const int nblk = D / 32, kb = q / nblk, nb = q % nblk, k0 = kb * 128, n0 = nb * 32;
        m.src = a.in[16] + ((size_t)e * DE + k0) * D + n0; m.ldw = D; m.dst = ws + WS_WDT + ((size_t)e * D + n0) * DE + k0; }
    return m;
}
__device__ __forceinline__ void moe_load(f32x4 (&v)[16], const MoeItem& m, int lane) {
#pragma unroll
    for (int j = 0; j < 16; ++j) v[j] = __builtin_nontemporal_load((const f32x4*)(m.src + (size_t)(16 * (lane >> 3) + j) * m.ldw + 4 * (lane & 7)));
}
__device__ __forceinline__ void moe_store(const f32x4 (&v)[16], unsigned char* dst, int lane) {
#pragma unroll
    for (int i = 0; i < 4; ++i) { u32x4 o;
        o.x = pk4_fp8(v[0][i] * SC_W8, v[1][i] * SC_W8, v[2][i] * SC_W8, v[3][i] * SC_W8); o.y = pk4_fp8(v[4][i] * SC_W8, v[5][i] * SC_W8, v[6][i] * SC_W8, v[7][i] * SC_W8);
        o.z = pk4_fp8(v[8][i] * SC_W8, v[9][i] * SC_W8, v[10][i] * SC_W8, v[11][i] * SC_W8); o.w = pk4_fp8(v[12][i] * SC_W8, v[13][i] * SC_W8, v[14][i] * SC_W8, v[15][i] * SC_W8);
        __builtin_nontemporal_store(o, (u32x4*)(dst + (size_t)(4 * (lane & 7) + i) * DE + 16 * (lane >> 3))); }
}
__device__ __forceinline__ void moe_convert(const Args& a, LAS unsigned char* lds, int begin, int end, int wave, int lane) {
    int it = begin + wave;
    if (it >= end) return;
    f32x4 cur[16], nxt[16];
    MoeItem mc = moe_item(a, it);
    moe_load(cur, mc, lane);
    for (;;) {
        const int itn = it + NWAVES; const bool more = itn < end;
        MoeItem mn = mc;
        if (more) { mn = moe_item(a, itn); moe_load(nxt, mn, lane); }
        moe_store(cur, mc.dst, lane);
        if (!more) break;
#pragma unroll
        for (int j = 0; j < 16; ++j) cur[j] = nxt[j];
        mc = mn; it = itn;
    }
}

struct P0Item { const float* src; bf16* dst; int ldw, ldt; };
__device__ __forceinline__ P0Item p0_item(const Args& a, int r) {
    constexpr int I_IN = (D / 64) * (C_GB_END_BF / 32), I_A = (AW / 64) * (D / 32);
    unsigned char* ws = a.ws; bf16* W1T = (bf16*)(ws + WS_W1T); bf16* W2T = (bf16*)(ws + WS_W2T);
    P0Item m;
    if (r < I_IN) { const int nblk = C_GB_END_BF / 32, kb = r / nblk, nb = r % nblk, k0 = kb * 64, n0 = nb * 32;
        bf16* dst;
        if (n0 < 2048) dst = W1T + (size_t)n0 * D; else if (n0 < 3072) dst = W2T + (size_t)(n0 - 2048) * D; else if (n0 < 4096) dst = W1T + (size_t)(n0 - 1024) * D;
        else dst = W2T + (size_t)(n0 - 3072) * D;
        m.src = a.in[2] + (size_t)k0 * PW + n0; m.ldw = PW; m.dst = dst + k0; m.ldt = D; return m; }
    r -= I_IN;
    const int nblk = D / 32;
    if (r < I_A) { const int kb2 = r / nblk, nb = r % nblk, k0 = kb2 * 64, n0 = nb * 32; m.src = a.in[8] + (size_t)k0 * D + n0; m.ldw = D; m.dst = (bf16*)(ws + WS_WAT) + (size_t)n0 * AW + k0; m.ldt = AW; return m; }
    r -= I_A;
    if (r < I_A) { const int kb2 = r / nblk, nb = r % nblk, k0 = kb2 * 64, n0 = nb * 32; m.src = a.in[9] + (size_t)k0 * D + n0; m.ldw = D; m.dst = (bf16*)(ws + WS_WBT) + (size_t)n0 * SW + k0; m.ldt = SW; return m; }
    r -= I_A;
    { const int kb2 = r / nblk, nb = r % nblk, k0 = kb2 * 64, n0 = nb * 32; m.src = a.in[10] + (size_t)k0 * D + n0; m.ldw = D; m.dst = (bf16*)(ws + WS_WOT) + (size_t)n0 * D + k0; m.ldt = D; return m; }
}
__device__ __forceinline__ void p0_load(f32x4 (&v)[8], const P0Item& m, int lane) {
#pragma unroll
    for (int j = 0; j < 8; ++j) v[j] = __builtin_nontemporal_load((const f32x4*)(m.src + (size_t)(8 * (lane >> 3) + j) * m.ldw + 4 * (lane & 7)));
}
__device__ __forceinline__ void p0_store(const f32x4 (&v)[8], const P0Item& m, int lane) {
#pragma unroll
    for (int i = 0; i < 4; ++i) { u32x4 o; o.x = cvt_pk_bf16(v[0][i], v[1][i]); o.y = cvt_pk_bf16(v[2][i], v[3][i]); o.z = cvt_pk_bf16(v[4][i], v[5][i]); o.w = cvt_pk_bf16(v[6][i], v[7][i]);
        *(u32x4*)(m.dst + (size_t)(4 * (lane & 7) + i) * m.ldt + 8 * (lane >> 3)) = o; }
}
__device__ __forceinline__ void p0_prologue(const Args& a, LAS unsigned char* lds, int vcu, int G, int wave, int lane) {
    unsigned char* ws = a.ws;
    const int gw = vcu * NWAVES + wave, NGW = G * NWAVES;
    constexpr int NITEMS = (D / 64) * (C_GB_END_BF / 32) + 2 * (AW / 64) * (D / 32) + (D / 64) * (D / 32);
    for (int it = gw; it < (D / 128) * ((PW - C_GB_END_BF) / 32); it += NGW) { const int nblk = (PW - C_GB_END_BF) / 32, kb = it / nblk, nb = it % nblk;
        MoeItem m; m.src = a.in[2] + (size_t)(kb * 128) * PW + C_GB_END_BF + nb * 32; m.ldw = PW; m.dst = ws + WS_WG8 + (size_t)(nb * 32) * D + kb * 128;
        f32x4 v[16]; moe_load(v, m, lane); moe_store(v, m.dst, lane); }
    if (gw < NITEMS) {
        int it = gw; f32x4 cur[8], nxt[8]; P0Item mc = p0_item(a, it); p0_load(cur, mc, lane);
        for (;;) { const int itn = it + NGW; const bool more = itn < NITEMS; P0Item mn = mc;
            if (more) { mn = p0_item(a, itn); p0_load(nxt, mn, lane); }
            p0_store(cur, mc, lane);
            if (!more) break;
#pragma unroll
            for (int j = 0; j < 8; ++j) cur[j] = nxt[j];
            mc = mn; it = itn; }
    }
    const float* g1 = a.in[1];
    if (gw < T) {
        int m = gw; f32x4 v[8], vn[8];
        { const f32x4* xr = (const f32x4*)(a.in[0] + (size_t)m * D) + lane;
#pragma unroll
          for (int j = 0; j < 8; ++j) v[j] = __builtin_nontemporal_load(xr + 64 * j); }
        for (;;) { const int mn = m + NGW; const bool more = mn < T;
            if (more) { const f32x4* xr = (const f32x4*)(a.in[0] + (size_t)mn * D) + lane;
#pragma unroll
                for (int j = 0; j < 8; ++j) vn[j] = __builtin_nontemporal_load(xr + 64 * j); }
            float s = 0.f;
#pragma unroll
            for (int j = 0; j < 8; ++j) s += (v[j].x * v[j].x + v[j].y * v[j].y) + (v[j].z * v[j].z + v[j].w * v[j].w);
            const float rstd = rsqrtf(wave_sum(s) * (1.f / D) + EPS);
            u32x2* o8 = (u32x2*)((bf16*)(ws + WS_XN) + (size_t)m * D) + lane; unsigned* o4 = (unsigned*)(ws + WS_XN8 + (size_t)m * D) + lane;
#pragma unroll
            for (int j = 0; j < 8; ++j) { const f32x4 gg = *((const f32x4*)g1 + lane + 64 * j);
                const float y0 = v[j].x * rstd * gg.x, y1 = v[j].y * rstd * gg.y, y2 = v[j].z * rstd * gg.z, y3 = v[j].w * rstd * gg.w;
                u32x2 o; o.x = cvt_pk_bf16(y0, y1); o.y = cvt_pk_bf16(y2, y3); o8[64 * j] = o;
                o4[64 * j] = pk4_fp8(y0 * SC_XN8, y1 * SC_XN8, y2 * SC_XN8, y3 * SC_XN8); }
            if (!more) break;
#pragma unroll
            for (int j = 0; j < 8; ++j) v[j] = vn[j];
            m = mn; }
    }
}

struct Epi1 {
    static constexpr bool PERM = true, CHAIN = false;
    bf16* PB; bf16* VT; bf16* QB; bf16* KB; float* stats; const float* gq; const float* gk; LAS float* scr;
    __device__ __forceinline__ void operator()(f32x4 (&acc)[2][2][4][2], const Unit& u, int wr, int wc, int fr, int fq) const {
        if (u.kind == 0) {
            const int pn = u.pn;
            bf16* base = PB + (size_t)(u.pm * 256 + wr * 64 + fr) * N1 + pn * 256 + wc * 32 + 8 * fq;
            if (pn < 8) {
#pragma unroll
                for (int ai = 0; ai < 2; ++ai)
#pragma unroll
                    for (int m = 0; m < 4; ++m)
#pragma unroll
                        for (int bj = 0; bj < 2; ++bj) { const f32x4 x0 = acc[ai][bj][m][0], x1 = acc[ai][bj][m][1];
                            float s = (x0.x * x0.x + x0.y * x0.y) + (x0.z * x0.z + x0.w * x0.w) + (x1.x * x1.x + x1.y * x1.y) + (x1.z * x1.z + x1.w * x1.w);
                            s += __shfl_xor(s, 16); s += __shfl_xor(s, 32);
                            if (fq == 0) scr[(ai * 128 + wr * 64 + m * 16 + fr) * 8 + bj * 4 + wc] = s; }
                LDS_WAIT(); __builtin_amdgcn_s_barrier(); asm volatile("" ::: "memory");
                const float* gn = (pn < 4) ? gq : gk; const float sc = (pn < 4) ? 0.12751743082459868f : 1.f;
                const f32x4 g0 = *(const f32x4*)(gn + wc * 32 + 8 * fq), g1 = *(const f32x4*)(gn + wc * 32 + 8 * fq + 4);
                bf16* qkb = (pn < 4 ? QB : KB) + ((size_t)(((u.pm * 256) >> 12) * NH + (pn & 3) * 2) * SEQ + ((u.pm * 256) & (SEQ - 1)) + wr * 64 + fr) * HD + wc * 32 + 8 * fq;
#pragma unroll
                for (int ai = 0; ai < 2; ++ai)
#pragma unroll
                    for (int m = 0; m < 4; ++m) { const int row = ai * 128 + wr * 64 + m * 16 + fr;
#pragma unroll
                        for (int bj = 0; bj < 2; ++bj) { const f32x4 p = *(const LAS f32x4*)(scr + row * 8 + bj * 4);
                            const float rinv = rsqrtf(((p.x + p.y) + (p.z + p.w)) * (1.f / HD) + EPS) * sc;
                            const f32x4 v0 = acc[ai][bj][m][0] * rinv * g0, v1 = acc[ai][bj][m][1] * rinv * g1;
                            u32x4 w; w.x = cvt_pk_bf16(v0.x, v0.y); w.y = cvt_pk_bf16(v0.z, v0.w); w.z = cvt_pk_bf16(v1.x, v1.y); w.w = cvt_pk_bf16(v1.z, v1.w);
                            *(u32x4*)(qkb + (size_t)(ai * 128 + m * 16) * HD + (size_t)bj * SEQ * HD) = w; } __builtin_amdgcn_sched_barrier(0); }
                LDS_WAIT();
            } else {
#pragma unroll
                for (int ai = 0; ai < 2; ++ai)
#pragma unroll
                    for (int m = 0; m < 4; ++m)
#pragma unroll
                        for (int bj = 0; bj < 2; ++bj) { f32x4 v0 = acc[ai][bj][m][0], v1 = acc[ai][bj][m][1];
#pragma unroll
                            for (int j = 0; j < 4; ++j) { v0[j] = gelu_tanh_f(v0[j]); v1[j] = gelu_tanh_f(v1[j]); }
                            u32x4 w; w.x = cvt_pk_bf16(v0.x, v0.y); w.y = cvt_pk_bf16(v0.z, v0.w); w.z = cvt_pk_bf16(v1.x, v1.y); w.w = cvt_pk_bf16(v1.z, v1.w);
                            *(u32x4*)(base + (size_t)(ai * 128 + m * 16) * N1 + bj * 128) = w; __builtin_amdgcn_sched_barrier(0); }
            }
        } else {
            const bool is_vv = u.pm >= 4;
            bf16* vtb = VT + ((((size_t)(((u.pn * 256) >> 12) * 16 + u.pm * 2) * 128 + (((u.pn * 256) & (SEQ - 1)) >> 5) + wc) * 128 + wr * 64 + fr) * 32 + 8 * fq);
            if (is_vv) {
#pragma unroll
                for (int bj = 0; bj < 2; ++bj)
#pragma unroll
                    for (int n = 0; n < 2; ++n) { f32x4 s = (f32x4){0.f, 0.f, 0.f, 0.f}, q = s;
#pragma unroll
                        for (int ai = 0; ai < 2; ++ai)
#pragma unroll
                            for (int m = 0; m < 4; ++m) { f32x4 x = acc[ai][bj][m][n];
#pragma unroll
                                for (int j = 0; j < 4; ++j) x[j] = gelu_tanh_f(x[j]);
                                s += x; q += x * x; }
#pragma unroll
                        for (int o = 1; o < 16; o <<= 1) {
#pragma unroll
                            for (int j = 0; j < 4; ++j) { s[j] += __shfl_xor(s[j], o); q[j] += __shfl_xor(q[j], o); } }
                        if (fr == 0) { const int slot = (u.pm - 4) * 2 + wr; float* sp = stats + ((size_t)(u.pn * 256 + bj * 128 + wc * 32 + 8 * fq + 4 * n) * 8 + slot) * 2;
#pragma unroll
                            for (int j = 0; j < 4; ++j) *(f32x2*)(sp + 16 * j) = (f32x2){s[j], q[j]}; }
                        __builtin_amdgcn_sched_barrier(0); }
            }
#pragma unroll
            for (int ai = 0; ai < 2; ++ai)
#pragma unroll
                for (int m = 0; m < 4; ++m)
#pragma unroll
                    for (int bj = 0; bj < 2; ++bj) { f32x4 v0 = acc[ai][bj][m][0], v1 = acc[ai][bj][m][1];
                        if (is_vv) {
#pragma unroll
                            for (int j = 0; j < 4; ++j) { v0[j] = gelu_tanh_f(v0[j]); v1[j] = gelu_tanh_f(v1[j]); } }
                        u32x4 w; w.x = cvt_pk_bf16(v0.x, v0.y); w.y = cvt_pk_bf16(v0.z, v0.w); w.z = cvt_pk_bf16(v1.x, v1.y); w.w = cvt_pk_bf16(v1.z, v1.w);
                        *(u32x4*)(vtb + (size_t)ai * (128 * 128 * 32) + bj * (4 * 128 * 32) + m * (16 * 32)) = w; __builtin_amdgcn_sched_barrier(0); }
        }
    }
};
struct Sched1 {
    int G, c; const char* XN; const char* W1T; const char* W2T;
    __device__ __forceinline__ bool next(int i, Unit& u) const {
        const int L = i * G + c; if (L >= 640) return false;
        u.e = 0; u.nvalid = 256; u.rbase = 0;
        if (L < 384) { pg8::tile_order(L, 32, 12, u.pm, u.pn); u.kind = 0; u.A = XN + (size_t)u.pm * 256 * D * 2; u.B = W1T + (size_t)u.pn * 256 * D * 2; }
        else { pg8::tile_order(L - 384, 8, 32, u.pm, u.pn); u.kind = 1; u.A = W2T + (size_t)u.pm * 256 * D * 2; u.B = XN + (size_t)u.pn * 256 * D * 2; }
        return true;
    }
};
struct Epi1g {
    static constexpr bool PERM = true, CHAIN = false;
    bf16* PB;
    __device__ __forceinline__ void operator()(f32x4 (&acc)[2][2][4][2], const Unit& u, int wr, int wc, int fr, int fq) const {
        constexpr float ds = 1.f / (SC_XN8 * SC_W8);
        bf16* base = PB + (size_t)(u.pm * 256 + wr * 64 + fr) * N1 + C_GA + u.pn * 256 + wc * 32 + 8 * fq;
#pragma unroll
        for (int ai = 0; ai < 2; ++ai)
#pragma unroll
            for (int m = 0; m < 4; ++m)
#pragma unroll
                for (int bj = 0; bj < 2; ++bj) { f32x4 v0 = acc[ai][bj][m][0] * ds, v1 = acc[ai][bj][m][1] * ds;
#pragma unroll
                    for (int j = 0; j < 4; ++j) { v0[j] = sigmoid_f(v0[j]); v1[j] = sigmoid_f(v1[j]); }
                    u32x4 w; w.x = cvt_pk_bf16(v0.x, v0.y); w.y = cvt_pk_bf16(v0.z, v0.w); w.z = cvt_pk_bf16(v1.x, v1.y); w.w = cvt_pk_bf16(v1.z, v1.w);
                    *(u32x4*)(base + (size_t)(ai * 128 + m * 16) * N1 + bj * 128) = w; __builtin_amdgcn_sched_barrier(0); }
    }
};
struct Sched1g {
    int G, c; const char* XN8; const char* WG8;
    __device__ __forceinline__ bool next(int i, Unit& u) const {
        const int L = i * G + c; if (L >= 512) return false;
        u.e = 0; u.nvalid = 256; u.rbase = 0; u.kind = 0;
        pg8::tile_order(L, 32, 16, u.pm, u.pn); u.A = XN8 + (size_t)u.pm * 256 * D; u.B = WG8 + (size_t)u.pn * 256 * D;
        return true;
    }
};

__device__ __forceinline__ void attn_task(const bf16* QB, const bf16* KB, const bf16* VT, bf16* OA, int task, int lane) {
    const int bh = task >> 7, qb = task & 127, b = bh >> 3, h = bh & 7;
    const int c = lane & 31, hh = lane >> 5;
    const size_t tokbase = (size_t)b * SEQ;
    const int t0 = qb * 32;
    bf16x8 qf[8];
    { const bf16* qp = QB + ((size_t)bh * SEQ + t0 + c) * HD + 8 * hh;
#pragma unroll
      for (int s = 0; s < 8; ++s) qf[s] = *(const bf16x8*)(qp + 16 * s); }
    f32x16 o[4];
#pragma unroll
    for (int d = 0; d < 4; ++d)
#pragma unroll
        for (int r = 0; r < 16; ++r) o[d][r] = 0.f;
    float crun = 0.f;
    const int kap = 16 * ((c >> 2) & 1) + 4 * (c >> 3) + (c & 3);
    const bf16* kp0 = KB + ((size_t)bh * SEQ + kap) * HD + 8 * hh;
    const bf16* vp0 = VT + ((size_t)(b * 16 + h) * 128 * 128 + c) * 32 + 16 * hh;
    bf16x8 kf[8];
#pragma unroll
    for (int s = 0; s < 8; ++s) kf[s] = *(const bf16x8*)(kp0 + (size_t)t0 * HD + 16 * s);
    for (int j = qb; j >= 0; --j) {
        const int kbase = j * 32;
        bf16x8 vf[4][2];
#pragma unroll
        for (int d = 0; d < 4; ++d)
#pragma unroll
            for (int s = 0; s < 2; ++s) vf[d][s] = *(const bf16x8*)(vp0 + (size_t)j * 4096 + d * 1024 + 8 * s);
        f32x16 S;
#pragma unroll
        for (int r = 0; r < 16; ++r) S[r] = 0.f;
#pragma unroll
        for (int s = 0; s < 8; ++s) S = __builtin_amdgcn_mfma_f32_32x32x16_bf16(kf[s], qf[s], S, 0, 0, 0);
        if (j > 0) {
#pragma unroll
            for (int s = 0; s < 8; ++s) kf[s] = *(const bf16x8*)(kp0 + (size_t)(kbase - 32) * HD + 16 * s);
        }
        const int tq = t0 + c, k0 = kbase + 16 * hh;
        float Lk[16], run = 0.f;
        if (j == qb) {
#pragma unroll
            for (int r = 0; r < 16; ++r) { const float z = S[r]; const float sp = fmaxf(z, 0.f) + __builtin_amdgcn_logf(1.f + __builtin_amdgcn_exp2f(-fabsf(z)));
                const bool past = (k0 + r) < tq; Lk[r] = past ? -sp : 0.f; S[r] = past ? z : -1e30f; run += Lk[r]; }
        } else {
#pragma unroll
            for (int r = 0; r < 16; ++r) { const float z = S[r]; const float sp = fmaxf(z, 0.f) + __builtin_amdgcn_logf(1.f + __builtin_amdgcn_exp2f(-fabsf(z))); Lk[r] = -sp; run += Lk[r]; }
        }
        const float other = __shfl_xor(run, 32);
        float acc_after = crun + (hh == 0 ? other : 0.f);
        float w[16];
#pragma unroll
        for (int r = 15; r >= 0; --r) { w[r] = __builtin_amdgcn_exp2f((S[r] + Lk[r]) + acc_after); acc_after += Lk[r]; }
        crun += run + other;
        bf16x8 pf[2];
#pragma unroll
        for (int s = 0; s < 2; ++s) { u32x4 pk; pk.x = cvt_pk_bf16(w[8 * s + 0], w[8 * s + 1]); pk.y = cvt_pk_bf16(w[8 * s + 2], w[8 * s + 3]); pk.z = cvt_pk_bf16(w[8 * s + 4], w[8 * s + 5]); pk.w = cvt_pk_bf16(w[8 * s + 6], w[8 * s + 7]);
            pf[s] = __builtin_bit_cast(bf16x8, pk); }
#pragma unroll
        for (int d = 0; d < 4; ++d)
#pragma unroll
            for (int s = 0; s < 2; ++s) o[d] = __builtin_amdgcn_mfma_f32_32x32x16_bf16(vf[d][s], pf[s], o[d], 0, 0, 0);
        if (__all(crun < -151.f)) break;
    }
    bf16* op = OA + (tokbase + t0 + c) * AW + h * HD + 4 * hh;
#pragma unroll
    for (int d = 0; d < 4; ++d)
#pragma unroll
        for (int g = 0; g < 4; ++g) { u32x2 pk; pk.x = cvt_pk_bf16(o[d][4 * g + 0], o[d][4 * g + 1]); pk.y = cvt_pk_bf16(o[d][4 * g + 2], o[d][4 * g + 3]);
            *(u32x2*)(op + d * 32 + 8 * g) = pk; }
}

__device__ __forceinline__ void sgu_task(const Args& a, const bf16* PB, const bf16* VT, const float* stats, bf16* OB, int idx, int lane) {
    const int ib = idx & 3, g = (idx >> 2) & 7, n = idx >> 5;
    const int c = lane & 31, hh = lane >> 5;
    const float* wsp = a.in[6] + ((size_t)g * 128 + ib * 32 + c) * 128 + 8 * hh;
    const bf16* vvp = VT + (((size_t)((n >> 5) * 16 + 8 + g) * 128 + (n & 31) * 4) * 128 + c) * 32 + 8 * hh;
    f32x16 acc[4];
#pragma unroll
    for (int d = 0; d < 4; ++d)
#pragma unroll
        for (int r = 0; r < 16; ++r) acc[d][r] = 0.f;
    const int nks = ib < 2 ? 4 : 8;
    for (int ks = 0; ks < nks; ++ks) {
        float mu[8], rs[8];
        { const f32x4 st = *(const f32x4*)(stats + ((size_t)(n * 128 + 16 * ks + (lane >> 2)) * 8 + 2 * (lane & 3)) * 2);
          float S = st.x + st.z, Q = st.y + st.w;
          S += __shfl_xor(S, 1); Q += __shfl_xor(Q, 1); S += __shfl_xor(S, 2); Q += __shfl_xor(Q, 2);
          const float m_ = S * (1.f / SW), r_ = rsqrtf(fmaxf(Q * (1.f / SW) - m_ * m_, 0.f) + EPS);
#pragma unroll
          for (int j = 0; j < 8; ++j) { mu[j] = __shfl(m_, 4 * (8 * hh + j)); rs[j] = __shfl(r_, 4 * (8 * hh + j)); } }
        const f32x4 w0 = *(const f32x4*)(wsp + 16 * ks), w1 = *(const f32x4*)(wsp + 16 * ks + 4);
        u32x4 bw; bw.x = cvt_pk_bf16(w0.x, w0.y); bw.y = cvt_pk_bf16(w0.z, w0.w); bw.z = cvt_pk_bf16(w1.x, w1.y); bw.w = cvt_pk_bf16(w1.z, w1.w);
        const bf16x8 bfrag = __builtin_bit_cast(bf16x8, bw);
#pragma unroll
        for (int cbk = 0; cbk < 4; ++cbk) {
            const u32x4 raw = *(const u32x4*)(vvp + (size_t)(ks >> 1) * 4096 + cbk * 1024 + 16 * (ks & 1));
            u32x4 nv;
            nv.x = cvt_pk_bf16((bf_lo(raw.x) - mu[0]) * rs[0], (bf_hi(raw.x) - mu[1]) * rs[1]);
            nv.y = cvt_pk_bf16((bf_lo(raw.y) - mu[2]) * rs[2], (bf_hi(raw.y) - mu[3]) * rs[3]);
            nv.z = cvt_pk_bf16((bf_lo(raw.z) - mu[4]) * rs[4], (bf_hi(raw.z) - mu[5]) * rs[5]);
            nv.w = cvt_pk_bf16((bf_lo(raw.w) - mu[6]) * rs[6], (bf_hi(raw.w) - mu[7]) * rs[7]);
            acc[cbk] = __builtin_amdgcn_mfma_f32_32x32x16_bf16(__builtin_bit_cast(bf16x8, nv), bfrag, acc[cbk], 0, 0, 0);
        }
    }
    const int tok = n * 128 + ib * 32 + c;
    const float bsp = a.in[7][g * 128 + ib * 32 + c];
    const float* gam = a.in[5] + g * 128 + 4 * hh;
    const bf16* up = PB + (size_t)tok * N1 + C_U + g * 128 + 4 * hh;
    bf16* op = OB + (size_t)tok * SW + g * 128 + 4 * hh;
#pragma unroll
    for (int d = 0; d < 4; ++d)
#pragma unroll
        for (int gg = 0; gg < 4; ++gg) { const f32x4 gm = *(const f32x4*)(gam + d * 32 + 8 * gg); const u32x2 uu = *(const u32x2*)(up + d * 32 + 8 * gg);
            const float r0 = bf_lo(uu.x) * (gm.x * acc[d][4 * gg + 0] + bsp), r1 = bf_hi(uu.x) * (gm.y * acc[d][4 * gg + 1] + bsp);
            const float r2 = bf_lo(uu.y) * (gm.z * acc[d][4 * gg + 2] + bsp), r3 = bf_hi(uu.y) * (gm.w * acc[d][4 * gg + 3] + bsp);
            u32x2 pk; pk.x = cvt_pk_bf16(r0, r1); pk.y = cvt_pk_bf16(r2, r3); *(u32x2*)(op + d * 32 + 8 * gg) = pk; }
}

struct Epi3 {
    static constexpr bool PERM = true, CHAIN = true;
    const bf16* PB; bf16* Y;
    __device__ __forceinline__ void operator()(f32x4 (&acc)[2][2][4][2], const Unit& u, int wr, int wc, int fr, int fq) const {
        const int row0 = u.pm * 256 + wr * 64 + fr, col0 = u.pn * 256 + wc * 32 + 8 * fq;
        const bf16* gpa = PB + (size_t)row0 * N1 + C_GA + col0; const bf16* gpb = PB + (size_t)row0 * N1 + C_GB + col0;
#pragma unroll
        for (int ai = 0; ai < 2; ++ai)
#pragma unroll
            for (int m = 0; m < 4; ++m)
#pragma unroll
                for (int bj = 0; bj < 2; ++bj) { const size_t ro = (size_t)(ai * 128 + m * 16);
                    const u32x4 gb = *(const u32x4*)(gpb + ro * N1 + bj * 128);
                    f32x4 b0, b1;
                    b0.x = fmaxf(bf_lo(gb.x), 1e-20f); b0.y = fmaxf(bf_hi(gb.x), 1e-20f); b0.z = fmaxf(bf_lo(gb.y), 1e-20f); b0.w = fmaxf(bf_hi(gb.y), 1e-20f);
                    b1.x = fmaxf(bf_lo(gb.z), 1e-20f); b1.y = fmaxf(bf_hi(gb.z), 1e-20f); b1.z = fmaxf(bf_lo(gb.w), 1e-20f); b1.w = fmaxf(bf_hi(gb.w), 1e-20f);
                    if (u.kind == 0) {
                        const u32x4 ga = *(const u32x4*)(gpa + ro * N1 + bj * 128);
                        f32x4 r0, r1;
                        r0.x = bf_lo(ga.x) * fast_rcp(b0.x); r0.y = bf_hi(ga.x) * fast_rcp(b0.y); r0.z = bf_lo(ga.y) * fast_rcp(b0.z); r0.w = bf_hi(ga.y) * fast_rcp(b0.w);
                        r1.x = bf_lo(ga.z) * fast_rcp(b1.x); r1.y = bf_hi(ga.z) * fast_rcp(b1.y); r1.z = bf_lo(ga.w) * fast_rcp(b1.z); r1.w = bf_hi(ga.w) * fast_rcp(b1.w);
                        acc[ai][bj][m][0] *= r0; acc[ai][bj][m][1] *= r1;
                    } else {
                        const f32x4 v0 = acc[ai][bj][m][0] * b0, v1 = acc[ai][bj][m][1] * b1;
                        u32x4 w; w.x = cvt_pk_bf16(v0.x, v0.y); w.y = cvt_pk_bf16(v0.z, v0.w); w.z = cvt_pk_bf16(v1.x, v1.y); w.w = cvt_pk_bf16(v1.z, v1.w);
                        *(u32x4*)(Y + (size_t)(row0 + ro) * D + col0 + bj * 128) = w; } }
    }
};
struct Sched3 {
    int G, c; const char* OA; const char* OB; const char* WAT; const char* WBT;
    __device__ __forceinline__ bool next(int i, Unit& u) const {
        const int tile = c + (i >> 1) * G; if (tile >= 256) return false;
        pg8::tile_order(tile, 32, 8, u.pm, u.pn); u.kind = i & 1; u.e = 0; u.nvalid = 256; u.rbase = 0;
        u.A = (u.kind == 0 ? OA : OB) + (size_t)u.pm * 256 * AW * 2; u.B = (u.kind == 0 ? WAT : WBT) + (size_t)u.pn * 256 * AW * 2;
        return true;
    }
};

struct Epi4 {
    static constexpr bool PERM = true, CHAIN = false;
    const float* X; bf16* H1;
    __device__ __forceinline__ void operator()(f32x4 (&acc)[2][2][4][2], const Unit& u, int wr, int wc, int fr, int fq) const {
        const size_t o0 = (size_t)(u.pm * 256 + wr * 64 + fr) * D + u.pn * 256 + wc * 32 + 8 * fq;
#pragma unroll
        for (int ai = 0; ai < 2; ++ai)
#pragma unroll
            for (int m = 0; m < 4; ++m)
#pragma unroll
                for (int bj = 0; bj < 2; ++bj) { const size_t o = o0 + (size_t)(ai * 128 + m * 16) * D + bj * 128;
                    const f32x4 v0 = *(const f32x4*)(X + o) + acc[ai][bj][m][0], v1 = *(const f32x4*)(X + o + 4) + acc[ai][bj][m][1];
                    u32x4 w; w.x = cvt_pk_bf16(v0.x, v0.y); w.y = cvt_pk_bf16(v0.z, v0.w); w.z = cvt_pk_bf16(v1.x, v1.y); w.w = cvt_pk_bf16(v1.z, v1.w);
                    *(u32x4*)(H1 + o) = w; }
    }
};
struct Sched4 {
    int G, c; const char* Y; const char* WOT;
    __device__ __forceinline__ bool next(int i, Unit& u) const {
        const int tile = c + i * G; if (tile >= 256) return false;
        pg8::tile_order(tile, 32, 8, u.pm, u.pn); u.kind = 0; u.e = 0; u.nvalid = 256; u.rbase = 0;
        u.A = Y + (size_t)u.pm * 256 * D * 2; u.B = WOT + (size_t)u.pn * 256 * D * 2;
        return true;
    }
};

template <int PH> struct SchedMoE {
    int G, vcu; const volatile LAS unsigned* misc; const char* Abase; const char* Bbase; int ncu;
    __device__ __forceinline__ bool next(int i, Unit& u) const {
        const volatile LAS unsigned* us = misc + (PH == 6 ? MW_US6 : MW_US7);
        const int total = __builtin_amdgcn_readfirstlane((int)us[NE]);
        int L;
        if ((G & 255) == 0) { const int nx = G >> 5, chunk = (total + nx - 1) / nx, x = vcu >> 5, j = vcu & 31;
            if (ncu == 32) { L = x * chunk + i * 32 + j; if (L >= (x + 1) * chunk) return false; }
            else {
                int len = total - x * chunk; len = len < 0 ? 0 : (len > chunk ? chunk : len);
                const int R = len / ncu - MOE_TAIL_TEST;
                if (j < ncu) { if (i >= R) return false; L = x * chunk + i * ncu + j; }
                else { const int p = i * (32 - ncu) + (j - ncu); if (p >= len - R * ncu) return false; L = x * chunk + R * ncu + p; } } }
        else L = i * G + vcu;
        if (L >= total) return false;
        const int ln = (int)(threadIdx.x & 63);
        const unsigned mine = us[ln < NE ? ln : NE];
        const unsigned long long mk = __ballot((unsigned)L >= mine);
        const int e = __builtin_amdgcn_readfirstlane(63 - __builtin_clzll(mk | 1ull));
        const int ne = __builtin_amdgcn_readfirstlane((int)misc[MW_CNT + e]), off = __builtin_amdgcn_readfirstlane((int)misc[MW_OFF + e]);
        const int st = __builtin_amdgcn_readfirstlane((int)us[e]);
        const int mte = (ne + 255) >> 8, rem = L - st, mt = rem % mte, ntl = rem / mte;
        u.kind = 0; u.pm = mt; u.pn = ntl; u.e = e; u.nvalid = ne - mt * 256; u.rbase = off + mt * 256;
        if (PH == 6) { u.A = Abase + ((size_t)e * T + (size_t)mt * 256) * D; u.B = Bbase + ((size_t)e * 2 * DE + (size_t)ntl * 256) * D; }
        else { u.A = Abase + (size_t)u.rbase * DE; u.B = Bbase + ((size_t)e * D + (size_t)ntl * 256) * DE; }
        return true;
    }
};
__device__ __forceinline__ f32x2 swiglu_pk(f32x2 g, f32x2 u) {
    const f32x2 ga = __builtin_elementwise_min(g, (f32x2){7.f, 7.f});
    const f32x2 ua = __builtin_elementwise_min(__builtin_elementwise_max(u, (f32x2){-7.f, -7.f}), (f32x2){7.f, 7.f});
    const f32x2 t = ga * (-1.702f * 1.4426950408889634f);
    f32x2 d; d.x = __builtin_amdgcn_exp2f(t.x); d.y = __builtin_amdgcn_exp2f(t.y); d = d + 1.0f;
    f32x2 r; r.x = __builtin_amdgcn_rcpf(d.x); r.y = __builtin_amdgcn_rcpf(d.y);
    return (ga * r) * (ua * SC_A8 + SC_A8);
}
__device__ __forceinline__ unsigned pk4_fp8_nc(float a, float b, float c, float d) { int r = 0; r = __builtin_amdgcn_cvt_pk_fp8_f32(a, b, r, false); r = __builtin_amdgcn_cvt_pk_fp8_f32(c, d, r, true); return (unsigned)r; }
struct Epi6 {
    static constexpr bool PERM = true, CHAIN = false;
    const float* bup; unsigned char* ACT;
    __device__ __forceinline__ void operator()(f32x4 (&acc)[2][2][4][2], const Unit& u, int wr, int wc, int fr, int fq) const {
        const int cc = u.pn * 128 + wc * 32 + 8 * fq;
        const float* bg = bup + (size_t)u.e * 2 * DE + cc;
        const f32x4 bg0 = *(const f32x4*)bg, bg1 = *(const f32x4*)(bg + 4), bu0 = *(const f32x4*)(bg + DE), bu1 = *(const f32x4*)(bg + DE + 4);
        constexpr float ds = 1.f / (SC_W8 * SC_X8);
#pragma unroll
        for (int ai = 0; ai < 2; ++ai)
#pragma unroll
            for (int m = 0; m < 4; ++m) { const int row = ai * 128 + wr * 64 + m * 16 + fr;
                const f32x4 g0 = acc[ai][0][m][0] * ds + bg0, g1 = acc[ai][0][m][1] * ds + bg1, u0 = acc[ai][1][m][0] * ds + bu0, u1 = acc[ai][1][m][1] * ds + bu1;
                const f32x2 a0 = swiglu_pk((f32x2){g0.x, g0.y}, (f32x2){u0.x, u0.y}), a1 = swiglu_pk((f32x2){g0.z, g0.w}, (f32x2){u0.z, u0.w});
                const f32x2 a2 = swiglu_pk((f32x2){g1.x, g1.y}, (f32x2){u1.x, u1.y}), a3 = swiglu_pk((f32x2){g1.z, g1.w}, (f32x2){u1.z, u1.w});
                if (row < u.nvalid) { u32x2 w; w.x = pk4_fp8_nc(a0.x, a0.y, a1.x, a1.y); w.y = pk4_fp8_nc(a2.x, a2.y, a3.x, a3.y);
                    *(u32x2*)(ACT + (size_t)(u.rbase + row) * DE + cc) = w; } }
    }
};
struct Epi7 {
    static constexpr bool PERM = true, CHAIN = false;
    const float* bdn; bf16* YM;
    __device__ __forceinline__ void operator()(f32x4 (&acc)[2][2][4][2], const Unit& u, int wr, int wc, int fr, int fq) const {
        const int cc = u.pn * 256 + wc * 32 + 8 * fq;
        const float* bp = bdn + (size_t)u.e * D + cc;
        f32x4 bb[2][2];
#pragma unroll
        for (int bj = 0; bj < 2; ++bj) { bb[bj][0] = *(const f32x4*)(bp + bj * 128); bb[bj][1] = *(const f32x4*)(bp + bj * 128 + 4); }
#pragma unroll
        for (int ai = 0; ai < 2; ++ai)
#pragma unroll
            for (int m = 0; m < 4; ++m) { const int row = ai * 128 + wr * 64 + m * 16 + fr;
                if (row < u.nvalid) {
#pragma unroll
                    for (int bj = 0; bj < 2; ++bj) { constexpr float ds = 1.f / (SC_W8 * SC_A8); const f32x4 v0 = acc[ai][bj][m][0] * ds + bb[bj][0], v1 = acc[ai][bj][m][1] * ds + bb[bj][1];
                        u32x4 w; w.x = cvt_pk_bf16(v0.x, v0.y); w.y = cvt_pk_bf16(v0.z, v0.w); w.z = cvt_pk_bf16(v1.x, v1.y); w.w = cvt_pk_bf16(v1.z, v1.w);
                        *(u32x4*)(YM + (size_t)(u.rbase + row) * D + cc + bj * 128) = w; } } }
    }
};

__global__ void __launch_bounds__(NWAVES * 64, 2) fwd(Args a) {
    extern __shared__ __attribute__((aligned(16))) unsigned char lds_raw[];
    LAS unsigned char* lds = (LAS unsigned char*)lds_raw;
    volatile LAS unsigned* MISC = (volatile LAS unsigned*)(lds + MISC_OFF);
    const int tid = threadIdx.x, lane = tid & 63, wave = __builtin_amdgcn_readfirstlane(tid >> 6);
    const int G = gridDim.x, bx = blockIdx.x;
    const int vcu = (G % 8 == 0) ? (bx % 8) * (G / 8) + bx / 8 : bx;
    unsigned char* ws = a.ws;
    unsigned* ctl = (unsigned*)(ws + WS_CTL);
    for (int u = tid; u < 512; u += NWAVES * 64) MISC[u] = 0u;
    __syncthreads();
    XcdBarrier bar = xcd_barrier_post(ctl + CW_BAR, MISC + MW_BAR);
    const int gw = vcu * NWAVES + wave, NGW = G * NWAVES;

    bf16* PB = (bf16*)(ws + WS_PB); bf16* VT = (bf16*)(ws + WS_VT); bf16* OA = (bf16*)(ws + WS_OA); bf16* OB = (bf16*)(ws + WS_OB);
    float* stats = (float*)(ws + WS_STATS);
    int* tok_e = (int*)(ws + WS_ROUTE); int* tok_rank = tok_e + T * TOPK; float* tok_gate = (float*)(tok_rank + T * TOPK);

    if (PH_ON(0)) p0_prologue(a, lds, vcu, G, wave, lane);
    xcd_barrier(bar);

    if (PH_ON(1)) {
        int cbeg, cend;
        constexpr int NUP = NE * I_UP1;
        const bool split6 = (G == 256);
        const int CONV1 = split6 ? NUP : MOE_ITEMS;
        if (G == 256) { constexpr int S5 = 220, S4 = 292; static_assert(128 * (S5 + S4) == NUP, "conversion shares");
            cbeg = bx < 128 ? bx * S5 : 128 * S5 + (bx - 128) * S4; cend = cbeg + (bx < 128 ? S5 : S4); }
        else { const int per = (CONV1 + G - 1) / G; cbeg = bx * per; cend = cbeg + per < CONV1 ? cbeg + per : CONV1; if (cbeg > CONV1) cbeg = CONV1; }
        const bool conv_first = ((bx >> 3) & 1) != 0;
        const bool roles = (G == 256);
        const int ridx = (bx >> 4) * 8 + (bx & 7);
        if (roles && conv_first) moe_convert(a, lds, ridx * (NUP / 128), (ridx + 1) * (NUP / 128), wave, lane);
        if (!roles && conv_first) { moe_convert(a, lds, cbeg, cend, wave, lane); __syncthreads(); }
        if (!(roles && conv_first)) {
        pg8::Gemm g{D, D, D};
        Sched1 S{roles ? 128 : G, roles ? ridx : bx, (const char*)(ws + WS_XN), (const char*)(ws + WS_W1T), (const char*)(ws + WS_W2T)};
        Epi1 E{PB, VT, (bf16*)(ws + WS_QB), (bf16*)(ws + WS_KB), stats, a.in[3], a.in[4], (LAS float*)(lds + SCR_OFF)};
        pg8::gemm_phase<Epi1, Sched1>(lds, g, S, E);
        { pg8::Gemm g8{D / 2, D / 2, D / 2};
          Sched1g S8{roles ? 128 : G, roles ? ridx : bx, (const char*)(ws + WS_XN8), (const char*)(ws + WS_WG8)};
          Epi1g E8{PB};
          pg8::gemm_phase<Epi1g, Sched1g, true>(lds, g8, S8, E8); }
        }
        if (!roles && !conv_first) moe_convert(a, lds, cbeg, cend, wave, lane);
    }
    xcd_barrier(bar);

    if (PH_ON(2)) for (int task = gw; task < 4096; task += NGW) {
        if (task < 2048) attn_task((const bf16*)(ws + WS_QB), (const bf16*)(ws + WS_KB), VT, OA, task, lane);
        else sgu_task(a, PB, VT, stats, OB, task - 2048, lane);
    }
    xcd_barrier(bar);

    if (PH_ON(3)) {
        pg8::Gemm g{AW, AW, AW};
        Sched3 S{G, bx, (const char*)(ws + WS_OA), (const char*)(ws + WS_OB), (const char*)(ws + WS_WAT), (const char*)(ws + WS_WBT)};
        Epi3 E{PB, (bf16*)(ws + WS_Y)};
        pg8::gemm_phase<Epi3, Sched3>(lds, g, S, E);
    }
    xcd_barrier(bar);

    if (PH_ON(4)) {
        pg8::Gemm g{D, D, D};
        Sched4 S{G, bx, (const char*)(ws + WS_Y), (const char*)(ws + WS_WOT)};
        Epi4 E{a.in[0], (bf16*)(ws + WS_H1)};
        pg8::gemm_phase<Epi4, Sched4>(lds, g, S, E);
    }
#if DBG_STAGE >= 5
    xcd_barrier(bar);

    if (PH_ON(5)) {
        LAS float* red = (LAS float*)lds;
        LAS float* ssqp = (LAS float*)(lds + 8 * 1056 * 4);
        LAS float* rinfo = ssqp + 256;
        LAS unsigned* lcnt = (LAS unsigned*)(rinfo + 384); LAS unsigned* lbase = lcnt + 32;
        const float* g2 = a.in[11]; const float* wrt = a.in[12]; const float* brt = a.in[13];
        for (int rb = bx; rb < T / 32; rb += G) {
            const int row0 = rb * 32, i = lane & 31, hk = lane >> 5, kb = wave * 256 + hk * 128;
            if (tid < 32) lcnt[tid] = 0u;
            const bf16* xr = (const bf16*)(ws + WS_H1) + (size_t)(row0 + i) * D + kb;
            f32x16 acc;
#pragma unroll
            for (int r = 0; r < 16; ++r) acc[r] = 0.f;
            float ssq = 0.f;
            for (int ch = 0; ch < 4; ++ch) {
                f32x4 xv[8];
#pragma unroll
                for (int q = 0; q < 4; ++q) { const u32x4 h = *(const u32x4*)(xr + ch * 32 + q * 8);
                    xv[2 * q] = (f32x4){bf_lo(h.x), bf_hi(h.x), bf_lo(h.y), bf_hi(h.y)}; xv[2 * q + 1] = (f32x4){bf_lo(h.z), bf_hi(h.z), bf_lo(h.w), bf_hi(h.w)}; }
#pragma unroll
                for (int q = 0; q < 8; ++q)
#pragma unroll
                    for (int jj = 0; jj < 4; ++jj) { const int k = kb + ch * 32 + q * 4 + jj; const float x = xv[q][jj];
                        const float bw = wrt[(size_t)k * NE + i] * g2[k];
                        acc = __builtin_amdgcn_mfma_f32_32x32x2f32(x, bw, acc, 0, 0, 0); ssq += x * x; }
            }
            ssq += __shfl_xor(ssq, 32);
            if (lane < 32) ssqp[wave * 32 + i] = ssq;
#pragma unroll
            for (int r = 0; r < 16; ++r) red[wave * 1056 + i * 33 + (r & 3) + 8 * (r >> 2) + 4 * hk] = acc[r];
            LDS_WAIT(); __syncthreads();
            if (tid < 32) {
                float sq = 0.f;
#pragma unroll
                for (int w = 0; w < 8; ++w) sq += ssqp[w * 32 + tid];
                const float rstd = rsqrtf(sq * (1.f / D) + EPS);
                float v0 = -3.0e38f, v1 = -3.0e38f, v2 = -3.0e38f, v3 = -3.0e38f; int i0 = 0, i1 = 0, i2 = 0, i3 = 0;
                for (int e = 0; e < NE; ++e) { float v = 0.f;
#pragma unroll
                    for (int w = 0; w < 8; ++w) v += red[w * 1056 + e * 33 + tid];
                    const float x = v * rstd + brt[e];
                    if (x > v3) { if (x > v2) { v3 = v2; i3 = i2; if (x > v1) { v2 = v1; i2 = i1; if (x > v0) { v1 = v0; i1 = i0; v0 = x; i0 = e; } else { v1 = x; i1 = e; } } else { v2 = x; i2 = e; } } else { v3 = x; i3 = e; } } }
                const float p1 = __expf(v1 - v0), p2 = __expf(v2 - v0), p3 = __expf(v3 - v0), inv = 1.f / (1.f + p1 + p2 + p3);
                const int t = row0 + tid;
                const unsigned l0 = __hip_atomic_fetch_add(lcnt + i0, 1u, __ATOMIC_RELAXED, __HIP_MEMORY_SCOPE_WORKGROUP), l1 = __hip_atomic_fetch_add(lcnt + i1, 1u, __ATOMIC_RELAXED, __HIP_MEMORY_SCOPE_WORKGROUP);
                const unsigned l2 = __hip_atomic_fetch_add(lcnt + i2, 1u, __ATOMIC_RELAXED, __HIP_MEMORY_SCOPE_WORKGROUP), l3 = __hip_atomic_fetch_add(lcnt + i3, 1u, __ATOMIC_RELAXED, __HIP_MEMORY_SCOPE_WORKGROUP);
                LDS_WAIT(); asm volatile("" ::: "memory");
                { const unsigned ne_ = lcnt[tid]; unsigned base_ = 0u; if (ne_) base_ = atomicAdd(ctl + CW_CNT + 64 * tid, ne_); lbase[tid] = base_; }
                LDS_WAIT(); asm volatile("" ::: "memory");
                const int r0 = (int)(lbase[i0] + l0), r1 = (int)(lbase[i1] + l1), r2 = (int)(lbase[i2] + l2), r3 = (int)(lbase[i3] + l3);
                tok_e[t * 4 + 0] = i0; tok_e[t * 4 + 1] = i1; tok_e[t * 4 + 2] = i2; tok_e[t * 4 + 3] = i3;
                tok_rank[t * 4 + 0] = r0; tok_rank[t * 4 + 1] = r1; tok_rank[t * 4 + 2] = r2; tok_rank[t * 4 + 3] = r3;
                tok_gate[t * 4 + 0] = inv; tok_gate[t * 4 + 1] = p1 * inv; tok_gate[t * 4 + 2] = p2 * inv; tok_gate[t * 4 + 3] = p3 * inv;
                LAS float* ri = rinfo + tid * 12; ri[0] = rstd;
                ri[1] = __int_as_float(i0); ri[2] = __int_as_float(i1); ri[3] = __int_as_float(i2); ri[4] = __int_as_float(i3);
                ri[5] = __int_as_float(r0); ri[6] = __int_as_float(r1); ri[7] = __int_as_float(r2); ri[8] = __int_as_float(r3);
            }
            LDS_WAIT(); __syncthreads();
            unsigned char* XG = ws + WS_XG;
            for (int rr = 0; rr < 4; ++rr) { const int il = wave * 4 + rr; const LAS float* ri = rinfo + il * 12;
                const float rstd = ri[0];
                size_t dsto[4];
#pragma unroll
                for (int k = 0; k < 4; ++k) dsto[k] = ((size_t)__float_as_int(ri[1 + k]) * T + (size_t)__float_as_int(ri[5 + k])) * D;
                const u32x2* hr = (const u32x2*)((const bf16*)(ws + WS_H1) + (size_t)(row0 + il) * D) + lane;
#pragma unroll
                for (int j = 0; j < 8; ++j) { const u32x2 hb = hr[64 * j]; const f32x4 v = (f32x4){bf_lo(hb.x), bf_hi(hb.x), bf_lo(hb.y), bf_hi(hb.y)}; const f32x4 gg = *((const f32x4*)g2 + lane + 64 * j);
                    const float rs8 = rstd * SC_X8; const unsigned o = pk4_fp8(v.x * rs8 * gg.x, v.y * rs8 * gg.y, v.z * rs8 * gg.z, v.w * rs8 * gg.w);
#pragma unroll
                    for (int k = 0; k < 4; ++k) *((unsigned*)(XG + dsto[k]) + lane + 64 * j) = o; } }
            LDS_WAIT(); __syncthreads();
        }
    }
    xcd_barrier(bar);

    if (tid < NE) MISC[MW_CNT + tid] = __hip_atomic_load(ctl + CW_CNT + 64 * tid, __ATOMIC_RELAXED, __HIP_MEMORY_SCOPE_AGENT);
    LDS_WAIT(); __syncthreads();
    if (tid < 64) {
        const unsigned n = tid < NE ? MISC[MW_CNT + tid] : 0u, mt = (n + 255u) >> 8;
        unsigned so = n, su = mt;
#pragma unroll
        for (int o = 1; o < 32; o <<= 1) { const unsigned a_ = __shfl_up(so, o), b_ = __shfl_up(su, o); if ((tid & 63) >= o) { so += a_; su += b_; } }
        if (tid < NE) { MISC[MW_OFF + tid] = so - n; MISC[MW_US6 + tid] = (su - mt) * 16u; MISC[MW_US7 + tid] = (su - mt) * 8u; }
        if (tid == NE - 1) { MISC[MW_US6 + NE] = su * 16u; MISC[MW_US7 + NE] = su * 8u; }
    }
    LDS_WAIT(); __syncthreads();

    if (PH_ON(6)) {
        pg8::Gemm g{D / 2, D / 2, D / 2};
        constexpr int NSTREAM = 8;
        const bool split = (G == 256);
        SchedMoE<6> S{G, vcu, MISC, (const char*)(ws + WS_XG), (const char*)(ws + WS_WUT), split ? 32 - NSTREAM : 32};
        Epi6 E{a.in[15], ws + WS_ACT};
        if (split && (vcu & 31) >= 32 - NSTREAM) { constexpr int NUP6 = NE * I_UP1, NDN6 = NE * I_DN1, PER = NDN6 / (8 * NSTREAM); static_assert(PER * 8 * NSTREAM == NDN6, "w_down shares");
            const int sidx = (vcu >> 5) * NSTREAM + ((vcu & 31) - (32 - NSTREAM)); moe_convert(a, lds, NUP6 + sidx * PER, NUP6 + (sidx + 1) * PER, wave, lane); __syncthreads(); }
        pg8::gemm_phase<Epi6, SchedMoE<6>, true>(lds, g, S, E);
    }
    xcd_barrier(bar);

    if (PH_ON(7)) {
        pg8::Gemm g{DE / 2, DE / 2, DE / 2};
        SchedMoE<7> S{G, vcu, MISC, (const char*)(ws + WS_ACT), (const char*)(ws + WS_WDT), 32};
        Epi7 E{a.in[17], (bf16*)(ws + WS_YM)};
        pg8::gemm_phase<Epi7, SchedMoE<7>, true>(lds, g, S, E);
    }
    xcd_barrier(bar);

    if (PH_ON(8)) {
        const bf16* YM = (const bf16*)(ws + WS_YM);
        for (int t = gw; t < T; t += NGW) {
            size_t pos[4]; float gt[4];
#pragma unroll
            for (int k = 0; k < 4; ++k) { const int e = tok_e[t * 4 + k], rk = tok_rank[t * 4 + k]; gt[k] = tok_gate[t * 4 + k]; pos[k] = ((size_t)MISC[MW_OFF + e] + (size_t)rk) * D; }
            f32x4* orow = (f32x4*)(a.out + (size_t)t * D) + lane;
            const u32x2* hrow = (const u32x2*)((const bf16*)(ws + WS_H1) + (size_t)t * D) + lane;
#pragma unroll
            for (int j = 0; j < 8; ++j) { const u32x2 hb = __builtin_nontemporal_load(hrow + 64 * j); f32x4 o = (f32x4){bf_lo(hb.x), bf_hi(hb.x), bf_lo(hb.y), bf_hi(hb.y)};
#pragma unroll
                for (int k = 0; k < 4; ++k) { const u32x2 y = __builtin_nontemporal_load((const u32x2*)(YM + pos[k]) + lane + 64 * j);
                    o.x += gt[k] * bf_lo(y.x); o.y += gt[k] * bf_hi(y.x); o.z += gt[k] * bf_lo(y.y); o.w += gt[k] * bf_hi(y.y); }
                __builtin_nontemporal_store(o, orow + 64 * j); }
        }
    }
#endif
}

extern "C" void kernel_launch(void* const* d_in, const int* in_sizes, int n_in, void* d_out, int out_size, void* d_ws, size_t ws_size, hipStream_t stream) {
    static int grid = 0;
    if (grid == 0) {
        if (n_in != 18 || out_size != T * D || ws_size < WS_END) { fprintf(stderr, "kernel_launch: unexpected shapes (n_in %d, out %d, ws %zu)\n", n_in, out_size, ws_size); grid = -1; return; }
        int dev = 0, cus = 0, per_cu = 0;
        if (hipGetDevice(&dev) != hipSuccess || hipDeviceGetAttribute(&cus, hipDeviceAttributeMultiprocessorCount, dev) != hipSuccess) { grid = -1; return; }
        if (hipFuncSetAttribute((const void*)fwd, hipFuncAttributeMaxDynamicSharedMemorySize, LDS_BYTES) != hipSuccess) { fprintf(stderr, "kernel_launch: hipFuncSetAttribute failed\n"); grid = -1; return; }
        if (hipOccupancyMaxActiveBlocksPerMultiprocessor(&per_cu, (const void*)fwd, NWAVES * 64, LDS_BYTES) != hipSuccess || per_cu < 1) { fprintf(stderr, "kernel_launch: occupancy query says %d\n", per_cu); }
        (void)hipGetLastError();
        grid = cus;
        if (per_cu < 1) grid = -1;
    }
    if (grid < 0) return;
    if (hipMemsetAsync((char*)d_ws + WS_CTL, 0, CTL_ZERO_BYTES, stream) != hipSuccess) return;
    Args a{};
    for (int i = 0; i < 18; ++i) a.in[i] = (const float*)d_in[i];
    a.out = (float*)d_out; a.ws = (unsigned char*)d_ws;
    hipLaunchKernelGGL(fwd, dim3(grid), dim3(NWAVES * 64), LDS_BYTES, stream, a);
}
```

```cpp
#ifndef MOE_TAIL_TEST
#define MOE_TAIL_TEST 0
#endif
#include <hip/hip_runtime.h>
#include <cstdio>
#include <cstdint>

#ifndef DBG_STAGE
#define DBG_STAGE 99
#endif
#ifndef PH_MASK
#define PH_MASK 0x1ff
#endif
#define PH_ON(p) ((PH_MASK >> (p)) & 1)

#define LAS __attribute__((address_space(3)))
#define GAS __attribute__((address_space(1)))
typedef unsigned short bf16;
typedef short bf16x8 __attribute__((ext_vector_type(8)));
typedef float f32x4 __attribute__((ext_vector_type(4)));
typedef float f32x2 __attribute__((ext_vector_type(2)));
typedef float f32x16 __attribute__((ext_vector_type(16)));
typedef unsigned u32x4 __attribute__((ext_vector_type(4)));
typedef unsigned u32x2 __attribute__((ext_vector_type(2)));
typedef int i32x8 __attribute__((ext_vector_type(8)));
typedef int i32x4 __attribute__((ext_vector_type(4)));

constexpr int T = 8192, D = 2048, SEQ = 4096, NH = 8, HD = 128, AW = 1024, SW = 1024, PW = 9216, NE = 32, TOPK = 4, DE = 2048;
constexpr int C_GB_END_BF = 5120;
constexpr int N1 = 7168;
constexpr int C_Q = 0, C_K = 1024, C_U = 2048, C_GA = 3072, C_GB = 5120;
constexpr float EPS = 1e-6f;
constexpr int NWAVES = 8;

constexpr size_t MiB = 1u << 20;
constexpr size_t WS_CTL = 0, CTL_ZERO_BYTES = 64 * 1024;
constexpr size_t WS_W1T = 2 * MiB;
constexpr size_t WS_W2T = 32 * MiB;
constexpr size_t WS_WAT = 40 * MiB;
constexpr size_t WS_WBT = 44 * MiB;
constexpr size_t WS_WOT = 48 * MiB;
constexpr size_t WS_WG8 = 56 * MiB;
constexpr size_t WS_XN = 64 * MiB;
constexpr size_t WS_PB = 96 * MiB;
constexpr size_t WS_VT = 208 * MiB;
constexpr size_t WS_OA = 240 * MiB;
constexpr size_t WS_OB = 256 * MiB;
constexpr size_t WS_QB = 272 * MiB;
constexpr size_t WS_KB = 288 * MiB;
constexpr size_t WS_XN8 = 304 * MiB;
constexpr size_t WS_Y = 336 * MiB;
constexpr size_t WS_ROUTE = 368 * MiB;
constexpr size_t WS_STATS = 369 * MiB;
constexpr size_t WS_ACT = 370 * MiB;
constexpr size_t WS_H1 = 440 * MiB;
constexpr size_t WS_YM = 500 * MiB;
constexpr size_t WS_WUT = 640 * MiB;
constexpr size_t WS_WDT = 1152 * MiB;
constexpr size_t WS_XG = 1408 * MiB;
constexpr size_t WS_END = 2432 * MiB;
constexpr int CW_BAR = 4096;
constexpr int CW_CNT = 8192;
constexpr int CW_STATS = 16384;

constexpr int RING_BYTES = 131072;
constexpr int SCR_OFF = RING_BYTES;
constexpr int MISC_OFF = RING_BYTES + 8192;
constexpr int LDS_BYTES = RING_BYTES + 8192 + 2048;
constexpr int MW_BAR = 8;
constexpr int MW_CNT = 32, MW_OFF = 64, MW_US6 = 96, MW_US7 = 160;

#define LDS_WAIT() asm volatile("s_waitcnt lgkmcnt(0)" ::: "memory")
#define VM_WAIT() asm volatile("s_waitcnt vmcnt(0)" ::: "memory")

__device__ __forceinline__ unsigned cvt_pk_bf16(float lo, float hi) { unsigned r; asm volatile("v_cvt_pk_bf16_f32 %0, %1, %2" : "=v"(r) : "v"(lo), "v"(hi)); return r; }
__device__ __forceinline__ unsigned pk4_fp8(float a, float b, float c, float d) {
    a = __builtin_amdgcn_fmed3f(a, -448.f, 448.f); b = __builtin_amdgcn_fmed3f(b, -448.f, 448.f); c = __builtin_amdgcn_fmed3f(c, -448.f, 448.f); d = __builtin_amdgcn_fmed3f(d, -448.f, 448.f);
    int r = 0; r = __builtin_amdgcn_cvt_pk_fp8_f32(a, b, r, false); r = __builtin_amdgcn_cvt_pk_fp8_f32(c, d, r, true); return (unsigned)r; }
constexpr float SC_W8 = 64.f, SC_X8 = 4.f, SC_A8 = 2.f, SC_XN8 = 16.f, SC_Y8 = 16.f;
__device__ __forceinline__ float bf_lo(unsigned u) { return __uint_as_float(u << 16); }
__device__ __forceinline__ float bf_hi(unsigned u) { return __uint_as_float(u & 0xffff0000u); }
__device__ __forceinline__ float fast_rcp(float x) { return __builtin_amdgcn_rcpf(x); }
__device__ __forceinline__ float sigmoid_f(float x) { return fast_rcp(1.f + __builtin_amdgcn_exp2f(-1.4426950408889634f * x)); }
__device__ __forceinline__ float gelu_tanh_f(float x) { const float in = -2.302208198f * (x + 0.044715f * x * x * x); return x * fast_rcp(1.f + __builtin_amdgcn_exp2f(in)); }
__device__ __forceinline__ float wave_sum(float v) {
#pragma unroll
    for (int o = 1; o < 64; o <<= 1) v += __shfl_xor(v, o);
    return v;
}

namespace pg8 {
constexpr int BM = 256, BK = 64, HALF = 128, HTB = HALF * BK * 2, STAGE_BYTES = 8 * HTB;
__host__ __device__ __forceinline__ int lds_byte(int r, int c) { const int st = (r >> 4) * 2 + (c >> 5), rr = r & 15, cc = c & 31, ob = rr * 64 + cc * 2; return st * 1024 + (ob ^ (((ob >> 9) & 1) << 5)); }
__host__ __device__ __forceinline__ void stage_rc(int b, int& R, int& C) { const int st = b / 1024, sb = b % 1024, swz = sb ^ (((sb >> 9) & 1) << 5); R = (st >> 1) * 16 + swz / 64; C = (st & 1) * 32 + (swz % 64) / 2; }
__host__ __device__ __forceinline__ int perm32(int rho) { const int n = rho >> 4, i = rho & 15; return 8 * (i >> 2) + 4 * n + (i & 3); }

struct Unit { const char* A; const char* B; int kind, pm, pn, e, nvalid, rbase; };
struct Gemm { int lda, ldb, K; };

__device__ __forceinline__ void tile_order(int L, int nM, int nN, int& pm, int& pn) {
    const int nwg = nM * nN; int wgid = L;
    { const int q = nwg / 8, r = nwg % 8, xcd = wgid % 8, off = wgid / 8; wgid = (xcd < r ? xcd * (q + 1) : r * (q + 1) + (xcd - r) * q) + off; }
    const int nig = 8 * nN, gid = wgid / nig, fm = gid * 8, gsz = (nM - fm) < 8 ? (nM - fm) : 8;
    pm = fm + ((wgid % nig) % gsz); pn = (wgid % nig) / gsz;
}

template <class Epi, class Sched, bool F8 = false>
__device__ __forceinline__ void gemm_phase(LAS unsigned char* lds, const Gemm g, const Sched& S, const Epi& E) {
    int tid_ = threadIdx.x; asm volatile("" : "+v"(tid_));
    const int tid = tid_, wid = __builtin_amdgcn_readfirstlane(tid >> 6), lane = tid & 63, wr = wid >> 2, wc = wid & 3, fr = lane & 15, fq = lane >> 4;
    const int K = g.K, nt = K / BK;
    unsigned voffA[2], voffB[2];
#pragma unroll
    for (int i = 0; i < 2; ++i) { int R, C; stage_rc(tid * 16 + i * 8192, R, C); const int Rb = Epi::PERM ? ((R & ~31) + perm32(R & 31)) : R;
        voffA[i] = (unsigned)(R * g.lda + C) * 2u; voffB[i] = (unsigned)(Rb * g.ldb + C) * 2u; }
    const size_t kstep = (size_t)(BK * 2);
    const size_t hstepA = (size_t)HALF * g.lda * 2, hstepB = (size_t)HALF * g.ldb * 2;
    const unsigned ldsw = (unsigned)wid * 1024u;
    const int aoff = lds_byte(wr * 64 + fr, fq * 8), boff = lds_byte(wc * 32 + fr, fq * 8);
#define PG8_SA(b, h) (((b) * 2 + (h)) * HTB)
#define PG8_SB(b, h) ((4 + (b) * 2 + (h)) * HTB)
#define PG8_STAGE(bufoff, gbase, voff) do { _Pragma("unroll") for (int _i = 0; _i < 2; ++_i) \
        __builtin_amdgcn_global_load_lds((const unsigned*)((const char*)(gbase) + (voff)[_i]), (LAS unsigned*)(lds + (bufoff) + ldsw + _i * 8192), 16, 0, 0); } while (0)
#define PG8_LDA(dst, b, h) do { _Pragma("unroll") for (int m = 0; m < 4; ++m) { const i32x4 lo_ = *(const LAS i32x4*)(lds + PG8_SA(b, h) + aoff + m * 2048), hi_ = *(const LAS i32x4*)(lds + PG8_SA(b, h) + aoff + m * 2048 + 1024); \
        dst[m] = __builtin_shufflevector(lo_, hi_, 0, 1, 2, 3, 4, 5, 6, 7); } } while (0)
#define PG8_LDB(dst, b, h) do { _Pragma("unroll") for (int n = 0; n < 2; ++n) { const i32x4 lo_ = *(const LAS i32x4*)(lds + PG8_SB(b, h) + boff + n * 2048), hi_ = *(const LAS i32x4*)(lds + PG8_SB(b, h) + boff + n * 2048 + 1024); \
        dst[n] = __builtin_shufflevector(lo_, hi_, 0, 1, 2, 3, 4, 5, 6, 7); } } while (0)
#define PG8_MMA(ai, bj, At, Bt) do { __builtin_amdgcn_s_setprio(1); _Pragma("unroll") for (int m = 0; m < 4; ++m) _Pragma("unroll") for (int n = 0; n < 2; ++n) { \
        if constexpr (F8) { asm volatile("v_mfma_f32_16x16x128_f8f6f4 %0, %1, %2, %0" : "+v"(acc[ai][bj][m][n]) : "v"(Bt[n]), "v"(At[m])); } \
        else { acc[ai][bj][m][n] = __builtin_amdgcn_mfma_f32_16x16x32_bf16(__builtin_bit_cast(bf16x8, __builtin_shufflevector(Bt[n], Bt[n], 0, 1, 2, 3)), __builtin_bit_cast(bf16x8, __builtin_shufflevector(At[m], At[m], 0, 1, 2, 3)), acc[ai][bj][m][n], 0, 0, 0); \
               acc[ai][bj][m][n] = __builtin_amdgcn_mfma_f32_16x16x32_bf16(__builtin_bit_cast(bf16x8, __builtin_shufflevector(Bt[n], Bt[n], 4, 5, 6, 7)), __builtin_bit_cast(bf16x8, __builtin_shufflevector(At[m], At[m], 4, 5, 6, 7)), acc[ai][bj][m][n], 0, 0, 0); } } \
        __builtin_amdgcn_s_setprio(0); } while (0)
#define PG8_WAIT_V(n) asm volatile("s_waitcnt vmcnt(" #n ")" ::: "memory")
#define PG8_WAIT_L(n) asm volatile("s_waitcnt lgkmcnt(" #n ")" ::: "memory")
#define PG8_BAR __builtin_amdgcn_s_barrier()
#define PG8_SCHED __builtin_amdgcn_sched_barrier(0)
    Unit cur, nxt; int ui = 0;
    if (!S.next(0, cur)) return;
    f32x4 acc[2][2][4][2];
#pragma unroll
    for (int a = 0; a < 2; ++a)
#pragma unroll
        for (int b = 0; b < 2; ++b)
#pragma unroll
            for (int m = 0; m < 4; ++m)
#pragma unroll
                for (int n = 0; n < 2; ++n) acc[a][b][m][n] = (f32x4){0.f, 0.f, 0.f, 0.f};
    i32x8 At[4], B0[2], B1[2];
    const char* cA = cur.A; const char* cB = cur.B;
    PG8_STAGE(PG8_SB(0, 0), cB, voffB); PG8_STAGE(PG8_SB(0, 1), cB + hstepB, voffB); PG8_STAGE(PG8_SA(0, 0), cA, voffA); PG8_STAGE(PG8_SA(0, 1), cA + hstepA, voffA);
    if (wr == 1) PG8_BAR;
    PG8_WAIT_V(2); PG8_BAR;
    PG8_STAGE(PG8_SB(1, 0), cB + kstep, voffB); PG8_STAGE(PG8_SA(1, 0), cA + kstep, voffA); PG8_STAGE(PG8_SB(1, 1), cB + hstepB + kstep, voffB);
    PG8_WAIT_V(6); PG8_BAR;
    for (;;) {
        const bool has_next = S.next(ui + 1, nxt);
        const char* nA = has_next ? nxt.A : cA; const char* nB = has_next ? nxt.B : cB;
        const bool full = cur.nvalid > HALF;
        for (int t = 0; t < nt; t += 2) {
            const bool last = (t == nt - 2);
            const char* a1 = cA + (size_t)(t + 1) * kstep;
            const char* a2 = last ? nA : cA + (size_t)(t + 2) * kstep; const char* b2 = last ? nB : cB + (size_t)(t + 2) * kstep;
            const char* a3 = a2 + kstep; const char* b3 = b2 + kstep;
            PG8_LDB(B0, 0, 0); PG8_LDB(B1, 0, 1); PG8_SCHED; PG8_LDA(At, 0, 0); PG8_STAGE(PG8_SA(1, 1), a1 + hstepA, voffA);
            PG8_WAIT_V(8); PG8_WAIT_L(0); PG8_BAR; PG8_MMA(0, 0, At, B0); PG8_MMA(0, 1, At, B1); PG8_BAR; PG8_SCHED;
            if (!F8 || full) PG8_LDA(At, 0, 1); PG8_STAGE(PG8_SB(0, 0), b2, voffB); PG8_STAGE(PG8_SB(0, 1), b2 + hstepB, voffB); PG8_STAGE(PG8_SA(0, 0), a2, voffA);
            PG8_WAIT_V(8); PG8_WAIT_L(0); PG8_BAR; if (!F8 || full) { PG8_MMA(1, 0, At, B0); PG8_MMA(1, 1, At, B1); } PG8_BAR; PG8_SCHED;
            PG8_LDB(B0, 1, 0); PG8_LDB(B1, 1, 1); PG8_SCHED; PG8_LDA(At, 1, 0); PG8_STAGE(PG8_SA(0, 1), a2 + hstepA, voffA);
            PG8_WAIT_V(8); PG8_WAIT_L(0); PG8_BAR; PG8_MMA(0, 0, At, B0); PG8_MMA(0, 1, At, B1); PG8_BAR; PG8_SCHED;
            if (!F8 || full) PG8_LDA(At, 1, 1); PG8_STAGE(PG8_SB(1, 0), b3, voffB); PG8_STAGE(PG8_SB(1, 1), b3 + hstepB, voffB); PG8_STAGE(PG8_SA(1, 0), a3, voffA);
            PG8_WAIT_V(8); PG8_WAIT_L(0); PG8_BAR; if (!F8 || full) { PG8_MMA(1, 0, At, B0); PG8_MMA(1, 1, At, B1); } PG8_BAR; PG8_SCHED;
        }
        if constexpr (F8) asm volatile("s_nop 15\n\ts_nop 15\n\ts_nop 7" ::: "memory");
        if (wr == 0) PG8_BAR;
        E(acc, cur, wr, wc, fr, fq);
        if (!has_next) break;
        if (!(Epi::CHAIN && cur.kind == 0)) {
#pragma unroll
        for (int a = 0; a < 2; ++a)
#pragma unroll
            for (int b = 0; b < 2; ++b)
#pragma unroll
                for (int m = 0; m < 4; ++m)
#pragma unroll
                    for (int n = 0; n < 2; ++n) acc[a][b][m][n] = (f32x4){0.f, 0.f, 0.f, 0.f};
        }
        cur = nxt; cA = nA; cB = nB; ++ui;
        if (wr == 1) PG8_BAR;
    }
    PG8_WAIT_V(0);
    PG8_BAR;
#undef PG8_SA
#undef PG8_SB
#undef PG8_STAGE
#undef PG8_LDA
#undef PG8_LDB
#undef PG8_MMA
#undef PG8_WAIT_V
#undef PG8_WAIT_L
#undef PG8_BAR
#undef PG8_SCHED
}
}
using pg8::Unit;

#define XB_TMO      128
#define XB_XCNT(j)  (256  + 64 * (j))
#define XB_XSUB(j)  (1280 + 64 * (j))
#define XB_XGEN(j)  (2304 + 64 * (j))
#define XB_TOP      3328
#define XB_TOPGEN   3392
#define XCD_BAR_WORDS 3456
#define XB_SPIN_CAP (1u << 18)
__device__ __forceinline__ unsigned xb_ld(unsigned* p)              { return __hip_atomic_load(p, __ATOMIC_RELAXED, __HIP_MEMORY_SCOPE_AGENT); }
__device__ __forceinline__ unsigned xb_add(unsigned* p, unsigned v) { return __hip_atomic_fetch_add(p, v, __ATOMIC_RELAXED, __HIP_MEMORY_SCOPE_AGENT); }
__device__ __forceinline__ unsigned xb_xcc_id() { return (unsigned)__builtin_amdgcn_s_getreg((3 << 11) | 20) & 0xFu; }
#define XB_SPIN(cond, bar) do { unsigned _sp = 0; while (cond) { __builtin_amdgcn_s_sleep(1); \
    if ((++_sp & 255u) == 0u) { if (xb_ld(&(bar)[XB_TMO])) break; if (_sp > XB_SPIN_CAP) { atomicAdd(&(bar)[XB_TMO], 1u); break; } } } } while (0)
struct XcdBarrier { unsigned* bar; unsigned x; volatile LAS unsigned* st; };
__device__ __forceinline__ XcdBarrier xcd_barrier_post(unsigned* bar, volatile LAS unsigned* st) {
    XcdBarrier b; b.bar = bar; b.x = xb_xcc_id(); b.st = st;
    if (threadIdx.x == 0) (void)xb_add(&bar[XB_XCNT(b.x)], 1u);
    return b;
}
__device__ __forceinline__ void xcd_barrier_complete(unsigned* bar, unsigned x, unsigned& nloc, unsigned& nx) {
    const unsigned G = gridDim.x * gridDim.y * gridDim.z;
    unsigned sum, cnt, mine, sp = 0u;
    for (;;) {
        sum = 0u; cnt = 0u; mine = 0u;
#pragma unroll
        for (unsigned j = 0; j < 16; ++j) { const unsigned c = xb_ld(&bar[XB_XCNT(j)]); sum += c; cnt += (c > 0u) ? 1u : 0u; mine = (j == x) ? c : mine; }
        if (sum == G) break;
        __builtin_amdgcn_s_sleep(1);
        if ((++sp & 255u) == 0u) { if (xb_ld(&bar[XB_TMO])) break; if (sp > XB_SPIN_CAP) { atomicAdd(&bar[XB_TMO], 1u); break; } }
    }
    nloc = mine > 0u ? mine : 1u; nx = cnt > 0u ? cnt : 1u;
}
__device__ __forceinline__ void xcd_barrier(const XcdBarrier& b) {
    asm volatile("s_waitcnt vmcnt(0)" ::: "memory");
    __syncthreads();
    if (threadIdx.x == 0) {
        unsigned* bar = b.bar;
        __builtin_amdgcn_s_waitcnt(0);
        unsigned nloc = b.st[0], nx = b.st[1];
        if (nloc == 0u) { xcd_barrier_complete(bar, b.x, nloc, nx); b.st[0] = nloc; b.st[1] = nx; }
        const unsigned old = xb_add(&bar[XB_XSUB(b.x)], 1u);
        const unsigned gen = old / nloc;
        if (old + 1u == (gen + 1u) * nloc) {
            __builtin_amdgcn_fence(__ATOMIC_RELEASE, "agent");
            asm volatile("s_waitcnt vmcnt(0)" ::: "memory");
            const unsigned og = xb_add(&bar[XB_TOP], 1u);
            const unsigned tg = og / nx;
            if (og + 1u == (tg + 1u) * nx) xb_add(&bar[XB_TOPGEN], 1u);
            else XB_SPIN(xb_ld(&bar[XB_TOPGEN]) == tg, bar);
            __builtin_amdgcn_fence(__ATOMIC_ACQUIRE, "agent");
            xb_add(&bar[XB_XGEN(b.x)], 1u);
            asm volatile("s_waitcnt vmcnt(0)" ::: "memory");
        } else {
            XB_SPIN(xb_ld(&bar[XB_XGEN(b.x)]) == gen, bar);
            __builtin_amdgcn_fence(__ATOMIC_ACQUIRE, "agent");
            asm volatile("s_waitcnt vmcnt(0)" ::: "memory");
        }
    }
    __syncthreads();
}

struct Args { const float* in[18]; float* out; unsigned char* ws; };

constexpr int I_UP1 = (D / 128) * (2 * DE / 32);
constexpr int I_DN1 = (DE / 128) * (D / 32);
constexpr int MOE_ITEMS = NE * (I_UP1 + I_DN1);
struct MoeItem { const float* src; unsigned char* dst; int ldw; };
__device__ __forceinline__ MoeItem moe_item(const Args& a, int r) {
    MoeItem m; unsigned char* ws = a.ws;
    if (r < NE * I_UP1) { const int e = r / I_UP1, q = r % I_UP1; const int nblk = 2 * DE / 32, kb = q / nblk, nb = q % nblk, k0 = kb * 128, n0 = nb * 32;
        const int nn = n0 < DE ? n0 : n0 - DE; const int row = (nn >> 7) * 256 + (nn & 127) + (n0 < DE ? 0 : 128);
        m.src = a.in[14] + ((size_t)e * D + k0) * (2 * DE) + n0; m.ldw = 2 * DE; m.dst = ws + WS_WUT + ((size_t)e * 2 * DE + row) * D + k0; }
    else { r -= NE * I_UP1; const int e = r / I_DN1, q = r % I_DN1; const int nblk = D / 32, kb = q / nblk, nb = q % nblk, k0 = kb * 128, n0 = nb * 32;
        m.src = a.in[16] + ((size_t)e * DE + k0) * D + n0; m.ldw = D; m.dst = ws + WS_WDT + ((size_t)e * D + n0) * DE + k0; }
    return m;
}
__device__ __forceinline__ void moe_load(f32x4 (&v)[16], const MoeItem& m, int lane) {
#pragma unroll
    for (int j = 0; j < 16; ++j) v[j] = __builtin_nontemporal_load((const f32x4*)(m.src + (size_t)(16 * (lane >> 3) + j) * m.ldw + 4 * (lane & 7)));
}
__device__ __forceinline__ void moe_store(const f32x4 (&v)[16], unsigned char* dst, int lane) {
#pragma unroll
    for (int i = 0; i < 4; ++i) { u32x4 o;
        o.x = pk4_fp8(v[0][i] * SC_W8, v[1][i] * SC_W8, v[2][i] * SC_W8, v[3][i] * SC_W8); o.y = pk4_fp8(v[4][i] * SC_W8, v[5][i] * SC_W8, v[6][i] * SC_W8, v[7][i] * SC_W8);
        o.z = pk4_fp8(v[8][i] * SC_W8, v[9][i] * SC_W8, v[10][i] * SC_W8, v[11][i] * SC_W8); o.w = pk4_fp8(v[12][i] * SC_W8, v[13][i] * SC_W8, v[14][i] * SC_W8, v[15][i] * SC_W8);
        __builtin_nontemporal_store(o, (u32x4*)(dst + (size_t)(4 * (lane & 7) + i) * DE + 16 * (lane >> 3))); }
}
__device__ __forceinline__ void moe_convert(const Args& a, LAS unsigned char* lds, int begin, int end, int wave, int lane) {
    int it = begin + wave;
    if (it >= end) return;
    f32x4 cur[16], nxt[16];
    MoeItem mc = moe_item(a, it);
    moe_load(cur, mc, lane);
    for (;;) {
        const int itn = it + NWAVES; const bool more = itn < end;
        MoeItem mn = mc;
        if (more) { mn = moe_item(a, itn); moe_load(nxt, mn, lane); }
        moe_store(cur, mc.dst, lane);
        if (!more) break;
#pragma unroll
        for (int j = 0; j < 16; ++j) cur[j] = nxt[j];
        mc = mn; it = itn;
    }
}

struct P0Item { const float* src; bf16* dst; int ldw, ldt; };
__device__ __forceinline__ P0Item p0_item(const Args& a, int r) {
    constexpr int I_IN = (D / 64) * (C_GB_END_BF / 32), I_A = (AW / 64) * (D / 32);
    unsigned char* ws = a.ws; bf16* W1T = (bf16*)(ws + WS_W1T); bf16* W2T = (bf16*)(ws + WS_W2T);
    P0Item m;
    if (r < I_IN) { const int nblk = C_GB_END_BF / 32, kb = r / nblk, nb = r % nblk, k0 = kb * 64, n0 = nb * 32;
        bf16* dst;
        if (n0 < 2048) dst = W1T + (size_t)n0 * D; else if (n0 < 3072) dst = W2T + (size_t)(n0 - 2048) * D; else if (n0 < 4096) dst = W1T + (size_t)(n0 - 1024) * D;
        else dst = W2T + (size_t)(n0 - 3072) * D;
        m.src = a.in[2] + (size_t)k0 * PW + n0; m.ldw = PW; m.dst = dst + k0; m.ldt = D; return m; }
    r -= I_IN;
    const int nblk = D / 32;
    if (r < I_A) { const int kb2 = r / nblk, nb = r % nblk, k0 = kb2 * 64, n0 = nb * 32; m.src = a.in[8] + (size_t)k0 * D + n0; m.ldw = D; m.dst = (bf16*)(ws + WS_WAT) + (size_t)n0 * AW + k0; m.ldt = AW; return m; }
    r -= I_A;
    if (r < I_A) { const int kb2 = r / nblk, nb = r % nblk, k0 = kb2 * 64, n0 = nb * 32; m.src = a.in[9] + (size_t)k0 * D + n0; m.ldw = D; m.dst = (bf16*)(ws + WS_WBT) + (size_t)n0 * SW + k0; m.ldt = SW; return m; }
    r -= I_A;
    { const int kb2 = r / nblk, nb = r % nblk, k0 = kb2 * 64, n0 = nb * 32; m.src = a.in[10] + (size_t)k0 * D + n0; m.ldw = D; m.dst = (bf16*)(ws + WS_WOT) + (size_t)n0 * D + k0; m.ldt = D; return m; }
}
__device__ __forceinline__ void p0_load(f32x4 (&v)[8], const P0Item& m, int lane) {
#pragma unroll
    for (int j = 0; j < 8; ++j) v[j] = __builtin_nontemporal_load((const f32x4*)(m.src + (size_t)(8 * (lane >> 3) + j) * m.ldw + 4 * (lane & 7)));
}
__device__ __forceinline__ void p0_store(const f32x4 (&v)[8], const P0Item& m, int lane) {
#pragma unroll
    for (int i = 0; i < 4; ++i) { u32x4 o; o.x = cvt_pk_bf16(v[0][i], v[1][i]); o.y = cvt_pk_bf16(v[2][i], v[3][i]); o.z = cvt_pk_bf16(v[4][i], v[5][i]); o.w = cvt_pk_bf16(v[6][i], v[7][i]);
        *(u32x4*)(m.dst + (size_t)(4 * (lane & 7) + i) * m.ldt + 8 * (lane >> 3)) = o; }
}
__device__ __forceinline__ void p0_prologue(const Args& a, LAS unsigned char* lds, int vcu, int G, int wave, int lane) {
    unsigned char* ws = a.ws;
    const int gw = vcu * NWAVES + wave, NGW = G * NWAVES;
    constexpr int NITEMS = (D / 64) * (C_GB_END_BF / 32) + 2 * (AW / 64) * (D / 32) + (D / 64) * (D / 32);
    for (int it = gw; it < (D / 128) * ((PW - C_GB_END_BF) / 32); it += NGW) { const int nblk = (PW - C_GB_END_BF) / 32, kb = it / nblk, nb = it % nblk;
        MoeItem m; m.src = a.in[2] + (size_t)(kb * 128) * PW + C_GB_END_BF + nb * 32; m.ldw = PW; m.dst = ws + WS_WG8 + (size_t)(nb * 32) * D + kb * 128;
        f32x4 v[16]; moe_load(v, m, lane); moe_store(v, m.dst, lane); }
    if (gw < NITEMS) {
        int it = gw; f32x4 cur[8], nxt[8]; P0Item mc = p0_item(a, it); p0_load(cur, mc, lane);
        for (;;) { const int itn = it + NGW; const bool more = itn < NITEMS; P0Item mn = mc;
            if (more) { mn = p0_item(a, itn); p0_load(nxt, mn, lane); }
            p0_store(cur, mc, lane);
            if (!more) break;
#pragma unroll
            for (int j = 0; j < 8; ++j) cur[j] = nxt[j];
            mc = mn; it = itn; }
    }
    const float* g1 = a.in[1];
    if (gw < T) {
        int m = gw; f32x4 v[8], vn[8];
        { const f32x4* xr = (const f32x4*)(a.in[0] + (size_t)m * D) + lane;
#pragma unroll
          for (int j = 0; j < 8; ++j) v[j] = __builtin_nontemporal_load(xr + 64 * j); }
        for (;;) { const int mn = m + NGW; const bool more = mn < T;
            if (more) { const f32x4* xr = (const f32x4*)(a.in[0] + (size_t)mn * D) + lane;
#pragma unroll
                for (int j = 0; j < 8; ++j) vn[j] = __builtin_nontemporal_load(xr + 64 * j); }
            float s = 0.f;
#pragma unroll
            for (int j = 0; j < 8; ++j) s += (v[j].x * v[j].x + v[j].y * v[j].y) + (v[j].z * v[j].z + v[j].w * v[j].w);
            const float rstd = rsqrtf(wave_sum(s) * (1.f / D) + EPS);
            u32x2* o8 = (u32x2*)((bf16*)(ws + WS_XN) + (size_t)m * D) + lane; unsigned* o4 = (unsigned*)(ws + WS_XN8 + (size_t)m * D) + lane;
#pragma unroll
            for (int j = 0; j < 8; ++j) { const f32x4 gg = *((const f32x4*)g1 + lane + 64 * j);
                const float y0 = v[j].x * rstd * gg.x, y1 = v[j].y * rstd * gg.y, y2 = v[j].z * rstd * gg.z, y3 = v[j].w * rstd * gg.w;
                u32x2 o; o.x = cvt_pk_bf16(y0, y1); o.y = cvt_pk_bf16(y2, y3); o8[64 * j] = o;
                o4[64 * j] = pk4_fp8(y0 * SC_XN8, y1 * SC_XN8, y2 * SC_XN8, y3 * SC_XN8); }
            if (!more) break;
#pragma unroll
            for (int j = 0; j < 8; ++j) v[j] = vn[j];
            m = mn; }
    }
}

struct Epi1 {
    static constexpr bool PERM = true, CHAIN = false;
    bf16* PB; bf16* VT; bf16* QB; bf16* KB; float* stats; const float* gq; const float* gk; LAS float* scr;
    __device__ __forceinline__ void operator()(f32x4 (&acc)[2][2][4][2], const Unit& u, int wr, int wc, int fr, int fq) const {
        if (u.kind == 0) {
            const int pn = u.pn;
            bf16* base = PB + (size_t)(u.pm * 256 + wr * 64 + fr) * N1 + pn * 256 + wc * 32 + 8 * fq;
            if (pn < 8) {
#pragma unroll
                for (int ai = 0; ai < 2; ++ai)
#pragma unroll
                    for (int m = 0; m < 4; ++m)
#pragma unroll
                        for (int bj = 0; bj < 2; ++bj) { const f32x4 x0 = acc[ai][bj][m][0], x1 = acc[ai][bj][m][1];
                            float s = (x0.x * x0.x + x0.y * x0.y) + (x0.z * x0.z + x0.w * x0.w) + (x1.x * x1.x + x1.y * x1.y) + (x1.z * x1.z + x1.w * x1.w);
                            s += __shfl_xor(s, 16); s += __shfl_xor(s, 32);
                            if (fq == 0) scr[(ai * 128 + wr * 64 + m * 16 + fr) * 8 + bj * 4 + wc] = s; }
                LDS_WAIT(); __builtin_amdgcn_s_barrier(); asm volatile("" ::: "memory");
                const float* gn = (pn < 4) ? gq : gk; const float sc = (pn < 4) ? 0.12751743082459868f : 1.f;
                const f32x4 g0 = *(const f32x4*)(gn + wc * 32 + 8 * fq), g1 = *(const f32x4*)(gn + wc * 32 + 8 * fq + 4);
                bf16* qkb = (pn < 4 ? QB : KB) + ((size_t)(((u.pm * 256) >> 12) * NH + (pn & 3) * 2) * SEQ + ((u.pm * 256) & (SEQ - 1)) + wr * 64 + fr) * HD + wc * 32 + 8 * fq;
#pragma unroll
                for (int ai = 0; ai < 2; ++ai)
#pragma unroll
                    for (int m = 0; m < 4; ++m) { const int row = ai * 128 + wr * 64 + m * 16 + fr;
#pragma unroll
                        for (int bj = 0; bj < 2; ++bj) { const f32x4 p = *(const LAS f32x4*)(scr + row * 8 + bj * 4);
                            const float rinv = rsqrtf(((p.x + p.y) + (p.z + p.w)) * (1.f / HD) + EPS) * sc;
                            const f32x4 v0 = acc[ai][bj][m][0] * rinv * g0, v1 = acc[ai][bj][m][1] * rinv * g1;
                            u32x4 w; w.x = cvt_pk_bf16(v0.x, v0.y); w.y = cvt_pk_bf16(v0.z, v0.w); w.z = cvt_pk_bf16(v1.x, v1.y); w.w = cvt_pk_bf16(v1.z, v1.w);
                            *(u32x4*)(qkb + (size_t)(ai * 128 + m * 16) * HD + (size_t)bj * SEQ * HD) = w; } __builtin_amdgcn_sched_barrier(0); }
                LDS_WAIT();
            } else {
#pragma unroll
                for (int ai = 0; ai < 2; ++ai)
#pragma unroll
                    for (int m = 0; m < 4; ++m)
#pragma unroll
                        for (int bj = 0; bj < 2; ++bj) { f32x4 v0 = acc[ai][bj][m][0], v1 = acc[ai][bj][m][1];
#pragma unroll
                            for (int j = 0; j < 4; ++j) { v0[j] = gelu_tanh_f(v0[j]); v1[j] = gelu_tanh_f(v1[j]); }
                            u32x4 w; w.x = cvt_pk_bf16(v0.x, v0.y); w.y = cvt_pk_bf16(v0.z, v0.w); w.z = cvt_pk_bf16(v1.x, v1.y); w.w = cvt_pk_bf16(v1.z, v1.w);
                            *(u32x4*)(base + (size_t)(ai * 128 + m * 16) * N1 + bj * 128) = w; __builtin_amdgcn_sched_barrier(0); }
            }
        } else {
            const bool is_vv = u.pm >= 4;
            bf16* vtb = VT + ((((size_t)(((u.pn * 256) >> 12) * 16 + u.pm * 2) * 128 + (((u.pn * 256) & (SEQ - 1)) >> 5) + wc) * 128 + wr * 64 + fr) * 32 + 8 * fq);
            if (is_vv) {
#pragma unroll
                for (int bj = 0; bj < 2; ++bj)
#pragma unroll
                    for (int n = 0; n < 2; ++n) { f32x4 s = (f32x4){0.f, 0.f, 0.f, 0.f}, q = s;
#pragma unroll
                        for (int ai = 0; ai < 2; ++ai)
#pragma unroll
                            for (int m = 0; m < 4; ++m) { f32x4 x = acc[ai][bj][m][n];
#pragma unroll
                                for (int j = 0; j < 4; ++j) x[j] = gelu_tanh_f(x[j]);
                                s += x; q += x * x; }
#pragma unroll
                        for (int o = 1; o < 16; o <<= 1) {
#pragma unroll
                            for (int j = 0; j < 4; ++j) { s[j] += __shfl_xor(s[j], o); q[j] += __shfl_xor(q[j], o); } }
                        if (fr == 0) { const int slot = (u.pm - 4) * 2 + wr; float* sp = stats + ((size_t)(u.pn * 256 + bj * 128 + wc * 32 + 8 * fq + 4 * n) * 8 + slot) * 2;
#pragma unroll
                            for (int j = 0; j < 4; ++j) *(f32x2*)(sp + 16 * j) = (f32x2){s[j], q[j]}; }
                        __builtin_amdgcn_sched_barrier(0); }
            }
#pragma unroll
            for (int ai = 0; ai < 2; ++ai)
#pragma unroll
                for (int m = 0; m < 4; ++m)
#pragma unroll
                    for (int bj = 0; bj < 2; ++bj) { f32x4 v0 = acc[ai][bj][m][0], v1 = acc[ai][bj][m][1];
                        if (is_vv) {
#pragma unroll
                            for (int j = 0; j < 4; ++j) { v0[j] = gelu_tanh_f(v0[j]); v1[j] = gelu_tanh_f(v1[j]); } }
                        u32x4 w; w.x = cvt_pk_bf16(v0.x, v0.y); w.y = cvt_pk_bf16(v0.z, v0.w); w.z = cvt_pk_bf16(v1.x, v1.y); w.w = cvt_pk_bf16(v1.z, v1.w);
                        *(u32x4*)(vtb + (size_t)ai * (128 * 128 * 32) + bj * (4 * 128 * 32) + m * (16 * 32)) = w; __builtin_amdgcn_sched_barrier(0); }
        }
    }
};
struct Sched1 {
    int G, c; const char* XN; const char* W1T; const char* W2T;
    __device__ __forceinline__ bool next(int i, Unit& u) const {
        const int L = i * G + c; if (L >= 640) return false;
        u.e = 0; u.nvalid = 256; u.rbase = 0;
        if (L < 384) { pg8::tile_order(L, 32, 12, u.pm, u.pn); u.kind = 0; u.A = XN + (size_t)u.pm * 256 * D * 2; u.B = W1T + (size_t)u.pn * 256 * D * 2; }
        else { pg8::tile_order(L - 384, 8, 32, u.pm, u.pn); u.kind = 1; u.A = W2T + (size_t)u.pm * 256 * D * 2; u.B = XN + (size_t)u.pn * 256 * D * 2; }
        return true;
    }
};
struct Epi1g {
    static constexpr bool PERM = true, CHAIN = false;
    bf16* PB;
    __device__ __forceinline__ void operator()(f32x4 (&acc)[2][2][4][2], const Unit& u, int wr, int wc, int fr, int fq) const {
        constexpr float ds = 1.f / (SC_XN8 * SC_W8);
        bf16* base = PB + (size_t)(u.pm * 256 + wr * 64 + fr) * N1 + C_GA + u.pn * 256 + wc * 32 + 8 * fq;
#pragma unroll
        for (int ai = 0; ai < 2; ++ai)
#pragma unroll
            for (int m = 0; m < 4; ++m)
#pragma unroll
                for (int bj = 0; bj < 2; ++bj) { f32x4 v0 = acc[ai][bj][m][0] * ds, v1 = acc[ai][bj][m][1] * ds;
#pragma unroll
                    for (int j = 0; j < 4; ++j) { v0[j] = sigmoid_f(v0[j]); v1[j] = sigmoid_f(v1[j]); }
                    u32x4 w; w.x = cvt_pk_bf16(v0.x, v0.y); w.y = cvt_pk_bf16(v0.z, v0.w); w.z = cvt_pk_bf16(v1.x, v1.y); w.w = cvt_pk_bf16(v1.z, v1.w);
                    *(u32x4*)(base + (size_t)(ai * 128 + m * 16) * N1 + bj * 128) = w; __builtin_amdgcn_sched_barrier(0); }
    }
};
struct Sched1g {
    int G, c; const char* XN8; const char* WG8;
    __device__ __forceinline__ bool next(int i, Unit& u) const {
        const int L = i * G + c; if (L >= 512) return false;
        u.e = 0; u.nvalid = 256; u.rbase = 0; u.kind = 0;
        pg8::tile_order(L, 32, 16, u.pm, u.pn); u.A = XN8 + (size_t)u.pm * 256 * D; u.B = WG8 + (size_t)u.pn * 256 * D;
        return true;
    }
};

__device__ __forceinline__ void attn_task(const bf16* QB, const bf16* KB, const bf16* VT, bf16* OA, int task, int lane) {
    const int bh = task >> 7, qb = task & 127, b = bh >> 3, h = bh & 7;
    const int c = lane & 31, hh = lane >> 5;
    const size_t tokbase = (size_t)b * SEQ;
    const int t0 = qb * 32;
    bf16x8 qf[8];
    { const bf16* qp = QB + ((size_t)bh * SEQ + t0 + c) * HD + 8 * hh;
#pragma unroll
      for (int s = 0; s < 8; ++s) qf[s] = *(const bf16x8*)(qp + 16 * s); }
    f32x16 o[4];
#pragma unroll
    for (int d = 0; d < 4; ++d)
#pragma unroll
        for (int r = 0; r < 16; ++r) o[d][r] = 0.f;
    float crun = 0.f;
    const int kap = 16 * ((c >> 2) & 1) + 4 * (c >> 3) + (c & 3);
    const bf16* kp0 = KB + ((size_t)bh * SEQ + kap) * HD + 8 * hh;
    const bf16* vp0 = VT + ((size_t)(b * 16 + h) * 128 * 128 + c) * 32 + 16 * hh;
    bf16x8 kf[8];
#pragma unroll
    for (int s = 0; s < 8; ++s) kf[s] = *(const bf16x8*)(kp0 + (size_t)t0 * HD + 16 * s);
    for (int j = qb; j >= 0; --j) {
        const int kbase = j * 32;
        bf16x8 vf[4][2];
#pragma unroll
        for (int d = 0; d < 4; ++d)
#pragma unroll
            for (int s = 0; s < 2; ++s) vf[d][s] = *(const bf16x8*)(vp0 + (size_t)j * 4096 + d * 1024 + 8 * s);
        f32x16 S;
#pragma unroll
        for (int r = 0; r < 16; ++r) S[r] = 0.f;
#pragma unroll
        for (int s = 0; s < 8; ++s) S = __builtin_amdgcn_mfma_f32_32x32x16_bf16(kf[s], qf[s], S, 0, 0, 0);
        if (j > 0) {
#pragma unroll
            for (int s = 0; s < 8; ++s) kf[s] = *(const bf16x8*)(kp0 + (size_t)(kbase - 32) * HD + 16 * s);
        }
        const int tq = t0 + c, k0 = kbase + 16 * hh;
        float Lk[16], run = 0.f;
        if (j == qb) {
#pragma unroll
            for (int r = 0; r < 16; ++r) { const float z = S[r]; const float sp = fmaxf(z, 0.f) + __builtin_amdgcn_logf(1.f + __builtin_amdgcn_exp2f(-fabsf(z)));
                const bool past = (k0 + r) < tq; Lk[r] = past ? -sp : 0.f; S[r] = past ? z : -1e30f; run += Lk[r]; }
        } else {
#pragma unroll
            for (int r = 0; r < 16; ++r) { const float z = S[r]; const float sp = fmaxf(z, 0.f) + __builtin_amdgcn_logf(1.f + __builtin_amdgcn_exp2f(-fabsf(z))); Lk[r] = -sp; run += Lk[r]; }
        }
        const float other = __shfl_xor(run, 32);
        float acc_after = crun + (hh == 0 ? other : 0.f);
        float w[16];
#pragma unroll
        for (int r = 15; r >= 0; --r) { w[r] = __builtin_amdgcn_exp2f((S[r] + Lk[r]) + acc_after); acc_after += Lk[r]; }
        crun += run + other;
        bf16x8 pf[2];
#pragma unroll
        for (int s = 0; s < 2; ++s) { u32x4 pk; pk.x = cvt_pk_bf16(w[8 * s + 0], w[8 * s + 1]); pk.y = cvt_pk_bf16(w[8 * s + 2], w[8 * s + 3]); pk.z = cvt_pk_bf16(w[8 * s + 4], w[8 * s + 5]); pk.w = cvt_pk_bf16(w[8 * s + 6], w[8 * s + 7]);
            pf[s] = __builtin_bit_cast(bf16x8, pk); }
#pragma unroll
        for (int d = 0; d < 4; ++d)
#pragma unroll
            for (int s = 0; s < 2; ++s) o[d] = __builtin_amdgcn_mfma_f32_32x32x16_bf16(vf[d][s], pf[s], o[d], 0, 0, 0);
        if (__all(crun < -151.f)) break;
    }
    bf16* op = OA + (tokbase + t0 + c) * AW + h * HD + 4 * hh;
#pragma unroll
    for (int d = 0; d < 4; ++d)
#pragma unroll
        for (int g = 0; g < 4; ++g) { u32x2 pk; pk.x = cvt_pk_bf16(o[d][4 * g + 0], o[d][4 * g + 1]); pk.y = cvt_pk_bf16(o[d][4 * g + 2], o[d][4 * g + 3]);
            *(u32x2*)(op + d * 32 + 8 * g) = pk; }
}

__device__ __forceinline__ void sgu_task(const Args& a, const bf16* PB, const bf16* VT, const float* stats, bf16* OB, int idx, int lane) {
    const int ib = idx & 3, g = (idx >> 2) & 7, n = idx >> 5;
    const int c = lane & 31, hh = lane >> 5;
    const float* wsp = a.in[6] + ((size_t)g * 128 + ib * 32 + c) * 128 + 8 * hh;
    const bf16* vvp = VT + (((size_t)((n >> 5) * 16 + 8 + g) * 128 + (n & 31) * 4) * 128 + c) * 32 + 8 * hh;
    f32x16 acc[4];
#pragma unroll
    for (int d = 0; d < 4; ++d)
#pragma unroll
        for (int r = 0; r < 16; ++r) acc[d][r] = 0.f;
    const int nks = ib < 2 ? 4 : 8;
    for (int ks = 0; ks < nks; ++ks) {
        float mu[8], rs[8];
        { const f32x4 st = *(const f32x4*)(stats + ((size_t)(n * 128 + 16 * ks + (lane >> 2)) * 8 + 2 * (lane & 3)) * 2);
          float S = st.x + st.z, Q = st.y + st.w;
          S += __shfl_xor(S, 1); Q += __shfl_xor(Q, 1); S += __shfl_xor(S, 2); Q += __shfl_xor(Q, 2);
          const float m_ = S * (1.f / SW), r_ = rsqrtf(fmaxf(Q * (1.f / SW) - m_ * m_, 0.f) + EPS);
#pragma unroll
          for (int j = 0; j < 8; ++j) { mu[j] = __shfl(m_, 4 * (8 * hh + j)); rs[j] = __shfl(r_, 4 * (8 * hh + j)); } }
        const f32x4 w0 = *(const f32x4*)(wsp + 16 * ks), w1 = *(const f32x4*)(wsp + 16 * ks + 4);
        u32x4 bw; bw.x = cvt_pk_bf16(w0.x, w0.y); bw.y = cvt_pk_bf16(w0.z, w0.w); bw.z = cvt_pk_bf16(w1.x, w1.y); bw.w = cvt_pk_bf16(w1.z, w1.w);
        const bf16x8 bfrag = __builtin_bit_cast(bf16x8, bw);
#pragma unroll
        for (int cbk = 0; cbk < 4; ++cbk) {
            const u32x4 raw = *(const u32x4*)(vvp + (size_t)(ks >> 1) * 4096 + cbk * 1024 + 16 * (ks & 1));
            u32x4 nv;
            nv.x = cvt_pk_bf16((bf_lo(raw.x) - mu[0]) * rs[0], (bf_hi(raw.x) - mu[1]) * rs[1]);
            nv.y = cvt_pk_bf16((bf_lo(raw.y) - mu[2]) * rs[2], (bf_hi(raw.y) - mu[3]) * rs[3]);
            nv.z = cvt_pk_bf16((bf_lo(raw.z) - mu[4]) * rs[4], (bf_hi(raw.z) - mu[5]) * rs[5]);
            nv.w = cvt_pk_bf16((bf_lo(raw.w) - mu[6]) * rs[6], (bf_hi(raw.w) - mu[7]) * rs[7]);
            acc[cbk] = __builtin_amdgcn_mfma_f32_32x32x16_bf16(__builtin_bit_cast(bf16x8, nv), bfrag, acc[cbk], 0, 0, 0);
        }
    }
    const int tok = n * 128 + ib * 32 + c;
    const float bsp = a.in[7][g * 128 + ib * 32 + c];
    const float* gam = a.in[5] + g * 128 + 4 * hh;
    const bf16* up = PB + (size_t)tok * N1 + C_U + g * 128 + 4 * hh;
    bf16* op = OB + (size_t)tok * SW + g * 128 + 4 * hh;
#pragma unroll
    for (int d = 0; d < 4; ++d)
#pragma unroll
        for (int gg = 0; gg < 4; ++gg) { const f32x4 gm = *(const f32x4*)(gam + d * 32 + 8 * gg); const u32x2 uu = *(const u32x2*)(up + d * 32 + 8 * gg);
            const float r0 = bf_lo(uu.x) * (gm.x * acc[d][4 * gg + 0] + bsp), r1 = bf_hi(uu.x) * (gm.y * acc[d][4 * gg + 1] + bsp);
            const float r2 = bf_lo(uu.y) * (gm.z * acc[d][4 * gg + 2] + bsp), r3 = bf_hi(uu.y) * (gm.w * acc[d][4 * gg + 3] + bsp);
            u32x2 pk; pk.x = cvt_pk_bf16(r0, r1); pk.y = cvt_pk_bf16(r2, r3); *(u32x2*)(op + d * 32 + 8 * gg) = pk; }
}

struct Epi3 {
    static constexpr bool PERM = true, CHAIN = true;
    const bf16* PB; bf16* Y;
    __device__ __forceinline__ void operator()(f32x4 (&acc)[2][2][4][2], const Unit& u, int wr, int wc, int fr, int fq) const {
        const int row0 = u.pm * 256 + wr * 64 + fr, col0 = u.pn * 256 + wc * 32 + 8 * fq;
        const bf16* gpa = PB + (size_t)row0 * N1 + C_GA + col0; const bf16* gpb = PB + (size_t)row0 * N1 + C_GB + col0;
#pragma unroll
        for (int ai = 0; ai < 2; ++ai)
#pragma unroll
            for (int m = 0; m < 4; ++m)
#pragma unroll
                for (int bj = 0; bj < 2; ++bj) { const size_t ro = (size_t)(ai * 128 + m * 16);
                    const u32x4 gb = *(const u32x4*)(gpb + ro * N1 + bj * 128);
                    f32x4 b0, b1;
                    b0.x = fmaxf(bf_lo(gb.x), 1e-20f); b0.y = fmaxf(bf_hi(gb.x), 1e-20f); b0.z = fmaxf(bf_lo(gb.y), 1e-20f); b0.w = fmaxf(bf_hi(gb.y), 1e-20f);
                    b1.x = fmaxf(bf_lo(gb.z), 1e-20f); b1.y = fmaxf(bf_hi(gb.z), 1e-20f); b1.z = fmaxf(bf_lo(gb.w), 1e-20f); b1.w = fmaxf(bf_hi(gb.w), 1e-20f);
                    if (u.kind == 0) {
                        const u32x4 ga = *(const u32x4*)(gpa + ro * N1 + bj * 128);
                        f32x4 r0, r1;
                        r0.x = bf_lo(ga.x) * fast_rcp(b0.x); r0.y = bf_hi(ga.x) * fast_rcp(b0.y); r0.z = bf_lo(ga.y) * fast_rcp(b0.z); r0.w = bf_hi(ga.y) * fast_rcp(b0.w);
                        r1.x = bf_lo(ga.z) * fast_rcp(b1.x); r1.y = bf_hi(ga.z) * fast_rcp(b1.y); r1.z = bf_lo(ga.w) * fast_rcp(b1.z); r1.w = bf_hi(ga.w) * fast_rcp(b1.w);
                        acc[ai][bj][m][0] *= r0; acc[ai][bj][m][1] *= r1;
                    } else {
                        const f32x4 v0 = acc[ai][bj][m][0] * b0, v1 = acc[ai][bj][m][1] * b1;
                        u32x4 w; w.x = cvt_pk_bf16(v0.x, v0.y); w.y = cvt_pk_bf16(v0.z, v0.w); w.z = cvt_pk_bf16(v1.x, v1.y); w.w = cvt_pk_bf16(v1.z, v1.w);
                        *(u32x4*)(Y + (size_t)(row0 + ro) * D + col0 + bj * 128) = w; } }
    }
};
struct Sched3 {
    int G, c; const char* OA; const char* OB; const char* WAT; const char* WBT;
    __device__ __forceinline__ bool next(int i, Unit& u) const {
        const int tile = c + (i >> 1) * G; if (tile >= 256) return false;
        pg8::tile_order(tile, 32, 8, u.pm, u.pn); u.kind = i & 1; u.e = 0; u.nvalid = 256; u.rbase = 0;
        u.A = (u.kind == 0 ? OA : OB) + (size_t)u.pm * 256 * AW * 2; u.B = (u.kind == 0 ? WAT : WBT) + (size_t)u.pn * 256 * AW * 2;
        return true;
    }
};

struct Epi4 {
    static constexpr bool PERM = true, CHAIN = false;
    const float* X; bf16* H1;
    __device__ __forceinline__ void operator()(f32x4 (&acc)[2][2][4][2], const Unit& u, int wr, int wc, int fr, int fq) const {
        const size_t o0 = (size_t)(u.pm * 256 + wr * 64 + fr) * D + u.pn * 256 + wc * 32 + 8 * fq;
#pragma unroll
        for (int ai = 0; ai < 2; ++ai)
#pragma unroll
            for (int m = 0; m < 4; ++m)
#pragma unroll
                for (int bj = 0; bj < 2; ++bj) { const size_t o = o0 + (size_t)(ai * 128 + m * 16) * D + bj * 128;
                    const f32x4 v0 = *(const f32x4*)(X + o) + acc[ai][bj][m][0], v1 = *(const f32x4*)(X + o + 4) + acc[ai][bj][m][1];
                    u32x4 w; w.x = cvt_pk_bf16(v0.x, v0.y); w.y = cvt_pk_bf16(v0.z, v0.w); w.z = cvt_pk_bf16(v1.x, v1.y); w.w = cvt_pk_bf16(v1.z, v1.w);
                    *(u32x4*)(H1 + o) = w; }
    }
};
struct Sched4 {
    int G, c; const char* Y; const char* WOT;
    __device__ __forceinline__ bool next(int i, Unit& u) const {
        const int tile = c + i * G; if (tile >= 256) return false;
        pg8::tile_order(tile, 32, 8, u.pm, u.pn); u.kind = 0; u.e = 0; u.nvalid = 256; u.rbase = 0;
        u.A = Y + (size_t)u.pm * 256 * D * 2; u.B = WOT + (size_t)u.pn * 256 * D * 2;
        return true;
    }
};

template <int PH> struct SchedMoE {
    int G, vcu; const volatile LAS unsigned* misc; const char* Abase; const char* Bbase; int ncu;
    __device__ __forceinline__ bool next(int i, Unit& u) const {
        const volatile LAS unsigned* us = misc + (PH == 6 ? MW_US6 : MW_US7);
        const int total = __builtin_amdgcn_readfirstlane((int)us[NE]);
        int L;
        if ((G & 255) == 0) { const int nx = G >> 5, chunk = (total + nx - 1) / nx, x = vcu >> 5, j = vcu & 31;
            if (ncu == 32) { L = x * chunk + i * 32 + j; if (L >= (x + 1) * chunk) return false; }
            else {
                int len = total - x * chunk; len = len < 0 ? 0 : (len > chunk ? chunk : len);
                const int R = len / ncu - MOE_TAIL_TEST;
                if (j < ncu) { if (i >= R) return false; L = x * chunk + i * ncu + j; }
                else { const int p = i * (32 - ncu) + (j - ncu); if (p >= len - R * ncu) return false; L = x * chunk + R * ncu + p; } } }
        else L = i * G + vcu;
        if (L >= total) return false;
        const int ln = (int)(threadIdx.x & 63);
        const unsigned mine = us[ln < NE ? ln : NE];
        const unsigned long long mk = __ballot((unsigned)L >= mine);
        const int e = __builtin_amdgcn_readfirstlane(63 - __builtin_clzll(mk | 1ull));
        const int ne = __builtin_amdgcn_readfirstlane((int)misc[MW_CNT + e]), off = __builtin_amdgcn_readfirstlane((int)misc[MW_OFF + e]);
        const int st = __builtin_amdgcn_readfirstlane((int)us[e]);
        const int mte = (ne + 255) >> 8, rem = L - st, mt = rem % mte, ntl = rem / mte;
        u.kind = 0; u.pm = mt; u.pn = ntl; u.e = e; u.nvalid = ne - mt * 256; u.rbase = off + mt * 256;
        if (PH == 6) { u.A = Abase + ((size_t)e * T + (size_t)mt * 256) * D; u.B = Bbase + ((size_t)e * 2 * DE + (size_t)ntl * 256) * D; }
        else { u.A = Abase + (size_t)u.rbase * DE; u.B = Bbase + ((size_t)e * D + (size_t)ntl * 256) * DE; }
        return true;
    }
};
__device__ __forceinline__ f32x2 swiglu_pk(f32x2 g, f32x2 u) {
    const f32x2 ga = __builtin_elementwise_min(g, (f32x2){7.f, 7.f});
    const f32x2 ua = __builtin_elementwise_min(__builtin_elementwise_max(u, (f32x2){-7.f, -7.f}), (f32x2){7.f, 7.f});
    const f32x2 t = ga * (-1.702f * 1.4426950408889634f);
    f32x2 d; d.x = __builtin_amdgcn_exp2f(t.x); d.y = __builtin_amdgcn_exp2f(t.y); d = d + 1.0f;
    f32x2 r; r.x = __builtin_amdgcn_rcpf(d.x); r.y = __builtin_amdgcn_rcpf(d.y);
    return (ga * r) * (ua * SC_A8 + SC_A8);
}
__device__ __forceinline__ unsigned pk4_fp8_nc(float a, float b, float c, float d) { int r = 0; r = __builtin_amdgcn_cvt_pk_fp8_f32(a, b, r, false); r = __builtin_amdgcn_cvt_pk_fp8_f32(c, d, r, true); return (unsigned)r; }
struct Epi6 {
    static constexpr bool PERM = true, CHAIN = false;
    const float* bup; unsigned char* ACT;
    __device__ __forceinline__ void operator()(f32x4 (&acc)[2][2][4][2], const Unit& u, int wr, int wc, int fr, int fq) const {
        const int cc = u.pn * 128 + wc * 32 + 8 * fq;
        const float* bg = bup + (size_t)u.e * 2 * DE + cc;
        const f32x4 bg0 = *(const f32x4*)bg, bg1 = *(const f32x4*)(bg + 4), bu0 = *(const f32x4*)(bg + DE), bu1 = *(const f32x4*)(bg + DE + 4);
        constexpr float ds = 1.f / (SC_W8 * SC_X8);
#pragma unroll
        for (int ai = 0; ai < 2; ++ai)
#pragma unroll
            for (int m = 0; m < 4; ++m) { const int row = ai * 128 + wr * 64 + m * 16 + fr;
                const f32x4 g0 = acc[ai][0][m][0] * ds + bg0, g1 = acc[ai][0][m][1] * ds + bg1, u0 = acc[ai][1][m][0] * ds + bu0, u1 = acc[ai][1][m][1] * ds + bu1;
                const f32x2 a0 = swiglu_pk((f32x2){g0.x, g0.y}, (f32x2){u0.x, u0.y}), a1 = swiglu_pk((f32x2){g0.z, g0.w}, (f32x2){u0.z, u0.w});
                const f32x2 a2 = swiglu_pk((f32x2){g1.x, g1.y}, (f32x2){u1.x, u1.y}), a3 = swiglu_pk((f32x2){g1.z, g1.w}, (f32x2){u1.z, u1.w});
                if (row < u.nvalid) { u32x2 w; w.x = pk4_fp8_nc(a0.x, a0.y, a1.x, a1.y); w.y = pk4_fp8_nc(a2.x, a2.y, a3.x, a3.y);
                    *(u32x2*)(ACT + (size_t)(u.rbase + row) * DE + cc) = w; } }
    }
};
struct Epi7 {
    static constexpr bool PERM = true, CHAIN = false;
    const float* bdn; unsigned char* YM;
    __device__ __forceinline__ void operator()(f32x4 (&acc)[2][2][4][2], const Unit& u, int wr, int wc, int fr, int fq) const {
        const int cc = u.pn * 256 + wc * 32 + 8 * fq;
        const float* bp = bdn + (size_t)u.e * D + cc;
        f32x4 bb[2][2];
#pragma unroll
        for (int bj = 0; bj < 2; ++bj) { bb[bj][0] = *(const f32x4*)(bp + bj * 128); bb[bj][1] = *(const f32x4*)(bp + bj * 128 + 4); }
#pragma unroll
        for (int ai = 0; ai < 2; ++ai)
#pragma unroll
            for (int m = 0; m < 4; ++m) { const int row = ai * 128 + wr * 64 + m * 16 + fr;
                if (row < u.nvalid) {
#pragma unroll
                    for (int bj = 0; bj < 2; ++bj) { constexpr float ds = 1.f / (SC_W8 * SC_A8); const f32x4 v0 = acc[ai][bj][m][0] * ds + bb[bj][0], v1 = acc[ai][bj][m][1] * ds + bb[bj][1];
                        u32x2 w; w.x = pk4_fp8(v0.x * SC_Y8, v0.y * SC_Y8, v0.z * SC_Y8, v0.w * SC_Y8); w.y = pk4_fp8(v1.x * SC_Y8, v1.y * SC_Y8, v1.z * SC_Y8, v1.w * SC_Y8);
                        *(u32x2*)(YM + (size_t)(u.rbase + row) * D + cc + bj * 128) = w; } } }
    }
};

__global__ void __launch_bounds__(NWAVES * 64, 2) fwd(Args a) {
    extern __shared__ __attribute__((aligned(16))) unsigned char lds_raw[];
    LAS unsigned char* lds = (LAS unsigned char*)lds_raw;
    volatile LAS unsigned* MISC = (volatile LAS unsigned*)(lds + MISC_OFF);
    const int tid = threadIdx.x, lane = tid & 63, wave = __builtin_amdgcn_readfirstlane(tid >> 6);
    const int G = gridDim.x, bx = blockIdx.x;
    const int vcu = (G % 8 == 0) ? (bx % 8) * (G / 8) + bx / 8 : bx;
    unsigned char* ws = a.ws;
    unsigned* ctl = (unsigned*)(ws + WS_CTL);
    for (int u = tid; u < 512; u += NWAVES * 64) MISC[u] = 0u;
    __syncthreads();
    XcdBarrier bar = xcd_barrier_post(ctl + CW_BAR, MISC + MW_BAR);
    const int gw = vcu * NWAVES + wave, NGW = G * NWAVES;

    bf16* PB = (bf16*)(ws + WS_PB); bf16* VT = (bf16*)(ws + WS_VT); bf16* OA = (bf16*)(ws + WS_OA); bf16* OB = (bf16*)(ws + WS_OB);
    float* stats = (float*)(ws + WS_STATS);
    int* tok_e = (int*)(ws + WS_ROUTE); int* tok_rank = tok_e + T * TOPK; float* tok_gate = (float*)(tok_rank + T * TOPK);

    if (PH_ON(0)) p0_prologue(a, lds, vcu, G, wave, lane);
    xcd_barrier(bar);

    if (PH_ON(1)) {
        int cbeg, cend;
        constexpr int NUP = NE * I_UP1;
        const bool split6 = (G == 256);
        const int CONV1 = split6 ? NUP : MOE_ITEMS;
        if (G == 256) { constexpr int S5 = 220, S4 = 292; static_assert(128 * (S5 + S4) == NUP, "conversion shares");
            cbeg = bx < 128 ? bx * S5 : 128 * S5 + (bx - 128) * S4; cend = cbeg + (bx < 128 ? S5 : S4); }
        else { const int per = (CONV1 + G - 1) / G; cbeg = bx * per; cend = cbeg + per < CONV1 ? cbeg + per : CONV1; if (cbeg > CONV1) cbeg = CONV1; }
        const bool conv_first = ((bx >> 3) & 1) != 0;
        const bool roles = (G == 256);
        const int ridx = (bx >> 4) * 8 + (bx & 7);
        if (roles && conv_first) moe_convert(a, lds, ridx * (NUP / 128), (ridx + 1) * (NUP / 128), wave, lane);
        if (!roles && conv_first) { moe_convert(a, lds, cbeg, cend, wave, lane); __syncthreads(); }
        if (!(roles && conv_first)) {
        pg8::Gemm g{D, D, D};
        Sched1 S{roles ? 128 : G, roles ? ridx : bx, (const char*)(ws + WS_XN), (const char*)(ws + WS_W1T), (const char*)(ws + WS_W2T)};
        Epi1 E{PB, VT, (bf16*)(ws + WS_QB), (bf16*)(ws + WS_KB), stats, a.in[3], a.in[4], (LAS float*)(lds + SCR_OFF)};
        pg8::gemm_phase<Epi1, Sched1>(lds, g, S, E);
        { pg8::Gemm g8{D / 2, D / 2, D / 2};
          Sched1g S8{roles ? 128 : G, roles ? ridx : bx, (const char*)(ws + WS_XN8), (const char*)(ws + WS_WG8)};
          Epi1g E8{PB};
          pg8::gemm_phase<Epi1g, Sched1g, true>(lds, g8, S8, E8); }
        }
        if (!roles && !conv_first) moe_convert(a, lds, cbeg, cend, wave, lane);
    }
    xcd_barrier(bar);

    if (PH_ON(2)) for (int task = gw; task < 4096; task += NGW) {
        if (task < 2048) attn_task((const bf16*)(ws + WS_QB), (const bf16*)(ws + WS_KB), VT, OA, task, lane);
        else sgu_task(a, PB, VT, stats, OB, task - 2048, lane);
    }
    xcd_barrier(bar);

    if (PH_ON(3)) {
        pg8::Gemm g{AW, AW, AW};
        Sched3 S{G, bx, (const char*)(ws + WS_OA), (const char*)(ws + WS_OB), (const char*)(ws + WS_WAT), (const char*)(ws + WS_WBT)};
        Epi3 E{PB, (bf16*)(ws + WS_Y)};
        pg8::gemm_phase<Epi3, Sched3>(lds, g, S, E);
    }
    xcd_barrier(bar);

    if (PH_ON(4)) {
        pg8::Gemm g{D, D, D};
        Sched4 S{G, bx, (const char*)(ws + WS_Y), (const char*)(ws + WS_WOT)};
        Epi4 E{a.in[0], (bf16*)(ws + WS_H1)};
        pg8::gemm_phase<Epi4, Sched4>(lds, g, S, E);
    }
#if DBG_STAGE >= 5
    xcd_barrier(bar);

    if (PH_ON(5)) {
        LAS float* red = (LAS float*)lds;
        LAS float* ssqp = (LAS float*)(lds + 8 * 1056 * 4);
        LAS float* rinfo = ssqp + 256;
        LAS unsigned* lcnt = (LAS unsigned*)(rinfo + 384); LAS unsigned* lbase = lcnt + 32;
        const float* g2 = a.in[11]; const float* wrt = a.in[12]; const float* brt = a.in[13];
        for (int rb = bx; rb < T / 32; rb += G) {
            const int row0 = rb * 32, i = lane & 31, hk = lane >> 5, kb = wave * 256 + hk * 128;
            if (tid < 32) lcnt[tid] = 0u;
            const bf16* xr = (const bf16*)(ws + WS_H1) + (size_t)(row0 + i) * D + kb;
            f32x16 acc;
#pragma unroll
            for (int r = 0; r < 16; ++r) acc[r] = 0.f;
            float ssq = 0.f;
            for (int ch = 0; ch < 4; ++ch) {
                f32x4 xv[8];
#pragma unroll
                for (int q = 0; q < 4; ++q) { const u32x4 h = *(const u32x4*)(xr + ch * 32 + q * 8);
                    xv[2 * q] = (f32x4){bf_lo(h.x), bf_hi(h.x), bf_lo(h.y), bf_hi(h.y)}; xv[2 * q + 1] = (f32x4){bf_lo(h.z), bf_hi(h.z), bf_lo(h.w), bf_hi(h.w)}; }
#pragma unroll
                for (int q = 0; q < 8; ++q)
#pragma unroll
                    for (int jj = 0; jj < 4; ++jj) { const int k = kb + ch * 32 + q * 4 + jj; const float x = xv[q][jj];
                        const float bw = wrt[(size_t)k * NE + i] * g2[k];
                        acc = __builtin_amdgcn_mfma_f32_32x32x2f32(x, bw, acc, 0, 0, 0); ssq += x * x; }
            }
            ssq += __shfl_xor(ssq, 32);
            if (lane < 32) ssqp[wave * 32 + i] = ssq;
#pragma unroll
            for (int r = 0; r < 16; ++r) red[wave * 1056 + i * 33 + (r & 3) + 8 * (r >> 2) + 4 * hk] = acc[r];
            LDS_WAIT(); __syncthreads();
            if (tid < 32) {
                float sq = 0.f;
#pragma unroll
                for (int w = 0; w < 8; ++w) sq += ssqp[w * 32 + tid];
                const float rstd = rsqrtf(sq * (1.f / D) + EPS);
                float v0 = -3.0e38f, v1 = -3.0e38f, v2 = -3.0e38f, v3 = -3.0e38f; int i0 = 0, i1 = 0, i2 = 0, i3 = 0;
                for (int e = 0; e < NE; ++e) { float v = 0.f;
#pragma unroll
                    for (int w = 0; w < 8; ++w) v += red[w * 1056 + e * 33 + tid];
                    const float x = v * rstd + brt[e];
                    if (x > v3) { if (x > v2) { v3 = v2; i3 = i2; if (x > v1) { v2 = v1; i2 = i1; if (x > v0) { v1 = v0; i1 = i0; v0 = x; i0 = e; } else { v1 = x; i1 = e; } } else { v2 = x; i2 = e; } } else { v3 = x; i3 = e; } } }
                const float p1 = __expf(v1 - v0), p2 = __expf(v2 - v0), p3 = __expf(v3 - v0), inv = 1.f / (1.f + p1 + p2 + p3);
                const int t = row0 + tid;
                const unsigned l0 = __hip_atomic_fetch_add(lcnt + i0, 1u, __ATOMIC_RELAXED, __HIP_MEMORY_SCOPE_WORKGROUP), l1 = __hip_atomic_fetch_add(lcnt + i1, 1u, __ATOMIC_RELAXED, __HIP_MEMORY_SCOPE_WORKGROUP);
                const unsigned l2 = __hip_atomic_fetch_add(lcnt + i2, 1u, __ATOMIC_RELAXED, __HIP_MEMORY_SCOPE_WORKGROUP), l3 = __hip_atomic_fetch_add(lcnt + i3, 1u, __ATOMIC_RELAXED, __HIP_MEMORY_SCOPE_WORKGROUP);
                LDS_WAIT(); asm volatile("" ::: "memory");
                { const unsigned ne_ = lcnt[tid]; unsigned base_ = 0u; if (ne_) base_ = atomicAdd(ctl + CW_CNT + 64 * tid, ne_); lbase[tid] = base_; }
                LDS_WAIT(); asm volatile("" ::: "memory");
                const int r0 = (int)(lbase[i0] + l0), r1 = (int)(lbase[i1] + l1), r2 = (int)(lbase[i2] + l2), r3 = (int)(lbase[i3] + l3);
                tok_e[t * 4 + 0] = i0; tok_e[t * 4 + 1] = i1; tok_e[t * 4 + 2] = i2; tok_e[t * 4 + 3] = i3;
                tok_rank[t * 4 + 0] = r0; tok_rank[t * 4 + 1] = r1; tok_rank[t * 4 + 2] = r2; tok_rank[t * 4 + 3] = r3;
                tok_gate[t * 4 + 0] = inv; tok_gate[t * 4 + 1] = p1 * inv; tok_gate[t * 4 + 2] = p2 * inv; tok_gate[t * 4 + 3] = p3 * inv;
                LAS float* ri = rinfo + tid * 12; ri[0] = rstd;
                ri[1] = __int_as_float(i0); ri[2] = __int_as_float(i1); ri[3] = __int_as_float(i2); ri[4] = __int_as_float(i3);
                ri[5] = __int_as_float(r0); ri[6] = __int_as_float(r1); ri[7] = __int_as_float(r2); ri[8] = __int_as_float(r3);
            }
            LDS_WAIT(); __syncthreads();
            unsigned char* XG = ws + WS_XG;
            for (int rr = 0; rr < 4; ++rr) { const int il = wave * 4 + rr; const LAS float* ri = rinfo + il * 12;
                const float rstd = ri[0];
                size_t dsto[4];
#pragma unroll
                for (int k = 0; k < 4; ++k) dsto[k] = ((size_t)__float_as_int(ri[1 + k]) * T + (size_t)__float_as_int(ri[5 + k])) * D;
                const u32x2* hr = (const u32x2*)((const bf16*)(ws + WS_H1) + (size_t)(row0 + il) * D) + lane;
#pragma unroll
                for (int j = 0; j < 8; ++j) { const u32x2 hb = hr[64 * j]; const f32x4 v = (f32x4){bf_lo(hb.x), bf_hi(hb.x), bf_lo(hb.y), bf_hi(hb.y)}; const f32x4 gg = *((const f32x4*)g2 + lane + 64 * j);
                    const float rs8 = rstd * SC_X8; const unsigned o = pk4_fp8(v.x * rs8 * gg.x, v.y * rs8 * gg.y, v.z * rs8 * gg.z, v.w * rs8 * gg.w);
#pragma unroll
                    for (int k = 0; k < 4; ++k) *((unsigned*)(XG + dsto[k]) + lane + 64 * j) = o; } }
            LDS_WAIT(); __syncthreads();
        }
    }
    xcd_barrier(bar);

    if (tid < NE) MISC[MW_CNT + tid] = __hip_atomic_load(ctl + CW_CNT + 64 * tid, __ATOMIC_RELAXED, __HIP_MEMORY_SCOPE_AGENT);
    LDS_WAIT(); __syncthreads();
    if (tid < 64) {
        const unsigned n = tid < NE ? MISC[MW_CNT + tid] : 0u, mt = (n + 255u) >> 8;
        unsigned so = n, su = mt;
#pragma unroll
        for (int o = 1; o < 32; o <<= 1) { const unsigned a_ = __shfl_up(so, o), b_ = __shfl_up(su, o); if ((tid & 63) >= o) { so += a_; su += b_; } }
        if (tid < NE) { MISC[MW_OFF + tid] = so - n; MISC[MW_US6 + tid] = (su - mt) * 16u; MISC[MW_US7 + tid] = (su - mt) * 8u; }
        if (tid == NE - 1) { MISC[MW_US6 + NE] = su * 16u; MISC[MW_US7 + NE] = su * 8u; }
    }
    LDS_WAIT(); __syncthreads();

    if (PH_ON(6)) {
        pg8::Gemm g{D / 2, D / 2, D / 2};
        constexpr int NSTREAM = 8;
        const bool split = (G == 256);
        SchedMoE<6> S{G, vcu, MISC, (const char*)(ws + WS_XG), (const char*)(ws + WS_WUT), split ? 32 - NSTREAM : 32};
        Epi6 E{a.in[15], ws + WS_ACT};
        if (split && (vcu & 31) >= 32 - NSTREAM) { constexpr int NUP6 = NE * I_UP1, NDN6 = NE * I_DN1, PER = NDN6 / (8 * NSTREAM); static_assert(PER * 8 * NSTREAM == NDN6, "w_down shares");
            const int sidx = (vcu >> 5) * NSTREAM + ((vcu & 31) - (32 - NSTREAM)); moe_convert(a, lds, NUP6 + sidx * PER, NUP6 + (sidx + 1) * PER, wave, lane); __syncthreads(); }
        pg8::gemm_phase<Epi6, SchedMoE<6>, true>(lds, g, S, E);
    }
    xcd_barrier(bar);

    if (PH_ON(7)) {
        pg8::Gemm g{DE / 2, DE / 2, DE / 2};
        SchedMoE<7> S{G, vcu, MISC, (const char*)(ws + WS_ACT), (const char*)(ws + WS_WDT), 32};
        Epi7 E{a.in[17], ws + WS_YM};
        pg8::gemm_phase<Epi7, SchedMoE<7>, true>(lds, g, S, E);
    }
    xcd_barrier(bar);

    if (PH_ON(8)) {
        const unsigned char* YM = ws + WS_YM;
        for (int t = gw; t < T; t += NGW) {
            size_t pos[4]; float gt[4];
#pragma unroll
            for (int k = 0; k < 4; ++k) { const int e = tok_e[t * 4 + k], rk = tok_rank[t * 4 + k]; gt[k] = tok_gate[t * 4 + k]; pos[k] = ((size_t)MISC[MW_OFF + e] + (size_t)rk) * D; }
            f32x4* orow = (f32x4*)(a.out + (size_t)t * D) + lane;
            const u32x2* hrow = (const u32x2*)((const bf16*)(ws + WS_H1) + (size_t)t * D) + lane;
#pragma unroll
            for (int j = 0; j < 8; ++j) { const u32x2 hb = __builtin_nontemporal_load(hrow + 64 * j); f32x4 o = (f32x4){bf_lo(hb.x), bf_hi(hb.x), bf_lo(hb.y), bf_hi(hb.y)};
#pragma unroll
                for (int k = 0; k < 4; ++k) { const int y = (int)__builtin_nontemporal_load((const unsigned*)(YM + pos[k]) + lane + 64 * j);
                    const f32x2 ylo = __builtin_amdgcn_cvt_pk_f32_fp8(y, false), yhi = __builtin_amdgcn_cvt_pk_f32_fp8(y, true); const float gk = gt[k] * (1.f / SC_Y8);
                    o.x += gk * ylo.x; o.y += gk * ylo.y; o.z += gk * yhi.x; o.w += gk * yhi.y; }
                __builtin_nontemporal_store(o, orow + 64 * j); }
        }
    }
#endif
}

extern "C" void kernel_launch(void* const* d_in, const int* in_sizes, int n_in, void* d_out, int out_size, void* d_ws, size_t ws_size, hipStream_t stream) {
    static int grid = 0;
    if (grid == 0) {
        if (n_in != 18 || out_size != T * D || ws_size < WS_END) { fprintf(stderr, "kernel_launch: unexpected shapes (n_in %d, out %d, ws %zu)\n", n_in, out_size, ws_size); grid = -1; return; }
        int dev = 0, cus = 0, per_cu = 0;
        if (hipGetDevice(&dev) != hipSuccess || hipDeviceGetAttribute(&cus, hipDeviceAttributeMultiprocessorCount, dev) != hipSuccess) { grid = -1; return; }
        if (hipFuncSetAttribute((const void*)fwd, hipFuncAttributeMaxDynamicSharedMemorySize, LDS_BYTES) != hipSuccess) { fprintf(stderr, "kernel_launch: hipFuncSetAttribute failed\n"); grid = -1; return; }
        if (hipOccupancyMaxActiveBlocksPerMultiprocessor(&per_cu, (const void*)fwd, NWAVES * 64, LDS_BYTES) != hipSuccess || per_cu < 1) { fprintf(stderr, "kernel_launch: occupancy query says %d\n", per_cu); }
        (void)hipGetLastError();
        grid = cus;
        if (per_cu < 1) grid = -1;
    }
    if (grid < 0) return;
    if (hipMemsetAsync((char*)d_ws + WS_CTL, 0, CTL_ZERO_BYTES, stream) != hipSuccess) return;
    Args a{};
    for (int i = 0; i < 18; ++i) a.in[i] = (const float*)d_in[i];
    a.out = (float*)d_out; a.ws = (unsigned char*)d_ws;
    hipLaunchKernelGGL(fwd, dim3(grid), dim3(NWAVES * 64), LDS_BYTES, stream, a);
}
```

```cpp
#ifndef MOE_TAIL_TEST
#define MOE_TAIL_TEST 0
#endif
#include <hip/hip_runtime.h>
#include <cstdio>
#include <cstdint>

#ifndef DBG_STAGE
#define DBG_STAGE 99
#endif
#ifndef PH_MASK
#define PH_MASK 0x1ff
#endif
#define PH_ON(p) ((PH_MASK >> (p)) & 1)

#define LAS __attribute__((address_space(3)))
#define GAS __attribute__((address_space(1)))
typedef unsigned short bf16;
typedef short bf16x8 __attribute__((ext_vector_type(8)));
typedef float f32x4 __attribute__((ext_vector_type(4)));
typedef float f32x2 __attribute__((ext_vector_type(2)));
typedef float f32x16 __attribute__((ext_vector_type(16)));
typedef unsigned u32x4 __attribute__((ext_vector_type(4)));
typedef unsigned u32x2 __attribute__((ext_vector_type(2)));
typedef int i32x8 __attribute__((ext_vector_type(8)));
typedef int i32x4 __attribute__((ext_vector_type(4)));

constexpr int T = 8192, D = 2048, SEQ = 4096, NH = 8, HD = 128, AW = 1024, SW = 1024, PW = 9216, NE = 32, TOPK = 4, DE = 2048;
constexpr int C_GB_END_BF = 5120;
constexpr int N1 = 7168;
constexpr int C_Q = 0, C_K = 1024, C_U = 2048, C_GA = 3072, C_GB = 5120;
constexpr float EPS = 1e-6f;
constexpr int NWAVES = 8;

constexpr size_t MiB = 1u << 20;
constexpr size_t WS_CTL = 0, CTL_ZERO_BYTES = 64 * 1024;
constexpr size_t WS_W1T = 2 * MiB;
constexpr size_t WS_W2T = 32 * MiB;
constexpr size_t WS_WAT = 40 * MiB;
constexpr size_t WS_WBT = 44 * MiB;
constexpr size_t WS_WOT = 48 * MiB;
constexpr size_t WS_WG8 = 56 * MiB;
constexpr size_t WS_XN = 64 * MiB;
constexpr size_t WS_PB = 96 * MiB;
constexpr size_t WS_VT = 208 * MiB;
constexpr size_t WS_OA = 240 * MiB;
constexpr size_t WS_OB = 256 * MiB;
constexpr size_t WS_QB = 272 * MiB;
constexpr size_t WS_KB = 288 * MiB;
constexpr size_t WS_XN8 = 304 * MiB;
constexpr size_t WS_Y = 336 * MiB;
constexpr size_t WS_ROUTE = 368 * MiB;
constexpr size_t WS_WRH = 368 * MiB + 512 * 1024, WS_WRL = 368 * MiB + 640 * 1024;
constexpr size_t WS_STATS = 369 * MiB;
constexpr size_t WS_ACT = 370 * MiB;
constexpr size_t WS_H1 = 440 * MiB;
constexpr size_t WS_YM = 500 * MiB;
constexpr size_t WS_WUT = 640 * MiB;
constexpr size_t WS_WDT = 1152 * MiB;
constexpr size_t WS_XG = 1408 * MiB;
constexpr size_t WS_END = 2432 * MiB;
constexpr int CW_BAR = 4096;
constexpr int CW_CNT = 8192;
constexpr int CW_STATS = 16384;

constexpr int RING_BYTES = 131072;
constexpr int SCR_OFF = RING_BYTES;
constexpr int MISC_OFF = RING_BYTES + 8192;
constexpr int LDS_BYTES = RING_BYTES + 8192 + 2048;
constexpr int MW_BAR = 8;
constexpr int MW_CNT = 32, MW_OFF = 64, MW_US6 = 96, MW_US7 = 160;

#define LDS_WAIT() asm volatile("s_waitcnt lgkmcnt(0)" ::: "memory")
#define VM_WAIT() asm volatile("s_waitcnt vmcnt(0)" ::: "memory")

__device__ __forceinline__ unsigned cvt_pk_bf16(float lo, float hi) { unsigned r; asm volatile("v_cvt_pk_bf16_f32 %0, %1, %2" : "=v"(r) : "v"(lo), "v"(hi)); return r; }
__device__ __forceinline__ unsigned pk4_fp8(float a, float b, float c, float d) {
    a = __builtin_amdgcn_fmed3f(a, -448.f, 448.f); b = __builtin_amdgcn_fmed3f(b, -448.f, 448.f); c = __builtin_amdgcn_fmed3f(c, -448.f, 448.f); d = __builtin_amdgcn_fmed3f(d, -448.f, 448.f);
    int r = 0; r = __builtin_amdgcn_cvt_pk_fp8_f32(a, b, r, false); r = __builtin_amdgcn_cvt_pk_fp8_f32(c, d, r, true); return (unsigned)r; }
constexpr float SC_W8 = 64.f, SC_X8 = 4.f, SC_A8 = 2.f, SC_XN8 = 16.f, SC_Y8 = 16.f;
__device__ __forceinline__ float bf_lo(unsigned u) { return __uint_as_float(u << 16); }
__device__ __forceinline__ float bf_hi(unsigned u) { return __uint_as_float(u & 0xffff0000u); }
__device__ __forceinline__ float fast_rcp(float x) { return __builtin_amdgcn_rcpf(x); }
__device__ __forceinline__ float sigmoid_f(float x) { return fast_rcp(1.f + __builtin_amdgcn_exp2f(-1.4426950408889634f * x)); }
__device__ __forceinline__ float gelu_tanh_f(float x) { const float in = -2.302208198f * (x + 0.044715f * x * x * x); return x * fast_rcp(1.f + __builtin_amdgcn_exp2f(in)); }
__device__ __forceinline__ float wave_sum(float v) {
#pragma unroll
    for (int o = 1; o < 64; o <<= 1) v += __shfl_xor(v, o);
    return v;
}

namespace pg8 {
constexpr int BM = 256, BK = 64, HALF = 128, HTB = HALF * BK * 2, STAGE_BYTES = 8 * HTB;
__host__ __device__ __forceinline__ int lds_byte(int r, int c) { const int st = (r >> 4) * 2 + (c >> 5), rr = r & 15, cc = c & 31, ob = rr * 64 + cc * 2; return st * 1024 + (ob ^ (((ob >> 9) & 1) << 5)); }
__host__ __device__ __forceinline__ void stage_rc(int b, int& R, int& C) { const int st = b / 1024, sb = b % 1024, swz = sb ^ (((sb >> 9) & 1) << 5); R = (st >> 1) * 16 + swz / 64; C = (st & 1) * 32 + (swz % 64) / 2; }
__host__ __device__ __forceinline__ int perm32(int rho) { const int n = rho >> 4, i = rho & 15; return 8 * (i >> 2) + 4 * n + (i & 3); }

struct Unit { const char* A; const char* B; int kind, pm, pn, e, nvalid, rbase; };
struct Gemm { int lda, ldb, K; };

__device__ __forceinline__ void tile_order(int L, int nM, int nN, int& pm, int& pn) {
    const int nwg = nM * nN; int wgid = L;
    { const int q = nwg / 8, r = nwg % 8, xcd = wgid % 8, off = wgid / 8; wgid = (xcd < r ? xcd * (q + 1) : r * (q + 1) + (xcd - r) * q) + off; }
    const int nig = 8 * nN, gid = wgid / nig, fm = gid * 8, gsz = (nM - fm) < 8 ? (nM - fm) : 8;
    pm = fm + ((wgid % nig) % gsz); pn = (wgid % nig) / gsz;
}

template <class Epi, class Sched, bool F8 = false>
__device__ __forceinline__ void gemm_phase(LAS unsigned char* lds, const Gemm g, const Sched& S, const Epi& E) {
    int tid_ = threadIdx.x; asm volatile("" : "+v"(tid_));
    const int tid = tid_, wid = __builtin_amdgcn_readfirstlane(tid >> 6), lane = tid & 63, wr = wid >> 2, wc = wid & 3, fr = lane & 15, fq = lane >> 4;
    const int K = g.K, nt = K / BK;
    unsigned voffA[2], voffB[2];
#pragma unroll
    for (int i = 0; i < 2; ++i) { int R, C; stage_rc(tid * 16 + i * 8192, R, C); const int Rb = Epi::PERM ? ((R & ~31) + perm32(R & 31)) : R;
        voffA[i] = (unsigned)(R * g.lda + C) * 2u; voffB[i] = (unsigned)(Rb * g.ldb + C) * 2u; }
    const size_t kstep = (size_t)(BK * 2);
    const size_t hstepA = (size_t)HALF * g.lda * 2, hstepB = (size_t)HALF * g.ldb * 2;
    const unsigned ldsw = (unsigned)wid * 1024u;
    const int aoff = lds_byte(wr * 64 + fr, fq * 8), boff = lds_byte(wc * 32 + fr, fq * 8);
#define PG8_SA(b, h) (((b) * 2 + (h)) * HTB)
#define PG8_SB(b, h) ((4 + (b) * 2 + (h)) * HTB)
#define PG8_STAGE(bufoff, gbase, voff) do { _Pragma("unroll") for (int _i = 0; _i < 2; ++_i) \
        __builtin_amdgcn_global_load_lds((const unsigned*)((const char*)(gbase) + (voff)[_i]), (LAS unsigned*)(lds + (bufoff) + ldsw + _i * 8192), 16, 0, 0); } while (0)
#define PG8_LDA(dst, b, h) do { _Pragma("unroll") for (int m = 0; m < 4; ++m) { const i32x4 lo_ = *(const LAS i32x4*)(lds + PG8_SA(b, h) + aoff + m * 2048), hi_ = *(const LAS i32x4*)(lds + PG8_SA(b, h) + aoff + m * 2048 + 1024); \
        dst[m] = __builtin_shufflevector(lo_, hi_, 0, 1, 2, 3, 4, 5, 6, 7); } } while (0)
#define PG8_LDB(dst, b, h) do { _Pragma("unroll") for (int n = 0; n < 2; ++n) { const i32x4 lo_ = *(const LAS i32x4*)(lds + PG8_SB(b, h) + boff + n * 2048), hi_ = *(const LAS i32x4*)(lds + PG8_SB(b, h) + boff + n * 2048 + 1024); \
        dst[n] = __builtin_shufflevector(lo_, hi_, 0, 1, 2, 3, 4, 5, 6, 7); } } while (0)
#define PG8_MMA(ai, bj, At, Bt) do { __builtin_amdgcn_s_setprio(1); _Pragma("unroll") for (int m = 0; m < 4; ++m) _Pragma("unroll") for (int n = 0; n < 2; ++n) { \
        if constexpr (F8) { asm volatile("v_mfma_f32_16x16x128_f8f6f4 %0, %1, %2, %0" : "+v"(acc[ai][bj][m][n]) : "v"(Bt[n]), "v"(At[m])); } \
        else { acc[ai][bj][m][n] = __builtin_amdgcn_mfma_f32_16x16x32_bf16(__builtin_bit_cast(bf16x8, __builtin_shufflevector(Bt[n], Bt[n], 0, 1, 2, 3)), __builtin_bit_cast(bf16x8, __builtin_shufflevector(At[m], At[m], 0, 1, 2, 3)), acc[ai][bj][m][n], 0, 0, 0); \
               acc[ai][bj][m][n] = __builtin_amdgcn_mfma_f32_16x16x32_bf16(__builtin_bit_cast(bf16x8, __builtin_shufflevector(Bt[n], Bt[n], 4, 5, 6, 7)), __builtin_bit_cast(bf16x8, __builtin_shufflevector(At[m], At[m], 4, 5, 6, 7)), acc[ai][bj][m][n], 0, 0, 0); } } \
        __builtin_amdgcn_s_setprio(0); } while (0)
#define PG8_WAIT_V(n) asm volatile("s_waitcnt vmcnt(" #n ")" ::: "memory")
#define PG8_WAIT_L(n) asm volatile("s_waitcnt lgkmcnt(" #n ")" ::: "memory")
#define PG8_BAR __builtin_amdgcn_s_barrier()
#define PG8_SCHED __builtin_amdgcn_sched_barrier(0)
    Unit cur, nxt; int ui = 0;
    if (!S.next(0, cur)) return;
    f32x4 acc[2][2][4][2];
#pragma unroll
    for (int a = 0; a < 2; ++a)
#pragma unroll
        for (int b = 0; b < 2; ++b)
#pragma unroll
            for (int m = 0; m < 4; ++m)
#pragma unroll
                for (int n = 0; n < 2; ++n) acc[a][b][m][n] = (f32x4){0.f, 0.f, 0.f, 0.f};
    i32x8 At[4], B0[2], B1[2];
    const char* cA = cur.A; const char* cB = cur.B;
    PG8_STAGE(PG8_SB(0, 0), cB, voffB); PG8_STAGE(PG8_SB(0, 1), cB + hstepB, voffB); PG8_STAGE(PG8_SA(0, 0), cA, voffA); PG8_STAGE(PG8_SA(0, 1), cA + hstepA, voffA);
    if (wr == 1) PG8_BAR;
    PG8_WAIT_V(2); PG8_BAR;
    PG8_STAGE(PG8_SB(1, 0), cB + kstep, voffB); PG8_STAGE(PG8_SA(1, 0), cA + kstep, voffA); PG8_STAGE(PG8_SB(1, 1), cB + hstepB + kstep, voffB);
    PG8_WAIT_V(6); PG8_BAR;
    for (;;) {
        const bool has_next = S.next(ui + 1, nxt);
        const char* nA = has_next ? nxt.A : cA; const char* nB = has_next ? nxt.B : cB;
        const bool full = cur.nvalid > HALF;
        for (int t = 0; t < nt; t += 2) {
            const bool last = (t == nt - 2);
            const char* a1 = cA + (size_t)(t + 1) * kstep;
            const char* a2 = last ? nA : cA + (size_t)(t + 2) * kstep; const char* b2 = last ? nB : cB + (size_t)(t + 2) * kstep;
            const char* a3 = a2 + kstep; const char* b3 = b2 + kstep;
            PG8_LDB(B0, 0, 0); PG8_LDB(B1, 0, 1); PG8_SCHED; PG8_LDA(At, 0, 0); PG8_STAGE(PG8_SA(1, 1), a1 + hstepA, voffA);
            PG8_WAIT_V(8); PG8_WAIT_L(0); PG8_BAR; PG8_MMA(0, 0, At, B0); PG8_MMA(0, 1, At, B1); PG8_BAR; PG8_SCHED;
            if (!F8 || full) PG8_LDA(At, 0, 1); PG8_STAGE(PG8_SB(0, 0), b2, voffB); PG8_STAGE(PG8_SB(0, 1), b2 + hstepB, voffB); PG8_STAGE(PG8_SA(0, 0), a2, voffA);
            PG8_WAIT_V(8); PG8_WAIT_L(0); PG8_BAR; if (!F8 || full) { PG8_MMA(1, 0, At, B0); PG8_MMA(1, 1, At, B1); } PG8_BAR; PG8_SCHED;
            PG8_LDB(B0, 1, 0); PG8_LDB(B1, 1, 1); PG8_SCHED; PG8_LDA(At, 1, 0); PG8_STAGE(PG8_SA(0, 1), a2 + hstepA, voffA);
            PG8_WAIT_V(8); PG8_WAIT_L(0); PG8_BAR; PG8_MMA(0, 0, At, B0); PG8_MMA(0, 1, At, B1); PG8_BAR; PG8_SCHED;
            if (!F8 || full) PG8_LDA(At, 1, 1); PG8_STAGE(PG8_SB(1, 0), b3, voffB); PG8_STAGE(PG8_SB(1, 1), b3 + hstepB, voffB); PG8_STAGE(PG8_SA(1, 0), a3, voffA);
            PG8_WAIT_V(8); PG8_WAIT_L(0); PG8_BAR; if (!F8 || full) { PG8_MMA(1, 0, At, B0); PG8_MMA(1, 1, At, B1); } PG8_BAR; PG8_SCHED;
        }
        if constexpr (F8) asm volatile("s_nop 15\n\ts_nop 15\n\ts_nop 7" ::: "memory");
        if (wr == 0) PG8_BAR;
        E(acc, cur, wr, wc, fr, fq);
        if (!has_next) break;
        if (!(Epi::CHAIN && cur.kind == 0)) {
#pragma unroll
        for (int a = 0; a < 2; ++a)
#pragma unroll
            for (int b = 0; b < 2; ++b)
#pragma unroll
                for (int m = 0; m < 4; ++m)
#pragma unroll
                    for (int n = 0; n < 2; ++n) acc[a][b][m][n] = (f32x4){0.f, 0.f, 0.f, 0.f};
        }
        cur = nxt; cA = nA; cB = nB; ++ui;
        if (wr == 1) PG8_BAR;
    }
    PG8_WAIT_V(0);
    PG8_BAR;
#undef PG8_SA
#undef PG8_SB
#undef PG8_STAGE
#undef PG8_LDA
#undef PG8_LDB
#undef PG8_MMA
#undef PG8_WAIT_V
#undef PG8_WAIT_L
#undef PG8_BAR
#undef PG8_SCHED
}
}
using pg8::Unit;

#define XB_TMO      128
#define XB_XCNT(j)  (256  + 64 * (j))
#define XB_XSUB(j)  (1280 + 64 * (j))
#define XB_XGEN(j)  (2304 + 64 * (j))
#define XB_TOP      3328
#define XB_TOPGEN   3392
#define XCD_BAR_WORDS 3456
#define XB_SPIN_CAP (1u << 18)
__device__ __forceinline__ unsigned xb_ld(unsigned* p)              { return __hip_atomic_load(p, __ATOMIC_RELAXED, __HIP_MEMORY_SCOPE_AGENT); }
__device__ __forceinline__ unsigned xb_add(unsigned* p, unsigned v) { return __hip_atomic_fetch_add(p, v, __ATOMIC_RELAXED, __HIP_MEMORY_SCOPE_AGENT); }
__device__ __forceinline__ unsigned xb_xcc_id() { return (unsigned)__builtin_amdgcn_s_getreg((3 << 11) | 20) & 0xFu; }
#define XB_SPIN(cond, bar) do { unsigned _sp = 0; while (cond) { __builtin_amdgcn_s_sleep(1); \
    if ((++_sp & 255u) == 0u) { if (xb_ld(&(bar)[XB_TMO])) break; if (_sp > XB_SPIN_CAP) { atomicAdd(&(bar)[XB_TMO], 1u); break; } } } } while (0)
struct XcdBarrier { unsigned* bar; unsigned x; volatile LAS unsigned* st; };
__device__ __forceinline__ XcdBarrier xcd_barrier_post(unsigned* bar, volatile LAS unsigned* st) {
    XcdBarrier b; b.bar = bar; b.x = xb_xcc_id(); b.st = st;
    if (threadIdx.x == 0) (void)xb_add(&bar[XB_XCNT(b.x)], 1u);
    return b;
}
__device__ __forceinline__ void xcd_barrier_complete(unsigned* bar, unsigned x, unsigned& nloc, unsigned& nx) {
    const unsigned G = gridDim.x * gridDim.y * gridDim.z;
    unsigned sum, cnt, mine, sp = 0u;
    for (;;) {
        sum = 0u; cnt = 0u; mine = 0u;
#pragma unroll
        for (unsigned j = 0; j < 16; ++j) { const unsigned c = xb_ld(&bar[XB_XCNT(j)]); sum += c; cnt += (c > 0u) ? 1u : 0u; mine = (j == x) ? c : mine; }
        if (sum == G) break;
        __builtin_amdgcn_s_sleep(1);
        if ((++sp & 255u) == 0u) { if (xb_ld(&bar[XB_TMO])) break; if (sp > XB_SPIN_CAP) { atomicAdd(&bar[XB_TMO], 1u); break; } }
    }
    nloc = mine > 0u ? mine : 1u; nx = cnt > 0u ? cnt : 1u;
}
__device__ __forceinline__ void xcd_barrier(const XcdBarrier& b) {
    asm volatile("s_waitcnt vmcnt(0)" ::: "memory");
    __syncthreads();
    if (threadIdx.x == 0) {
        unsigned* bar = b.bar;
        __builtin_amdgcn_s_waitcnt(0);
        unsigned nloc = b.st[0], nx = b.st[1];
        if (nloc == 0u) { xcd_barrier_complete(bar, b.x, nloc, nx); b.st[0] = nloc; b.st[1] = nx; }
        const unsigned old = xb_add(&bar[XB_XSUB(b.x)], 1u);
        const unsigned gen = old / nloc;
        if (old + 1u == (gen + 1u) * nloc) {
            __builtin_amdgcn_fence(__ATOMIC_RELEASE, "agent");
            asm volatile("s_waitcnt vmcnt(0)" ::: "memory");
            const unsigned og = xb_add(&bar[XB_TOP], 1u);
            const unsigned tg = og / nx;
            if (og + 1u == (tg + 1u) * nx) xb_add(&bar[XB_TOPGEN], 1u);
            else XB_SPIN(xb_ld(&bar[XB_TOPGEN]) == tg, bar);
            __builtin_amdgcn_fence(__ATOMIC_ACQUIRE, "agent");
            xb_add(&bar[XB_XGEN(b.x)], 1u);
            asm volatile("s_waitcnt vmcnt(0)" ::: "memory");
        } else {
            XB_SPIN(xb_ld(&bar[XB_XGEN(b.x)]) == gen, bar);
            __builtin_amdgcn_fence(__ATOMIC_ACQUIRE, "agent");
            asm volatile("s_waitcnt vmcnt(0)" ::: "memory");
        }
    }
    __syncthreads();
}

struct Args { const float* in[18]; float* out; unsigned char* ws; };

constexpr int I_UP1 = (D / 128) * (2 * DE / 32);
constexpr int I_DN1 = (DE / 128) * (D / 32);
constexpr int MOE_ITEMS = NE * (I_UP1 + I_DN1);
struct MoeItem { const float* src; unsigned char* dst; int ldw; };
__device__ __forceinline__ MoeItem moe_item(const Args& a, int r) {
    MoeItem m; unsigned char* ws = a.ws;
    if (r < NE * I_UP1) { const int e = r / I_UP1, q = r % I_UP1; const int nblk = 2 * DE / 32, kb = q / nblk, nb = q % nblk, k0 = kb * 128, n0 = nb * 32;
        const int nn = n0 < DE ? n0 : n0 - DE; const int row = (nn >> 7) * 256 + (nn & 127) + (n0 < DE ? 0 : 128);
        m.src = a.in[14] + ((size_t)e * D + k0) * (2 * DE) + n0; m.ldw = 2 * DE; m.dst = ws + WS_WUT + ((size_t)e * 2 * DE + row) * D + k0; }
    else { r -= NE * I_UP1; const int e = r / I_DN1, q = r % I_DN1; const int nblk = D / 32, kb = q / nblk, nb = q % nblk, k0 = kb * 128, n0 = nb * 32;
        m.src = a.in[16] + ((size_t)e * DE + k0) * D + n0; m.ldw = D; m.dst = ws + WS_WDT + ((size_t)e * D + n0) * DE + k0; }
    return m;
}
__device__ __forceinline__ void moe_load(f32x4 (&v)[16], const MoeItem& m, int lane) {
#pragma unroll
    for (int j = 0; j < 16; ++j) v[j] = __builtin_nontemporal_load((const f32x4*)(m.src + (size_t)(16 * (lane >> 3) + j) * m.ldw + 4 * (lane & 7)));
}
__device__ __forceinline__ void moe_store(const f32x4 (&v)[16], unsigned char* dst, int lane) {
#pragma unroll
    for (int i = 0; i < 4; ++i) { u32x4 o;
        o.x = pk4_fp8(v[0][i] * SC_W8, v[1][i] * SC_W8, v[2][i] * SC_W8, v[3][i] * SC_W8); o.y = pk4_fp8(v[4][i] * SC_W8, v[5][i] * SC_W8, v[6][i] * SC_W8, v[7][i] * SC_W8);
        o.z = pk4_fp8(v[8][i] * SC_W8, v[9][i] * SC_W8, v[10][i] * SC_W8, v[11][i] * SC_W8); o.w = pk4_fp8(v[12][i] * SC_W8, v[13][i] * SC_W8, v[14][i] * SC_W8, v[15][i] * SC_W8);
        __builtin_nontemporal_store(o, (u32x4*)(dst + (size_t)(4 * (lane & 7) + i) * DE + 16 * (lane >> 3))); }
}
__device__ __forceinline__ void moe_convert(const Args& a, LAS unsigned char* lds, int begin, int end, int wave, int lane) {
    int it = begin + wave;
    if (it >= end) return;
    f32x4 cur[16], nxt[16];
    MoeItem mc = moe_item(a, it);
    moe_load(cur, mc, lane);
    for (;;) {
        const int itn = it + NWAVES; const bool more = itn < end;
        MoeItem mn = mc;
        if (more) { mn = moe_item(a, itn); moe_load(nxt, mn, lane); }
        moe_store(cur, mc.dst, lane);
        if (!more) break;
#pragma unroll
        for (int j = 0; j < 16; ++j) cur[j] = nxt[j];
        mc = mn; it = itn;
    }
}

struct P0Item { const float* src; bf16* dst; int ldw, ldt; };
__device__ __forceinline__ P0Item p0_item(const Args& a, int r) {
    constexpr int I_IN = (D / 64) * (C_GB_END_BF / 32), I_A = (AW / 64) * (D / 32);
    unsigned char* ws = a.ws; bf16* W1T = (bf16*)(ws + WS_W1T); bf16* W2T = (bf16*)(ws + WS_W2T);
    P0Item m;
    if (r < I_IN) { const int nblk = C_GB_END_BF / 32, kb = r / nblk, nb = r % nblk, k0 = kb * 64, n0 = nb * 32;
        bf16* dst;
        if (n0 < 2048) dst = W1T + (size_t)n0 * D; else if (n0 < 3072) dst = W2T + (size_t)(n0 - 2048) * D; else if (n0 < 4096) dst = W1T + (size_t)(n0 - 1024) * D;
        else dst = W2T + (size_t)(n0 - 3072) * D;
        m.src = a.in[2] + (size_t)k0 * PW + n0; m.ldw = PW; m.dst = dst + k0; m.ldt = D; return m; }
    r -= I_IN;
    const int nblk = D / 32;
    if (r < I_A) { const int kb2 = r / nblk, nb = r % nblk, k0 = kb2 * 64, n0 = nb * 32; m.src = a.in[8] + (size_t)k0 * D + n0; m.ldw = D; m.dst = (bf16*)(ws + WS_WAT) + (size_t)n0 * AW + k0; m.ldt = AW; return m; }
    r -= I_A;
    if (r < I_A) { const int kb2 = r / nblk, nb = r % nblk, k0 = kb2 * 64, n0 = nb * 32; m.src = a.in[9] + (size_t)k0 * D + n0; m.ldw = D; m.dst = (bf16*)(ws + WS_WBT) + (size_t)n0 * SW + k0; m.ldt = SW; return m; }
    r -= I_A;
    { const int kb2 = r / nblk, nb = r % nblk, k0 = kb2 * 64, n0 = nb * 32; m.src = a.in[10] + (size_t)k0 * D + n0; m.ldw = D; m.dst = (bf16*)(ws + WS_WOT) + (size_t)n0 * D + k0; m.ldt = D; return m; }
}
__device__ __forceinline__ void p0_load(f32x4 (&v)[8], const P0Item& m, int lane) {
#pragma unroll
    for (int j = 0; j < 8; ++j) v[j] = __builtin_nontemporal_load((const f32x4*)(m.src + (size_t)(8 * (lane >> 3) + j) * m.ldw + 4 * (lane & 7)));
}
__device__ __forceinline__ void p0_store(const f32x4 (&v)[8], const P0Item& m, int lane) {
#pragma unroll
    for (int i = 0; i < 4; ++i) { u32x4 o; o.x = cvt_pk_bf16(v[0][i], v[1][i]); o.y = cvt_pk_bf16(v[2][i], v[3][i]); o.z = cvt_pk_bf16(v[4][i], v[5][i]); o.w = cvt_pk_bf16(v[6][i], v[7][i]);
        *(u32x4*)(m.dst + (size_t)(4 * (lane & 7) + i) * m.ldt + 8 * (lane >> 3)) = o; }
}
__device__ __forceinline__ void p0_prologue(const Args& a, LAS unsigned char* lds, int vcu, int G, int wave, int lane) {
    unsigned char* ws = a.ws;
    const int gw = vcu * NWAVES + wave, NGW = G * NWAVES;
    constexpr int NITEMS = (D / 64) * (C_GB_END_BF / 32) + 2 * (AW / 64) * (D / 32) + (D / 64) * (D / 32);
    for (int it = gw; it < (D / 128) * ((PW - C_GB_END_BF) / 32); it += NGW) { const int nblk = (PW - C_GB_END_BF) / 32, kb = it / nblk, nb = it % nblk;
        MoeItem m; m.src = a.in[2] + (size_t)(kb * 128) * PW + C_GB_END_BF + nb * 32; m.ldw = PW; m.dst = ws + WS_WG8 + (size_t)(nb * 32) * D + kb * 128;
        f32x4 v[16]; moe_load(v, m, lane); moe_store(v, m.dst, lane); }
    if (gw < NITEMS) {
        int it = gw; f32x4 cur[8], nxt[8]; P0Item mc = p0_item(a, it); p0_load(cur, mc, lane);
        for (;;) { const int itn = it + NGW; const bool more = itn < NITEMS; P0Item mn = mc;
            if (more) { mn = p0_item(a, itn); p0_load(nxt, mn, lane); }
            p0_store(cur, mc, lane);
            if (!more) break;
#pragma unroll
            for (int j = 0; j < 8; ++j) cur[j] = nxt[j];
            mc = mn; it = itn; }
    }
    for (int idx = gw * 64 + lane; idx < NE * D; idx += NGW * 64) { const int e = idx / D, k = idx % D;
        const float wg = a.in[12][(size_t)k * NE + e] * a.in[11][k];
        const unsigned hb = cvt_pk_bf16(wg, 0.f) & 0xffffu; const float hf = __uint_as_float(hb << 16);
        ((bf16*)(ws + WS_WRH))[idx] = (bf16)hb; ((bf16*)(ws + WS_WRL))[idx] = (bf16)(cvt_pk_bf16(wg - hf, 0.f) & 0xffffu); }
    const float* g1 = a.in[1];
    if (gw < T) {
        int m = gw; f32x4 v[8], vn[8];
        { const f32x4* xr = (const f32x4*)(a.in[0] + (size_t)m * D) + lane;
#pragma unroll
          for (int j = 0; j < 8; ++j) v[j] = __builtin_nontemporal_load(xr + 64 * j); }
        for (;;) { const int mn = m + NGW; const bool more = mn < T;
            if (more) { const f32x4* xr = (const f32x4*)(a.in[0] + (size_t)mn * D) + lane;
#pragma unroll
                for (int j = 0; j < 8; ++j) vn[j] = __builtin_nontemporal_load(xr + 64 * j); }
            float s = 0.f;
#pragma unroll
            for (int j = 0; j < 8; ++j) s += (v[j].x * v[j].x + v[j].y * v[j].y) + (v[j].z * v[j].z + v[j].w * v[j].w);
            const float rstd = rsqrtf(wave_sum(s) * (1.f / D) + EPS);
            u32x2* o8 = (u32x2*)((bf16*)(ws + WS_XN) + (size_t)m * D) + lane; unsigned* o4 = (unsigned*)(ws + WS_XN8 + (size_t)m * D) + lane;
#pragma unroll
            for (int j = 0; j < 8; ++j) { const f32x4 gg = *((const f32x4*)g1 + lane + 64 * j);
                const float y0 = v[j].x * rstd * gg.x, y1 = v[j].y * rstd * gg.y, y2 = v[j].z * rstd * gg.z, y3 = v[j].w * rstd * gg.w;
                u32x2 o; o.x = cvt_pk_bf16(y0, y1); o.y = cvt_pk_bf16(y2, y3); o8[64 * j] = o;
                o4[64 * j] = pk4_fp8(y0 * SC_XN8, y1 * SC_XN8, y2 * SC_XN8, y3 * SC_XN8); }
            if (!more) break;
#pragma unroll
            for (int j = 0; j < 8; ++j) v[j] = vn[j];
            m = mn; }
    }
}

struct Epi1 {
    static constexpr bool PERM = true, CHAIN = false;
    bf16* PB; bf16* VT; bf16* QB; bf16* KB; float* stats; const float* gq; const float* gk; LAS float* scr;
    __device__ __forceinline__ void operator()(f32x4 (&acc)[2][2][4][2], const Unit& u, int wr, int wc, int fr, int fq) const {
        if (u.kind == 0) {
            const int pn = u.pn;
            bf16* base = PB + (size_t)(u.pm * 256 + wr * 64 + fr) * N1 + pn * 256 + wc * 32 + 8 * fq;
            if (pn < 8) {
#pragma unroll
                for (int ai = 0; ai < 2; ++ai)
#pragma unroll
                    for (int m = 0; m < 4; ++m)
#pragma unroll
                        for (int bj = 0; bj < 2; ++bj) { const f32x4 x0 = acc[ai][bj][m][0], x1 = acc[ai][bj][m][1];
                            float s = (x0.x * x0.x + x0.y * x0.y) + (x0.z * x0.z + x0.w * x0.w) + (x1.x * x1.x + x1.y * x1.y) + (x1.z * x1.z + x1.w * x1.w);
                            s += __shfl_xor(s, 16); s += __shfl_xor(s, 32);
                            if (fq == 0) scr[(ai * 128 + wr * 64 + m * 16 + fr) * 8 + bj * 4 + wc] = s; }
                LDS_WAIT(); __builtin_amdgcn_s_barrier(); asm volatile("" ::: "memory");
                const float* gn = (pn < 4) ? gq : gk; const float sc = (pn < 4) ? 0.12751743082459868f : 1.f;
                const f32x4 g0 = *(const f32x4*)(gn + wc * 32 + 8 * fq), g1 = *(const f32x4*)(gn + wc * 32 + 8 * fq + 4);
                bf16* qkb = (pn < 4 ? QB : KB) + ((size_t)(((u.pm * 256) >> 12) * NH + (pn & 3) * 2) * SEQ + ((u.pm * 256) & (SEQ - 1)) + wr * 64 + fr) * HD + wc * 32 + 8 * fq;
#pragma unroll
                for (int ai = 0; ai < 2; ++ai)
#pragma unroll
                    for (int m = 0; m < 4; ++m) { const int row = ai * 128 + wr * 64 + m * 16 + fr;
#pragma unroll
                        for (int bj = 0; bj < 2; ++bj) { const f32x4 p = *(const LAS f32x4*)(scr + row * 8 + bj * 4);
                            const float rinv = rsqrtf(((p.x + p.y) + (p.z + p.w)) * (1.f / HD) + EPS) * sc;
                            const f32x4 v0 = acc[ai][bj][m][0] * rinv * g0, v1 = acc[ai][bj][m][1] * rinv * g1;
                            u32x4 w; w.x = cvt_pk_bf16(v0.x, v0.y); w.y = cvt_pk_bf16(v0.z, v0.w); w.z = cvt_pk_bf16(v1.x, v1.y); w.w = cvt_pk_bf16(v1.z, v1.w);
                            *(u32x4*)(qkb + (size_t)(ai * 128 + m * 16) * HD + (size_t)bj * SEQ * HD) = w; } __builtin_amdgcn_sched_barrier(0); }
                LDS_WAIT();
            } else {
#pragma unroll
                for (int ai = 0; ai < 2; ++ai)
#pragma unroll
                    for (int m = 0; m < 4; ++m)
#pragma unroll
                        for (int bj = 0; bj < 2; ++bj) { f32x4 v0 = acc[ai][bj][m][0], v1 = acc[ai][bj][m][1];
#pragma unroll
                            for (int j = 0; j < 4; ++j) { v0[j] = gelu_tanh_f(v0[j]); v1[j] = gelu_tanh_f(v1[j]); }
                            u32x4 w; w.x = cvt_pk_bf16(v0.x, v0.y); w.y = cvt_pk_bf16(v0.z, v0.w); w.z = cvt_pk_bf16(v1.x, v1.y); w.w = cvt_pk_bf16(v1.z, v1.w);
                            *(u32x4*)(base + (size_t)(ai * 128 + m * 16) * N1 + bj * 128) = w; __builtin_amdgcn_sched_barrier(0); }
            }
        } else {
            const bool is_vv = u.pm >= 4;
            bf16* vtb = VT + ((((size_t)(((u.pn * 256) >> 12) * 16 + u.pm * 2) * 128 + (((u.pn * 256) & (SEQ - 1)) >> 5) + wc) * 128 + wr * 64 + fr) * 32 + 8 * fq);
            if (is_vv) {
#pragma unroll
                for (int bj = 0; bj < 2; ++bj)
#pragma unroll
                    for (int n = 0; n < 2; ++n) { f32x4 s = (f32x4){0.f, 0.f, 0.f, 0.f}, q = s;
#pragma unroll
                        for (int ai = 0; ai < 2; ++ai)
#pragma unroll
                            for (int m = 0; m < 4; ++m) { f32x4 x = acc[ai][bj][m][n];
#pragma unroll
                                for (int j = 0; j < 4; ++j) x[j] = gelu_tanh_f(x[j]);
                                s += x; q += x * x; }
#pragma unroll
                        for (int o = 1; o < 16; o <<= 1) {
#pragma unroll
                            for (int j = 0; j < 4; ++j) { s[j] += __shfl_xor(s[j], o); q[j] += __shfl_xor(q[j], o); } }
                        if (fr == 0) { const int slot = (u.pm - 4) * 2 + wr; float* sp = stats + ((size_t)(u.pn * 256 + bj * 128 + wc * 32 + 8 * fq + 4 * n) * 8 + slot) * 2;
#pragma unroll
                            for (int j = 0; j < 4; ++j) *(f32x2*)(sp + 16 * j) = (f32x2){s[j], q[j]}; }
                        __builtin_amdgcn_sched_barrier(0); }
            }
#pragma unroll
            for (int ai = 0; ai < 2; ++ai)
#pragma unroll
                for (int m = 0; m < 4; ++m)
#pragma unroll
                    for (int bj = 0; bj < 2; ++bj) { f32x4 v0 = acc[ai][bj][m][0], v1 = acc[ai][bj][m][1];
                        if (is_vv) {
#pragma unroll
                            for (int j = 0; j < 4; ++j) { v0[j] = gelu_tanh_f(v0[j]); v1[j] = gelu_tanh_f(v1[j]); } }
                        u32x4 w; w.x = cvt_pk_bf16(v0.x, v0.y); w.y = cvt_pk_bf16(v0.z, v0.w); w.z = cvt_pk_bf16(v1.x, v1.y); w.w = cvt_pk_bf16(v1.z, v1.w);
                        *(u32x4*)(vtb + (size_t)ai * (128 * 128 * 32) + bj * (4 * 128 * 32) + m * (16 * 32)) = w; __builtin_amdgcn_sched_barrier(0); }
        }
    }
};
struct Sched1 {
    int G, c; const char* XN; const char* W1T; const char* W2T;
    __device__ __forceinline__ bool next(int i, Unit& u) const {
        const int L = i * G + c; if (L >= 640) return false;
        u.e = 0; u.nvalid = 256; u.rbase = 0;
        if (L < 384) { pg8::tile_order(L, 32, 12, u.pm, u.pn); u.kind = 0; u.A = XN + (size_t)u.pm * 256 * D * 2; u.B = W1T + (size_t)u.pn * 256 * D * 2; }
        else { pg8::tile_order(L - 384, 8, 32, u.pm, u.pn); u.kind = 1; u.A = W2T + (size_t)u.pm * 256 * D * 2; u.B = XN + (size_t)u.pn * 256 * D * 2; }
        return true;
    }
};
struct Epi1g {
    static constexpr bool PERM = true, CHAIN = false;
    bf16* PB;
    __device__ __forceinline__ void operator()(f32x4 (&acc)[2][2][4][2], const Unit& u, int wr, int wc, int fr, int fq) const {
        constexpr float ds = 1.f / (SC_XN8 * SC_W8);
        bf16* base = PB + (size_t)(u.pm * 256 + wr * 64 + fr) * N1 + C_GA + u.pn * 256 + wc * 32 + 8 * fq;
#pragma unroll
        for (int ai = 0; ai < 2; ++ai)
#pragma unroll
            for (int m = 0; m < 4; ++m)
#pragma unroll
                for (int bj = 0; bj < 2; ++bj) { f32x4 v0 = acc[ai][bj][m][0] * ds, v1 = acc[ai][bj][m][1] * ds;
#pragma unroll
                    for (int j = 0; j < 4; ++j) { v0[j] = sigmoid_f(v0[j]); v1[j] = sigmoid_f(v1[j]); }
                    u32x4 w; w.x = cvt_pk_bf16(v0.x, v0.y); w.y = cvt_pk_bf16(v0.z, v0.w); w.z = cvt_pk_bf16(v1.x, v1.y); w.w = cvt_pk_bf16(v1.z, v1.w);
                    *(u32x4*)(base + (size_t)(ai * 128 + m * 16) * N1 + bj * 128) = w; __builtin_amdgcn_sched_barrier(0); }
    }
};
struct Sched1g {
    int G, c; const char* XN8; const char* WG8;
    __device__ __forceinline__ bool next(int i, Unit& u) const {
        const int L = i * G + c; if (L >= 512) return false;
        u.e = 0; u.nvalid = 256; u.rbase = 0; u.kind = 0;
        pg8::tile_order(L, 32, 16, u.pm, u.pn); u.A = XN8 + (size_t)u.pm * 256 * D; u.B = WG8 + (size_t)u.pn * 256 * D;
        return true;
    }
};

__device__ __forceinline__ void attn_task(const bf16* QB, const bf16* KB, const bf16* VT, bf16* OA, int task, int lane) {
    const int bh = task >> 7, qb = task & 127, b = bh >> 3, h = bh & 7;
    const int c = lane & 31, hh = lane >> 5;
    const size_t tokbase = (size_t)b * SEQ;
    const int t0 = qb * 32;
    bf16x8 qf[8];
    { const bf16* qp = QB + ((size_t)bh * SEQ + t0 + c) * HD + 8 * hh;
#pragma unroll
      for (int s = 0; s < 8; ++s) qf[s] = *(const bf16x8*)(qp + 16 * s); }
    f32x16 o[4];
#pragma unroll
    for (int d = 0; d < 4; ++d)
#pragma unroll
        for (int r = 0; r < 16; ++r) o[d][r] = 0.f;
    float crun = 0.f;
    const int kap = 16 * ((c >> 2) & 1) + 4 * (c >> 3) + (c & 3);
    const bf16* kp0 = KB + ((size_t)bh * SEQ + kap) * HD + 8 * hh;
    const bf16* vp0 = VT + ((size_t)(b * 16 + h) * 128 * 128 + c) * 32 + 16 * hh;
    bf16x8 kf[8];
#pragma unroll
    for (int s = 0; s < 8; ++s) kf[s] = *(const bf16x8*)(kp0 + (size_t)t0 * HD + 16 * s);
    for (int j = qb; j >= 0; --j) {
        const int kbase = j * 32;
        bf16x8 vf[4][2];
#pragma unroll
        for (int d = 0; d < 4; ++d)
#pragma unroll
            for (int s = 0; s < 2; ++s) vf[d][s] = *(const bf16x8*)(vp0 + (size_t)j * 4096 + d * 1024 + 8 * s);
        f32x16 S;
#pragma unroll
        for (int r = 0; r < 16; ++r) S[r] = 0.f;
#pragma unroll
        for (int s = 0; s < 8; ++s) S = __builtin_amdgcn_mfma_f32_32x32x16_bf16(kf[s], qf[s], S, 0, 0, 0);
        if (j > 0) {
#pragma unroll
            for (int s = 0; s < 8; ++s) kf[s] = *(const bf16x8*)(kp0 + (size_t)(kbase - 32) * HD + 16 * s);
        }
        const int tq = t0 + c, k0 = kbase + 16 * hh;
        float Lk[16], run = 0.f;
        if (j == qb) {
#pragma unroll
            for (int r = 0; r < 16; ++r) { const float z = S[r]; const float sp = fmaxf(z, 0.f) + __builtin_amdgcn_logf(1.f + __builtin_amdgcn_exp2f(-fabsf(z)));
                const bool past = (k0 + r) < tq; Lk[r] = past ? -sp : 0.f; S[r] = past ? z : -1e30f; run += Lk[r]; }
        } else {
#pragma unroll
            for (int r = 0; r < 16; ++r) { const float z = S[r]; const float sp = fmaxf(z, 0.f) + __builtin_amdgcn_logf(1.f + __builtin_amdgcn_exp2f(-fabsf(z))); Lk[r] = -sp; run += Lk[r]; }
        }
        const float other = __shfl_xor(run, 32);
        float acc_after = crun + (hh == 0 ? other : 0.f);
        float w[16];
#pragma unroll
        for (int r = 15; r >= 0; --r) { w[r] = __builtin_amdgcn_exp2f((S[r] + Lk[r]) + acc_after); acc_after += Lk[r]; }
        crun += run + other;
        bf16x8 pf[2];
#pragma unroll
        for (int s = 0; s < 2; ++s) { u32x4 pk; pk.x = cvt_pk_bf16(w[8 * s + 0], w[8 * s + 1]); pk.y = cvt_pk_bf16(w[8 * s + 2], w[8 * s + 3]); pk.z = cvt_pk_bf16(w[8 * s + 4], w[8 * s + 5]); pk.w = cvt_pk_bf16(w[8 * s + 6], w[8 * s + 7]);
            pf[s] = __builtin_bit_cast(bf16x8, pk); }
#pragma unroll
        for (int d = 0; d < 4; ++d)
#pragma unroll
            for (int s = 0; s < 2; ++s) o[d] = __builtin_amdgcn_mfma_f32_32x32x16_bf16(vf[d][s], pf[s], o[d], 0, 0, 0);
        if (__all(crun < -151.f)) break;
    }
    bf16* op = OA + (tokbase + t0 + c) * AW + h * HD + 4 * hh;
#pragma unroll
    for (int d = 0; d < 4; ++d)
#pragma unroll
        for (int g = 0; g < 4; ++g) { u32x2 pk; pk.x = cvt_pk_bf16(o[d][4 * g + 0], o[d][4 * g + 1]); pk.y = cvt_pk_bf16(o[d][4 * g + 2], o[d][4 * g + 3]);
            *(u32x2*)(op + d * 32 + 8 * g) = pk; }
}

__device__ __forceinline__ void sgu_task(const Args& a, const bf16* PB, const bf16* VT, const float* stats, bf16* OB, int idx, int lane) {
    const int ib = idx & 3, g = (idx >> 2) & 7, n = idx >> 5;
    const int c = lane & 31, hh = lane >> 5;
    const float* wsp = a.in[6] + ((size_t)g * 128 + ib * 32 + c) * 128 + 8 * hh;
    const bf16* vvp = VT + (((size_t)((n >> 5) * 16 + 8 + g) * 128 + (n & 31) * 4) * 128 + c) * 32 + 8 * hh;
    f32x16 acc[4];
#pragma unroll
    for (int d = 0; d < 4; ++d)
#pragma unroll
        for (int r = 0; r < 16; ++r) acc[d][r] = 0.f;
    const int nks = ib < 2 ? 4 : 8;
    for (int ks = 0; ks < nks; ++ks) {
        float mu[8], rs[8];
        { const f32x4 st = *(const f32x4*)(stats + ((size_t)(n * 128 + 16 * ks + (lane >> 2)) * 8 + 2 * (lane & 3)) * 2);
          float S = st.x + st.z, Q = st.y + st.w;
          S += __shfl_xor(S, 1); Q += __shfl_xor(Q, 1); S += __shfl_xor(S, 2); Q += __shfl_xor(Q, 2);
          const float m_ = S * (1.f / SW), r_ = rsqrtf(fmaxf(Q * (1.f / SW) - m_ * m_, 0.f) + EPS);
#pragma unroll
          for (int j = 0; j < 8; ++j) { mu[j] = __shfl(m_, 4 * (8 * hh + j)); rs[j] = __shfl(r_, 4 * (8 * hh + j)); } }
        const f32x4 w0 = *(const f32x4*)(wsp + 16 * ks), w1 = *(const f32x4*)(wsp + 16 * ks + 4);
        u32x4 bw; bw.x = cvt_pk_bf16(w0.x, w0.y); bw.y = cvt_pk_bf16(w0.z, w0.w); bw.z = cvt_pk_bf16(w1.x, w1.y); bw.w = cvt_pk_bf16(w1.z, w1.w);
        const bf16x8 bfrag = __builtin_bit_cast(bf16x8, bw);
#pragma unroll
        for (int cbk = 0; cbk < 4; ++cbk) {
            const u32x4 raw = *(const u32x4*)(vvp + (size_t)(ks >> 1) * 4096 + cbk * 1024 + 16 * (ks & 1));
            u32x4 nv;
            nv.x = cvt_pk_bf16((bf_lo(raw.x) - mu[0]) * rs[0], (bf_hi(raw.x) - mu[1]) * rs[1]);
            nv.y = cvt_pk_bf16((bf_lo(raw.y) - mu[2]) * rs[2], (bf_hi(raw.y) - mu[3]) * rs[3]);
            nv.z = cvt_pk_bf16((bf_lo(raw.z) - mu[4]) * rs[4], (bf_hi(raw.z) - mu[5]) * rs[5]);
            nv.w = cvt_pk_bf16((bf_lo(raw.w) - mu[6]) * rs[6], (bf_hi(raw.w) - mu[7]) * rs[7]);
            acc[cbk] = __builtin_amdgcn_mfma_f32_32x32x16_bf16(__builtin_bit_cast(bf16x8, nv), bfrag, acc[cbk], 0, 0, 0);
        }
    }
    const int tok = n * 128 + ib * 32 + c;
    const float bsp = a.in[7][g * 128 + ib * 32 + c];
    const float* gam = a.in[5] + g * 128 + 4 * hh;
    const bf16* up = PB + (size_t)tok * N1 + C_U + g * 128 + 4 * hh;
    bf16* op = OB + (size_t)tok * SW + g * 128 + 4 * hh;
#pragma unroll
    for (int d = 0; d < 4; ++d)
#pragma unroll
        for (int gg = 0; gg < 4; ++gg) { const f32x4 gm = *(const f32x4*)(gam + d * 32 + 8 * gg); const u32x2 uu = *(const u32x2*)(up + d * 32 + 8 * gg);
            const float r0 = bf_lo(uu.x) * (gm.x * acc[d][4 * gg + 0] + bsp), r1 = bf_hi(uu.x) * (gm.y * acc[d][4 * gg + 1] + bsp);
            const float r2 = bf_lo(uu.y) * (gm.z * acc[d][4 * gg + 2] + bsp), r3 = bf_hi(uu.y) * (gm.w * acc[d][4 * gg + 3] + bsp);
            u32x2 pk; pk.x = cvt_pk_bf16(r0, r1); pk.y = cvt_pk_bf16(r2, r3); *(u32x2*)(op + d * 32 + 8 * gg) = pk; }
}

struct Epi3 {
    static constexpr bool PERM = true, CHAIN = true;
    const bf16* PB; bf16* Y;
    __device__ __forceinline__ void operator()(f32x4 (&acc)[2][2][4][2], const Unit& u, int wr, int wc, int fr, int fq) const {
        const int row0 = u.pm * 256 + wr * 64 + fr, col0 = u.pn * 256 + wc * 32 + 8 * fq;
        const bf16* gpa = PB + (size_t)row0 * N1 + C_GA + col0; const bf16* gpb = PB + (size_t)row0 * N1 + C_GB + col0;
#pragma unroll
        for (int ai = 0; ai < 2; ++ai)
#pragma unroll
            for (int m = 0; m < 4; ++m)
#pragma unroll
                for (int bj = 0; bj < 2; ++bj) { const size_t ro = (size_t)(ai * 128 + m * 16);
                    const u32x4 gb = *(const u32x4*)(gpb + ro * N1 + bj * 128);
                    f32x4 b0, b1;
                    b0.x = fmaxf(bf_lo(gb.x), 1e-20f); b0.y = fmaxf(bf_hi(gb.x), 1e-20f); b0.z = fmaxf(bf_lo(gb.y), 1e-20f); b0.w = fmaxf(bf_hi(gb.y), 1e-20f);
                    b1.x = fmaxf(bf_lo(gb.z), 1e-20f); b1.y = fmaxf(bf_hi(gb.z), 1e-20f); b1.z = fmaxf(bf_lo(gb.w), 1e-20f); b1.w = fmaxf(bf_hi(gb.w), 1e-20f);
                    if (u.kind == 0) {
                        const u32x4 ga = *(const u32x4*)(gpa + ro * N1 + bj * 128);
                        f32x4 r0, r1;
                        r0.x = bf_lo(ga.x) * fast_rcp(b0.x); r0.y = bf_hi(ga.x) * fast_rcp(b0.y); r0.z = bf_lo(ga.y) * fast_rcp(b0.z); r0.w = bf_hi(ga.y) * fast_rcp(b0.w);
                        r1.x = bf_lo(ga.z) * fast_rcp(b1.x); r1.y = bf_hi(ga.z) * fast_rcp(b1.y); r1.z = bf_lo(ga.w) * fast_rcp(b1.z); r1.w = bf_hi(ga.w) * fast_rcp(b1.w);
                        acc[ai][bj][m][0] *= r0; acc[ai][bj][m][1] *= r1;
                    } else {
                        const f32x4 v0 = acc[ai][bj][m][0] * b0, v1 = acc[ai][bj][m][1] * b1;
                        u32x4 w; w.x = cvt_pk_bf16(v0.x, v0.y); w.y = cvt_pk_bf16(v0.z, v0.w); w.z = cvt_pk_bf16(v1.x, v1.y); w.w = cvt_pk_bf16(v1.z, v1.w);
                        *(u32x4*)(Y + (size_t)(row0 + ro) * D + col0 + bj * 128) = w; } }
    }
};
struct Sched3 {
    int G, c; const char* OA; const char* OB; const char* WAT; const char* WBT;
    __device__ __forceinline__ bool next(int i, Unit& u) const {
        const int tile = c + (i >> 1) * G; if (tile >= 256) return false;
        pg8::tile_order(tile, 32, 8, u.pm, u.pn); u.kind = i & 1; u.e = 0; u.nvalid = 256; u.rbase = 0;
        u.A = (u.kind == 0 ? OA : OB) + (size_t)u.pm * 256 * AW * 2; u.B = (u.kind == 0 ? WAT : WBT) + (size_t)u.pn * 256 * AW * 2;
        return true;
    }
};

struct Epi4 {
    static constexpr bool PERM = true, CHAIN = false;
    const float* X; bf16* H1;
    __device__ __forceinline__ void operator()(f32x4 (&acc)[2][2][4][2], const Unit& u, int wr, int wc, int fr, int fq) const {
        const size_t o0 = (size_t)(u.pm * 256 + wr * 64 + fr) * D + u.pn * 256 + wc * 32 + 8 * fq;
#pragma unroll
        for (int ai = 0; ai < 2; ++ai)
#pragma unroll
            for (int m = 0; m < 4; ++m)
#pragma unroll
                for (int bj = 0; bj < 2; ++bj) { const size_t o = o0 + (size_t)(ai * 128 + m * 16) * D + bj * 128;
                    const f32x4 v0 = *(const f32x4*)(X + o) + acc[ai][bj][m][0], v1 = *(const f32x4*)(X + o + 4) + acc[ai][bj][m][1];
                    u32x4 w; w.x = cvt_pk_bf16(v0.x, v0.y); w.y = cvt_pk_bf16(v0.z, v0.w); w.z = cvt_pk_bf16(v1.x, v1.y); w.w = cvt_pk_bf16(v1.z, v1.w);
                    *(u32x4*)(H1 + o) = w; }
    }
};
struct Sched4 {
    int G, c; const char* Y; const char* WOT;
    __device__ __forceinline__ bool next(int i, Unit& u) const {
        const int tile = c + i * G; if (tile >= 256) return false;
        pg8::tile_order(tile, 32, 8, u.pm, u.pn); u.kind = 0; u.e = 0; u.nvalid = 256; u.rbase = 0;
        u.A = Y + (size_t)u.pm * 256 * D * 2; u.B = WOT + (size_t)u.pn * 256 * D * 2;
        return true;
    }
};

template <int PH> struct SchedMoE {
    int G, vcu; const volatile LAS unsigned* misc; const char* Abase; const char* Bbase; int ncu;
    __device__ __forceinline__ bool next(int i, Unit& u) const {
        const volatile LAS unsigned* us = misc + (PH == 6 ? MW_US6 : MW_US7);
        const int total = __builtin_amdgcn_readfirstlane((int)us[NE]);
        int L;
        if ((G & 255) == 0) { const int nx = G >> 5, chunk = (total + nx - 1) / nx, x = vcu >> 5, j = vcu & 31;
            if (ncu == 32) { L = x * chunk + i * 32 + j; if (L >= (x + 1) * chunk) return false; }
            else {
                int len = total - x * chunk; len = len < 0 ? 0 : (len > chunk ? chunk : len);
                const int R = len / ncu - MOE_TAIL_TEST;
                if (j < ncu) { if (i >= R) return false; L = x * chunk + i * ncu + j; }
                else { const int p = i * (32 - ncu) + (j - ncu); if (p >= len - R * ncu) return false; L = x * chunk + R * ncu + p; } } }
        else L = i * G + vcu;
        if (L >= total) return false;
        const int ln = (int)(threadIdx.x & 63);
        const unsigned mine = us[ln < NE ? ln : NE];
        const unsigned long long mk = __ballot((unsigned)L >= mine);
        const int e = __builtin_amdgcn_readfirstlane(63 - __builtin_clzll(mk | 1ull));
        const int ne = __builtin_amdgcn_readfirstlane((int)misc[MW_CNT + e]), off = __builtin_amdgcn_readfirstlane((int)misc[MW_OFF + e]);
        const int st = __builtin_amdgcn_readfirstlane((int)us[e]);
        const int mte = (ne + 255) >> 8, rem = L - st, mt = rem % mte, ntl = rem / mte;
        u.kind = 0; u.pm = mt; u.pn = ntl; u.e = e; u.nvalid = ne - mt * 256; u.rbase = off + mt * 256;
        if (PH == 6) { u.A = Abase + ((size_t)e * T + (size_t)mt * 256) * D; u.B = Bbase + ((size_t)e * 2 * DE + (size_t)ntl * 256) * D; }
        else { u.A = Abase + (size_t)u.rbase * DE; u.B = Bbase + ((size_t)e * D + (size_t)ntl * 256) * DE; }
        return true;
    }
};
__device__ __forceinline__ f32x2 swiglu_pk(f32x2 g, f32x2 u) {
    const f32x2 ga = __builtin_elementwise_min(g, (f32x2){7.f, 7.f});
    const f32x2 ua = __builtin_elementwise_min(__builtin_elementwise_max(u, (f32x2){-7.f, -7.f}), (f32x2){7.f, 7.f});
    const f32x2 t = ga * (-1.702f * 1.4426950408889634f);
    f32x2 d; d.x = __builtin_amdgcn_exp2f(t.x); d.y = __builtin_amdgcn_exp2f(t.y); d = d + 1.0f;
    f32x2 r; r.x = __builtin_amdgcn_rcpf(d.x); r.y = __builtin_amdgcn_rcpf(d.y);
    return (ga * r) * (ua * SC_A8 + SC_A8);
}
__device__ __forceinline__ unsigned pk4_fp8_nc(float a, float b, float c, float d) { int r = 0; r = __builtin_amdgcn_cvt_pk_fp8_f32(a, b, r, false); r = __builtin_amdgcn_cvt_pk_fp8_f32(c, d, r, true); return (unsigned)r; }
struct Epi6 {
    static constexpr bool PERM = true, CHAIN = false;
    const float* bup; unsigned char* ACT;
    __device__ __forceinline__ void operator()(f32x4 (&acc)[2][2][4][2], const Unit& u, int wr, int wc, int fr, int fq) const {
        const int cc = u.pn * 128 + wc * 32 + 8 * fq;
        const float* bg = bup + (size_t)u.e * 2 * DE + cc;
        const f32x4 bg0 = *(const f32x4*)bg, bg1 = *(const f32x4*)(bg + 4), bu0 = *(const f32x4*)(bg + DE), bu1 = *(const f32x4*)(bg + DE + 4);
        constexpr float ds = 1.f / (SC_W8 * SC_X8);
#pragma unroll
        for (int ai = 0; ai < 2; ++ai)
#pragma unroll
            for (int m = 0; m < 4; ++m) { const int row = ai * 128 + wr * 64 + m * 16 + fr;
                const f32x4 g0 = acc[ai][0][m][0] * ds + bg0, g1 = acc[ai][0][m][1] * ds + bg1, u0 = acc[ai][1][m][0] * ds + bu0, u1 = acc[ai][1][m][1] * ds + bu1;
                const f32x2 a0 = swiglu_pk((f32x2){g0.x, g0.y}, (f32x2){u0.x, u0.y}), a1 = swiglu_pk((f32x2){g0.z, g0.w}, (f32x2){u0.z, u0.w});
                const f32x2 a2 = swiglu_pk((f32x2){g1.x, g1.y}, (f32x2){u1.x, u1.y}), a3 = swiglu_pk((f32x2){g1.z, g1.w}, (f32x2){u1.z, u1.w});
                if (row < u.nvalid) { u32x2 w; w.x = pk4_fp8_nc(a0.x, a0.y, a1.x, a1.y); w.y = pk4_fp8_nc(a2.x, a2.y, a3.x, a3.y);
                    *(u32x2*)(ACT + (size_t)(u.rbase + row) * DE + cc) = w; } }
    }
};
struct Epi7 {
    static constexpr bool PERM = true, CHAIN = false;
    const float* bdn; unsigned char* YM;
    __device__ __forceinline__ void operator()(f32x4 (&acc)[2][2][4][2], const Unit& u, int wr, int wc, int fr, int fq) const {
        const int cc = u.pn * 256 + wc * 32 + 8 * fq;
        const float* bp = bdn + (size_t)u.e * D + cc;
        f32x4 bb[2][2];
#pragma unroll
        for (int bj = 0; bj < 2; ++bj) { bb[bj][0] = *(const f32x4*)(bp + bj * 128); bb[bj][1] = *(const f32x4*)(bp + bj * 128 + 4); }
#pragma unroll
        for (int ai = 0; ai < 2; ++ai)
#pragma unroll
            for (int m = 0; m < 4; ++m) { const int row = ai * 128 + wr * 64 + m * 16 + fr;
                if (row < u.nvalid) {
#pragma unroll
                    for (int bj = 0; bj < 2; ++bj) { constexpr float ds = 1.f / (SC_W8 * SC_A8); const f32x4 v0 = acc[ai][bj][m][0] * ds + bb[bj][0], v1 = acc[ai][bj][m][1] * ds + bb[bj][1];
                        u32x2 w; w.x = pk4_fp8(v0.x * SC_Y8, v0.y * SC_Y8, v0.z * SC_Y8, v0.w * SC_Y8); w.y = pk4_fp8(v1.x * SC_Y8, v1.y * SC_Y8, v1.z * SC_Y8, v1.w * SC_Y8);
                        *(u32x2*)(YM + (size_t)(u.rbase + row) * D + cc + bj * 128) = w; } } }
    }
};

__global__ void __launch_bounds__(NWAVES * 64, 2) fwd(Args a) {
    extern __shared__ __attribute__((aligned(16))) unsigned char lds_raw[];
    LAS unsigned char* lds = (LAS unsigned char*)lds_raw;
    volatile LAS unsigned* MISC = (volatile LAS unsigned*)(lds + MISC_OFF);
    const int tid = threadIdx.x, lane = tid & 63, wave = __builtin_amdgcn_readfirstlane(tid >> 6);
    const int G = gridDim.x, bx = blockIdx.x;
    const int vcu = (G % 8 == 0) ? (bx % 8) * (G / 8) + bx / 8 : bx;
    unsigned char* ws = a.ws;
    unsigned* ctl = (unsigned*)(ws + WS_CTL);
    for (int u = tid; u < 512; u += NWAVES * 64) MISC[u] = 0u;
    __syncthreads();
    XcdBarrier bar = xcd_barrier_post(ctl + CW_BAR, MISC + MW_BAR);
    const int gw = vcu * NWAVES + wave, NGW = G * NWAVES;

    bf16* PB = (bf16*)(ws + WS_PB); bf16* VT = (bf16*)(ws + WS_VT); bf16* OA = (bf16*)(ws + WS_OA); bf16* OB = (bf16*)(ws + WS_OB);
    float* stats = (float*)(ws + WS_STATS);
    int* tok_e = (int*)(ws + WS_ROUTE); int* tok_rank = tok_e + T * TOPK; float* tok_gate = (float*)(tok_rank + T * TOPK);

    if (PH_ON(0)) p0_prologue(a, lds, vcu, G, wave, lane);
    xcd_barrier(bar);

    if (PH_ON(1)) {
        int cbeg, cend;
        constexpr int NUP = NE * I_UP1;
        const bool split6 = (G == 256);
        const int CONV1 = split6 ? NUP : MOE_ITEMS;
        if (G == 256) { constexpr int S5 = 220, S4 = 292; static_assert(128 * (S5 + S4) == NUP, "conversion shares");
            cbeg = bx < 128 ? bx * S5 : 128 * S5 + (bx - 128) * S4; cend = cbeg + (bx < 128 ? S5 : S4); }
        else { const int per = (CONV1 + G - 1) / G; cbeg = bx * per; cend = cbeg + per < CONV1 ? cbeg + per : CONV1; if (cbeg > CONV1) cbeg = CONV1; }
        const bool conv_first = ((bx >> 3) & 1) != 0;
        const bool roles = (G == 256);
        const int ridx = (bx >> 4) * 8 + (bx & 7);
        if (roles && conv_first) moe_convert(a, lds, ridx * (NUP / 128), (ridx + 1) * (NUP / 128), wave, lane);
        if (!roles && conv_first) { moe_convert(a, lds, cbeg, cend, wave, lane); __syncthreads(); }
        if (!(roles && conv_first)) {
        pg8::Gemm g{D, D, D};
        Sched1 S{roles ? 128 : G, roles ? ridx : bx, (const char*)(ws + WS_XN), (const char*)(ws + WS_W1T), (const char*)(ws + WS_W2T)};
        Epi1 E{PB, VT, (bf16*)(ws + WS_QB), (bf16*)(ws + WS_KB), stats, a.in[3], a.in[4], (LAS float*)(lds + SCR_OFF)};
        pg8::gemm_phase<Epi1, Sched1>(lds, g, S, E);
        { pg8::Gemm g8{D / 2, D / 2, D / 2};
          Sched1g S8{roles ? 128 : G, roles ? ridx : bx, (const char*)(ws + WS_XN8), (const char*)(ws + WS_WG8)};
          Epi1g E8{PB};
          pg8::gemm_phase<Epi1g, Sched1g, true>(lds, g8, S8, E8); }
        }
        if (!roles && !conv_first) moe_convert(a, lds, cbeg, cend, wave, lane);
    }
    xcd_barrier(bar);

    if (PH_ON(2)) for (int task = gw; task < 4096; task += NGW) {
        if (task < 2048) attn_task((const bf16*)(ws + WS_QB), (const bf16*)(ws + WS_KB), VT, OA, task, lane);
        else sgu_task(a, PB, VT, stats, OB, task - 2048, lane);
    }
    xcd_barrier(bar);

    if (PH_ON(3)) {
        pg8::Gemm g{AW, AW, AW};
        Sched3 S{G, bx, (const char*)(ws + WS_OA), (const char*)(ws + WS_OB), (const char*)(ws + WS_WAT), (const char*)(ws + WS_WBT)};
        Epi3 E{PB, (bf16*)(ws + WS_Y)};
        pg8::gemm_phase<Epi3, Sched3>(lds, g, S, E);
    }
    xcd_barrier(bar);

    if (PH_ON(4)) {
        pg8::Gemm g{D, D, D};
        Sched4 S{G, bx, (const char*)(ws + WS_Y), (const char*)(ws + WS_WOT)};
        Epi4 E{a.in[0], (bf16*)(ws + WS_H1)};
        pg8::gemm_phase<Epi4, Sched4>(lds, g, S, E);
    }
#if DBG_STAGE >= 5
    xcd_barrier(bar);

    if (PH_ON(5)) {
        LAS float* red = (LAS float*)lds;
        LAS float* ssqp = (LAS float*)(lds + 8 * 1056 * 4);
        LAS float* rinfo = ssqp + 256;
        LAS unsigned* lcnt = (LAS unsigned*)(rinfo + 384); LAS unsigned* lbase = lcnt + 32;
        const float* g2 = a.in[11]; const float* brt = a.in[13];
        for (int rb = bx; rb < T / 32; rb += G) {
            const int row0 = rb * 32, i = lane & 31, hk = lane >> 5;
            if (tid < 32) lcnt[tid] = 0u;
            const bf16* xr = (const bf16*)(ws + WS_H1) + (size_t)(row0 + i) * D + wave * 256 + 8 * hk;
            const bf16* whp = (const bf16*)(ws + WS_WRH) + (size_t)i * D + wave * 256 + 8 * hk;
            const bf16* wlp = (const bf16*)(ws + WS_WRL) + (size_t)i * D + wave * 256 + 8 * hk;
            f32x16 acc;
#pragma unroll
            for (int r = 0; r < 16; ++r) acc[r] = 0.f;
            float ssq = 0.f;
#pragma unroll 4
            for (int st = 0; st < 16; ++st) {
                const u32x4 xb = *(const u32x4*)(xr + 16 * st);
                const bf16x8 wh = *(const bf16x8*)(whp + 16 * st), wl = *(const bf16x8*)(wlp + 16 * st);
                const float x0 = bf_lo(xb.x), x1 = bf_hi(xb.x), x2 = bf_lo(xb.y), x3 = bf_hi(xb.y), x4 = bf_lo(xb.z), x5 = bf_hi(xb.z), x6 = bf_lo(xb.w), x7 = bf_hi(xb.w);
                ssq += (x0 * x0 + x1 * x1) + (x2 * x2 + x3 * x3) + (x4 * x4 + x5 * x5) + (x6 * x6 + x7 * x7);
                const bf16x8 xh = __builtin_bit_cast(bf16x8, xb);
                acc = __builtin_amdgcn_mfma_f32_32x32x16_bf16(xh, wh, acc, 0, 0, 0);
                acc = __builtin_amdgcn_mfma_f32_32x32x16_bf16(xh, wl, acc, 0, 0, 0);
            }
            ssq += __shfl_xor(ssq, 32);
            if (lane < 32) ssqp[wave * 32 + i] = ssq;
#pragma unroll
            for (int r = 0; r < 16; ++r) red[wave * 1056 + i * 33 + (r & 3) + 8 * (r >> 2) + 4 * hk] = acc[r];
            LDS_WAIT(); __syncthreads();
            if (tid < 32) {
                float sq = 0.f;
#pragma unroll
                for (int w = 0; w < 8; ++w) sq += ssqp[w * 32 + tid];
                const float rstd = rsqrtf(sq * (1.f / D) + EPS);
                float v0 = -3.0e38f, v1 = -3.0e38f, v2 = -3.0e38f, v3 = -3.0e38f; int i0 = 0, i1 = 0, i2 = 0, i3 = 0;
                for (int e = 0; e < NE; ++e) { float v = 0.f;
#pragma unroll
                    for (int w = 0; w < 8; ++w) v += red[w * 1056 + e * 33 + tid];
                    const float x = v * rstd + brt[e];
                    if (x > v3) { if (x > v2) { v3 = v2; i3 = i2; if (x > v1) { v2 = v1; i2 = i1; if (x > v0) { v1 = v0; i1 = i0; v0 = x; i0 = e; } else { v1 = x; i1 = e; } } else { v2 = x; i2 = e; } } else { v3 = x; i3 = e; } } }
                const float p1 = __expf(v1 - v0), p2 = __expf(v2 - v0), p3 = __expf(v3 - v0), inv = 1.f / (1.f + p1 + p2 + p3);
                const int t = row0 + tid;
                const unsigned l0 = __hip_atomic_fetch_add(lcnt + i0, 1u, __ATOMIC_RELAXED, __HIP_MEMORY_SCOPE_WORKGROUP), l1 = __hip_atomic_fetch_add(lcnt + i1, 1u, __ATOMIC_RELAXED, __HIP_MEMORY_SCOPE_WORKGROUP);
                const unsigned l2 = __hip_atomic_fetch_add(lcnt + i2, 1u, __ATOMIC_RELAXED, __HIP_MEMORY_SCOPE_WORKGROUP), l3 = __hip_atomic_fetch_add(lcnt + i3, 1u, __ATOMIC_RELAXED, __HIP_MEMORY_SCOPE_WORKGROUP);
                LDS_WAIT(); asm volatile("" ::: "memory");
                { const unsigned ne_ = lcnt[tid]; unsigned base_ = 0u; if (ne_) base_ = atomicAdd(ctl + CW_CNT + 64 * tid, ne_); lbase[tid] = base_; }
                LDS_WAIT(); asm volatile("" ::: "memory");
                const int r0 = (int)(lbase[i0] + l0), r1 = (int)(lbase[i1] + l1), r2 = (int)(lbase[i2] + l2), r3 = (int)(lbase[i3] + l3);
                tok_e[t * 4 + 0] = i0; tok_e[t * 4 + 1] = i1; tok_e[t * 4 + 2] = i2; tok_e[t * 4 + 3] = i3;
                tok_rank[t * 4 + 0] = r0; tok_rank[t * 4 + 1] = r1; tok_rank[t * 4 + 2] = r2; tok_rank[t * 4 + 3] = r3;
                tok_gate[t * 4 + 0] = inv; tok_gate[t * 4 + 1] = p1 * inv; tok_gate[t * 4 + 2] = p2 * inv; tok_gate[t * 4 + 3] = p3 * inv;
                LAS float* ri = rinfo + tid * 12; ri[0] = rstd;
                ri[1] = __int_as_float(i0); ri[2] = __int_as_float(i1); ri[3] = __int_as_float(i2); ri[4] = __int_as_float(i3);
                ri[5] = __int_as_float(r0); ri[6] = __int_as_float(r1); ri[7] = __int_as_float(r2); ri[8] = __int_as_float(r3);
            }
            LDS_WAIT(); __syncthreads();
            unsigned char* XG = ws + WS_XG;
            for (int rr = 0; rr < 4; ++rr) { const int il = wave * 4 + rr; const LAS float* ri = rinfo + il * 12;
                const float rstd = ri[0];
                size_t dsto[4];
#pragma unroll
                for (int k = 0; k < 4; ++k) dsto[k] = ((size_t)__float_as_int(ri[1 + k]) * T + (size_t)__float_as_int(ri[5 + k])) * D;
                const u32x2* hr = (const u32x2*)((const bf16*)(ws + WS_H1) + (size_t)(row0 + il) * D) + lane;
#pragma unroll
                for (int j = 0; j < 8; ++j) { const u32x2 hb = hr[64 * j]; const f32x4 v = (f32x4){bf_lo(hb.x), bf_hi(hb.x), bf_lo(hb.y), bf_hi(hb.y)}; const f32x4 gg = *((const f32x4*)g2 + lane + 64 * j);
                    const float rs8 = rstd * SC_X8; const unsigned o = pk4_fp8(v.x * rs8 * gg.x, v.y * rs8 * gg.y, v.z * rs8 * gg.z, v.w * rs8 * gg.w);
#pragma unroll
                    for (int k = 0; k < 4; ++k) *((unsigned*)(XG + dsto[k]) + lane + 64 * j) = o; } }
            LDS_WAIT(); __syncthreads();
        }
    }
    xcd_barrier(bar);

    if (tid < NE) MISC[MW_CNT + tid] = __hip_atomic_load(ctl + CW_CNT + 64 * tid, __ATOMIC_RELAXED, __HIP_MEMORY_SCOPE_AGENT);
    LDS_WAIT(); __syncthreads();
    if (tid < 64) {
        const unsigned n = tid < NE ? MISC[MW_CNT + tid] : 0u, mt = (n + 255u) >> 8;
        unsigned so = n, su = mt;
#pragma unroll
        for (int o = 1; o < 32; o <<= 1) { const unsigned a_ = __shfl_up(so, o), b_ = __shfl_up(su, o); if ((tid & 63) >= o) { so += a_; su += b_; } }
        if (tid < NE) { MISC[MW_OFF + tid] = so - n; MISC[MW_US6 + tid] = (su - mt) * 16u; MISC[MW_US7 + tid] = (su - mt) * 8u; }
        if (tid == NE - 1) { MISC[MW_US6 + NE] = su * 16u; MISC[MW_US7 + NE] = su * 8u; }
    }
    LDS_WAIT(); __syncthreads();

    if (PH_ON(6)) {
        pg8::Gemm g{D / 2, D / 2, D / 2};
        constexpr int NSTREAM = 8;
        const bool split = (G == 256);
        SchedMoE<6> S{G, vcu, MISC, (const char*)(ws + WS_XG), (const char*)(ws + WS_WUT), split ? 32 - NSTREAM : 32};
        Epi6 E{a.in[15], ws + WS_ACT};
        if (split && (vcu & 31) >= 32 - NSTREAM) { constexpr int NUP6 = NE * I_UP1, NDN6 = NE * I_DN1, PER = NDN6 / (8 * NSTREAM); static_assert(PER * 8 * NSTREAM == NDN6, "w_down shares");
            const int sidx = (vcu >> 5) * NSTREAM + ((vcu & 31) - (32 - NSTREAM)); moe_convert(a, lds, NUP6 + sidx * PER, NUP6 + (sidx + 1) * PER, wave, lane); __syncthreads(); }
        pg8::gemm_phase<Epi6, SchedMoE<6>, true>(lds, g, S, E);
    }
    xcd_barrier(bar);

    if (PH_ON(7)) {
        pg8::Gemm g{DE / 2, DE / 2, DE / 2};
        SchedMoE<7> S{G, vcu, MISC, (const char*)(ws + WS_ACT), (const char*)(ws + WS_WDT), 32};
        Epi7 E{a.in[17], ws + WS_YM};
        pg8::gemm_phase<Epi7, SchedMoE<7>, true>(lds, g, S, E);
    }
    xcd_barrier(bar);

    if (PH_ON(8)) {
        const unsigned char* YM = ws + WS_YM;
        for (int t = gw; t < T; t += NGW) {
            size_t pos[4]; float gt[4];
#pragma unroll
            for (int k = 0; k < 4; ++k) { const int e = tok_e[t * 4 + k], rk = tok_rank[t * 4 + k]; gt[k] = tok_gate[t * 4 + k]; pos[k] = ((size_t)MISC[MW_OFF + e] + (size_t)rk) * D; }
            f32x4* orow = (f32x4*)(a.out + (size_t)t * D) + lane;
            const u32x2* hrow = (const u32x2*)((const bf16*)(ws + WS_H1) + (size_t)t * D) + lane;
#pragma unroll
            for (int j = 0; j < 8; ++j) { const u32x2 hb = __builtin_nontemporal_load(hrow + 64 * j); f32x4 o = (f32x4){bf_lo(hb.x), bf_hi(hb.x), bf_lo(hb.y), bf_hi(hb.y)};
#pragma unroll
                for (int k = 0; k < 4; ++k) { const int y = (int)__builtin_nontemporal_load((const unsigned*)(YM + pos[k]) + lane + 64 * j);
                    const f32x2 ylo = __builtin_amdgcn_cvt_pk_f32_fp8(y, false), yhi = __builtin_amdgcn_cvt_pk_f32_fp8(y, true); const float gk = gt[k] * (1.f / SC_Y8);
                    o.x += gk * ylo.x; o.y += gk * ylo.y; o.z += gk * yhi.x; o.w += gk * yhi.y; }
                __builtin_nontemporal_store(o, orow + 64 * j); }
        }
    }
#endif
}

extern "C" void kernel_launch(void* const* d_in, const int* in_sizes, int n_in, void* d_out, int out_size, void* d_ws, size_t ws_size, hipStream_t stream) {
    static int grid = 0;
    if (grid == 0) {
        if (n_in != 18 || out_size != T * D || ws_size < WS_END) { fprintf(stderr, "kernel_launch: unexpected shapes (n_in %d, out %d, ws %zu)\n", n_in, out_size, ws_size); grid = -1; return; }
        int dev = 0, cus = 0, per_cu = 0;
        if (hipGetDevice(&dev) != hipSuccess || hipDeviceGetAttribute(&cus, hipDeviceAttributeMultiprocessorCount, dev) != hipSuccess) { grid = -1; return; }
        if (hipFuncSetAttribute((const void*)fwd, hipFuncAttributeMaxDynamicSharedMemorySize, LDS_BYTES) != hipSuccess) { fprintf(stderr, "kernel_launch: hipFuncSetAttribute failed\n"); grid = -1; return; }
        if (hipOccupancyMaxActiveBlocksPerMultiprocessor(&per_cu, (const void*)fwd, NWAVES * 64, LDS_BYTES) != hipSuccess || per_cu < 1) { fprintf(stderr, "kernel_launch: occupancy query says %d\n", per_cu); }
        (void)hipGetLastError();
        grid = cus;
        if (per_cu < 1) grid = -1;
    }
    if (grid < 0) return;
    if (hipMemsetAsync((char*)d_ws + WS_CTL, 0, CTL_ZERO_BYTES, stream) != hipSuccess) return;
    Args a{};
    for (int i = 0; i < 18; ++i) a.in[i] = (const float*)d_in[i];
    a.out = (float*)d_out; a.ws = (unsigned char*)d_ws;
    hipLaunchKernelGGL(fwd, dim3(grid), dim3(NWAVES * 64), LDS_BYTES, stream, a);
}
```
